# Optimizing an MI355X kernel written in HIP

```python
import math
import jax, jax.numpy as jnp
from jax import lax
import numpy as np

D_MODEL = 1024
BATCH = 2
SEQ = 16384
DEPTH = 4
DEC_BATCH = 8
DEC_SEQ = 32
PAST_LEN = 1024

CHUNK = 64
Q_BLOCK = 128
N_MIXERS = 4
N_GROUPS = DEPTH // N_MIXERS
ROPE_THETA = 10000.0
NORM_EPS = 1e-6
NEG_INF = -1e30

A_HEADS = 8
A_HD = 64
A_VD = 2 * A_HD
A_SUBLN_EPS = 1e-5
B_HEADS = 8
B_NOPE = 128
B_ROPE = 64
B_VD = 128
B_Q_LORA = 384
B_KV_LORA = 256
C_WIDTH = 3
D_WINDOWS = (2, 4, 8, 16)
D_GROUP = D_MODEL // 4
D_HIST = 15
D_FF = 2816
FFN_WIDTH = 3

kernel_name = 'hybrid_chunk_causal_encoder_step'


def rmsnorm(x, g, eps=NORM_EPS):
    xf = x.astype(jnp.float32)
    y = xf * lax.rsqrt(jnp.mean(xf * xf, axis=-1, keepdims=True) + eps)
    return (y * g.astype(jnp.float32)).astype(x.dtype)


def rope(x, pos):
    d = x.shape[-1]
    inv = jnp.power(ROPE_THETA, -jnp.arange(0, d, 2, dtype=jnp.float32) / d)
    ang = pos.astype(jnp.float32)[:, None] * inv[None, :]
    ang = ang.reshape((ang.shape[0],) + (1,) * (x.ndim - 3) + (d // 2,))
    cos, sin = jnp.cos(ang), jnp.sin(ang)
    xf = x.astype(jnp.float32)
    x1, x2 = xf[..., : d // 2], xf[..., d // 2:]
    return jnp.concatenate([x1 * cos - x2 * sin, x2 * cos + x1 * sin], axis=-1).astype(x.dtype)


def causal_dwconv(x, hist, w):
    width = w.shape[0]
    s = x.shape[1]
    xh = jnp.concatenate([hist, x], axis=1)
    y = xh[:, 0:s] * w[0]
    for k in range(1, width):
        y = y + xh[:, k:k + s] * w[k]
    return y, xh[:, -(width - 1):]


def masked_softmax(s, mask):
    s = s.astype(jnp.float32)
    if mask is not None:
        s = jnp.where(mask, s, NEG_INF)
    return jax.nn.softmax(s, axis=-1)


def chunk_causal_mask(q_start, n_q, n_k):
    qc = (q_start + jnp.arange(n_q)) // CHUNK
    kc = jnp.arange(n_k) // CHUNK
    return kc[None, :] <= qc[:, None]


def sweep_query_blocks(fn, q_arrays, seq):
    nb = seq // Q_BLOCK
    def to_blocks(a):
        return jnp.moveaxis(a.reshape((a.shape[0], nb, Q_BLOCK) + a.shape[2:]), 1, 0)
    idx = jnp.arange(nb, dtype=jnp.int32)
    out = lax.map(lambda args: fn(args[0] * Q_BLOCK, *args[1:]),
                  (idx,) + tuple(to_blocks(a) for a in q_arrays))
    out = jnp.moveaxis(out, 0, 1)
    return out.reshape((out.shape[0], seq) + out.shape[3:])


def diff_lambda(lam, layer):
    lam_init = 0.8 - 0.6 * math.exp(-0.3 * layer)
    lf = lam.astype(jnp.float32)
    val = jnp.exp(jnp.sum(lf[0] * lf[1])) - jnp.exp(jnp.sum(lf[2] * lf[3])) + lam_init
    return val, lam_init


def diff_project(h, w_qkv, pos):
    nb, s, _ = h.shape
    q, k, v = jnp.split(h @ w_qkv, 3, axis=-1)
    q = rope(q.reshape(nb, s, A_HEADS, 2, A_HD), pos)
    k = rope(k.reshape(nb, s, A_HEADS, 2, A_HD), pos)
    return q, k, v.reshape(nb, s, A_HEADS, A_VD)


def diff_attend(q, k, v, lam, mask):
    s = jnp.einsum('bqhcd,bkhcd->bchqk', q, k) / math.sqrt(A_HD)
    p = masked_softmax(s, mask)
    p = p[:, 0] - lam * p[:, 1]
    return jnp.einsum('bhqk,bkhe->bqhe', p.astype(v.dtype), v)


def diff_finish(o, subln_g, lam_init, w_o):
    o = rmsnorm(o, subln_g, A_SUBLN_EPS) * (1.0 - lam_init)
    return o.reshape(o.shape[0], o.shape[1], -1) @ w_o


def mla_project(h, w_down, q_norm_g, w_uq, kv_norm_g, pos):
    nb, s, _ = h.shape
    cq, ckv, kr = jnp.split(h @ w_down, [B_Q_LORA, B_Q_LORA + B_KV_LORA], axis=-1)
    cq = rmsnorm(cq, q_norm_g)
    ckv = rmsnorm(ckv, kv_norm_g)
    kr = rope(kr[:, :, None, :], pos)[:, :, 0]
    q = (cq @ w_uq).reshape(nb, s, B_HEADS, B_NOPE + B_ROPE)
    return q[..., :B_NOPE], rope(q[..., B_NOPE:], pos), ckv, kr


def mla_expand_kv(ckv, kr, w_uk, w_uv):
    k_nope = jnp.einsum('bsl,lhn->bshn', ckv, w_uk)
    v = jnp.einsum('bsl,lhv->bshv', ckv, w_uv)
    k_rope = jnp.broadcast_to(kr[:, :, None, :], k_nope.shape[:3] + (B_ROPE,))
    return jnp.concatenate([k_nope, k_rope], axis=-1), v


def mla_attend_expanded(q, k, v, mask):
    s = jnp.einsum('bqhd,bkhd->bhqk', q, k) / math.sqrt(B_NOPE + B_ROPE)
    p = masked_softmax(s, mask).astype(v.dtype)
    return jnp.einsum('bhqk,bkhv->bqhv', p, v)


def mla_attend_latent(q_nope, q_rope, ckv, kr, w_uk, w_uv):
    q_lat = jnp.einsum('bqhn,lhn->bqhl', q_nope, w_uk)
    s = (jnp.einsum('bqhl,bkl->bhqk', q_lat, ckv)
         + jnp.einsum('bqhr,bkr->bhqk', q_rope, kr)) / math.sqrt(B_NOPE + B_ROPE)
    p = masked_softmax(s, None).astype(ckv.dtype)
    o_lat = jnp.einsum('bhqk,bkl->bqhl', p, ckv)
    return jnp.einsum('bqhl,lhv->bqhv', o_lat, w_uv)


def short_conv_mixer(h, hist, w_in, conv_w, w_out):
    gate_b, gate_c, v = jnp.split(h @ w_in, 3, axis=-1)
    y, new_hist = causal_dwconv(gate_c * v, hist, conv_w)
    return (gate_b * y) @ w_out, new_hist


def pooling_mixer(h, hist, hist_valid, w_group, scale):
    t = h.shape[1]
    xcat = jnp.concatenate([hist, h], axis=1)
    xh = xcat.astype(jnp.float32)
    cs = jnp.concatenate([jnp.zeros_like(xh[:, :1]), jnp.cumsum(xh, axis=1)], axis=1)
    end = cs[:, D_HIST + 1:]
    tpos = jnp.arange(t)
    outs = []
    for g, w in enumerate(D_WINDOWS):
        sl = slice(g * D_GROUP, (g + 1) * D_GROUP)
        start = cs[:, D_HIST + 1 - w: D_HIST + 1 - w + t, sl]
        cnt = jnp.minimum(tpos + hist_valid + 1, w).astype(jnp.float32)[None, :, None]
        pooled = (end[..., sl] - start) / cnt
        outs.append((pooled - xh[:, D_HIST:, sl]).astype(h.dtype) @ w_group[g])
    return jnp.concatenate(outs, axis=-1) * scale, xcat[:, -D_HIST:]


def conv_ffn(h, hist, w_gate, w_up, conv_w, conv_b, w_down):
    g, new_hist = causal_dwconv(h @ w_gate, hist, conv_w)
    return (jax.nn.silu(g + conv_b) * (h @ w_up)) @ w_down, new_hist


def setup_inputs(seed: int = 0) -> dict:
    key = jax.random.key(seed)
    ks = iter(jax.random.split(key, 64))
    def nrm(shape, scale):
        return jax.random.normal(next(ks), shape, jnp.float32) * scale
    def gain(shape):
        return 1.0 + nrm(shape, 0.1)
    G = N_GROUPS
    return {
        'x_prompt': nrm((BATCH, SEQ, D_MODEL), 1.0),
        'x_sample': nrm((DEC_BATCH, DEC_SEQ, D_MODEL), 1.0),
        'cache_a_k': nrm((G, DEC_BATCH, PAST_LEN, A_HEADS, 2, A_HD), 1.0),
        'cache_a_v': nrm((G, DEC_BATCH, PAST_LEN, A_HEADS, A_VD), 1.0),
        'cache_b_latent': nrm((G, DEC_BATCH, PAST_LEN, B_KV_LORA), 1.0),
        'cache_b_krope': nrm((G, DEC_BATCH, PAST_LEN, B_ROPE), 1.0),
        'state_c_conv': nrm((G, DEC_BATCH, C_WIDTH - 1, D_MODEL), 1.0),
        'state_d_pool': nrm((G, DEC_BATCH, D_HIST, D_MODEL), 1.0),
        'state_ffn_conv': nrm((DEPTH, DEC_BATCH, FFN_WIDTH - 1, D_FF), 1.0),
        'norm_mix_g': gain((DEPTH, D_MODEL)),
        'norm_ffn_g': gain((DEPTH, D_MODEL)),
        'norm_final_g': gain((D_MODEL,)),
        'a_w_qkv': nrm((G, D_MODEL, 3 * D_MODEL), D_MODEL ** -0.5),
        'a_lam': nrm((G, 4, A_HD), 0.1),
        'a_subln_g': gain((G, A_VD)),
        'a_w_o': nrm((G, A_HEADS * A_VD, D_MODEL), (A_HEADS * A_VD) ** -0.5),
        'b_w_down': nrm((G, D_MODEL, B_Q_LORA + B_KV_LORA + B_ROPE), D_MODEL ** -0.5),
        'b_q_norm_g': gain((G, B_Q_LORA)),
        'b_w_uq': nrm((G, B_Q_LORA, B_HEADS * (B_NOPE + B_ROPE)), B_Q_LORA ** -0.5),
        'b_kv_norm_g': gain((G, B_KV_LORA)),
        'b_w_uk': nrm((G, B_KV_LORA, B_HEADS, B_NOPE), B_KV_LORA ** -0.5),
        'b_w_uv': nrm((G, B_KV_LORA, B_HEADS, B_VD), B_KV_LORA ** -0.5),
        'b_w_o': nrm((G, B_HEADS * B_VD, D_MODEL), (B_HEADS * B_VD) ** -0.5),
        'c_w_in': nrm((G, D_MODEL, 3 * D_MODEL), D_MODEL ** -0.5),
        'c_conv_w': nrm((G, C_WIDTH, D_MODEL), C_WIDTH ** -0.5),
        'c_w_out': nrm((G, D_MODEL, D_MODEL), D_MODEL ** -0.5),
        'd_w_group': nrm((G, 4, D_GROUP, D_GROUP), D_GROUP ** -0.5),
        'd_scale': gain((G, D_MODEL)),
        'ffn_w_gate': nrm((DEPTH, D_MODEL, D_FF), D_MODEL ** -0.5),
        'ffn_w_up': nrm((DEPTH, D_MODEL, D_FF), D_MODEL ** -0.5),
        'ffn_conv_w': nrm((DEPTH, FFN_WIDTH, D_FF), FFN_WIDTH ** -0.5),
        'ffn_conv_b': nrm((DEPTH, D_FF), 0.01),
        'ffn_w_down': nrm((DEPTH, D_FF, D_MODEL), D_FF ** -0.5),
    }


def reference(x_prompt, x_sample, cache_a_k, cache_a_v, cache_b_latent, cache_b_krope,
              state_c_conv, state_d_pool, state_ffn_conv, norm_mix_g, norm_ffn_g, norm_final_g,
              a_w_qkv, a_lam, a_subln_g, a_w_o, b_w_down, b_q_norm_g, b_w_uq, b_kv_norm_g,
              b_w_uk, b_w_uv, b_w_o, c_w_in, c_conv_w, c_w_out, d_w_group, d_scale,
              ffn_w_gate, ffn_w_up, ffn_conv_w, ffn_conv_b, ffn_w_down):
    xp, xs = x_prompt, x_sample
    n_p, seq = xp.shape[0], xp.shape[1]
    n_s, t_new = xs.shape[0], xs.shape[1]
    past = cache_a_k.shape[2]
    pos_p = jnp.arange(seq, dtype=jnp.int32)
    pos_s = past + jnp.arange(t_new, dtype=jnp.int32)
    ak_p, av_p, bl_p, br_p, cc_p, dp_p, fc_p = [], [], [], [], [], [], []
    ak_s, av_s, bl_s, br_s, cc_s, dp_s, fc_s = [], [], [], [], [], [], []
    for i in range(DEPTH):
        m, j = i % N_MIXERS, i // N_MIXERS
        hp = rmsnorm(xp, norm_mix_g[i])
        hs = rmsnorm(xs, norm_mix_g[i])
        if m == 0:
            lam, lam_init = diff_lambda(a_lam[j], i)
            qp, kp, vp = diff_project(hp, a_w_qkv[j], pos_p)
            op = sweep_query_blocks(
                lambda q0, qb, k=kp, v=vp, lm=lam: diff_attend(qb, k, v, lm, chunk_causal_mask(q0, Q_BLOCK, seq)),
                (qp,), seq)
            qs, ks_, vs = diff_project(hs, a_w_qkv[j], pos_s)
            osm = diff_attend(qs, jnp.concatenate([cache_a_k[j], ks_], axis=1),
                              jnp.concatenate([cache_a_v[j], vs], axis=1), lam, None)
            mp = diff_finish(op, a_subln_g[j], lam_init, a_w_o[j])
            ms = diff_finish(osm, a_subln_g[j], lam_init, a_w_o[j])
            ak_p.append(kp); av_p.append(vp); ak_s.append(ks_); av_s.append(vs)
        elif m == 1:
            qnp, qrp, lp, rp = mla_project(hp, b_w_down[j], b_q_norm_g[j], b_w_uq[j], b_kv_norm_g[j], pos_p)
            kfull, vfull = mla_expand_kv(lp, rp, b_w_uk[j], b_w_uv[j])
            qfull = jnp.concatenate([qnp, qrp], axis=-1)
            op = sweep_query_blocks(
                lambda q0, qb, k=kfull, v=vfull: mla_attend_expanded(qb, k, v, chunk_causal_mask(q0, Q_BLOCK, seq)),
                (qfull,), seq)
            qns, qrs, ls, rs = mla_project(hs, b_w_down[j], b_q_norm_g[j], b_w_uq[j], b_kv_norm_g[j], pos_s)
            osm = mla_attend_latent(qns, qrs, jnp.concatenate([cache_b_latent[j], ls], axis=1),
                                    jnp.concatenate([cache_b_krope[j], rs], axis=1), b_w_uk[j], b_w_uv[j])
            mp = op.reshape(n_p, seq, -1) @ b_w_o[j]
            ms = osm.reshape(n_s, t_new, -1) @ b_w_o[j]
            bl_p.append(lp); br_p.append(rp); bl_s.append(ls); br_s.append(rs)
        elif m == 2:
            mp, hcp = short_conv_mixer(hp, jnp.zeros((n_p, C_WIDTH - 1, D_MODEL), hp.dtype),
                                       c_w_in[j], c_conv_w[j], c_w_out[j])
            ms, hcs = short_conv_mixer(hs, state_c_conv[j], c_w_in[j], c_conv_w[j], c_w_out[j])
            cc_p.append(hcp); cc_s.append(hcs)
        else:
            mp, hdp = pooling_mixer(hp, jnp.zeros((n_p, D_HIST, D_MODEL), hp.dtype), 0,
                                    d_w_group[j], d_scale[j])
            ms, hds = pooling_mixer(hs, state_d_pool[j], D_HIST, d_w_group[j], d_scale[j])
            dp_p.append(hdp); dp_s.append(hds)
        xp = xp + mp
        xs = xs + ms
        hp = rmsnorm(xp, norm_ffn_g[i])
        hs = rmsnorm(xs, norm_ffn_g[i])
        fp, hfp = conv_ffn(hp, jnp.zeros((n_p, FFN_WIDTH - 1, D_FF), hp.dtype), ffn_w_gate[i],
                           ffn_w_up[i], ffn_conv_w[i], ffn_conv_b[i], ffn_w_down[i])
        fs, hfs = conv_ffn(hs, state_ffn_conv[i], ffn_w_gate[i], ffn_w_up[i], ffn_conv_w[i],
                           ffn_conv_b[i], ffn_w_down[i])
        fc_p.append(hfp); fc_s.append(hfs)
        xp = xp + fp
        xs = xs + fs
    y_prompt = rmsnorm(xp, norm_final_g)
    y_sample = rmsnorm(xs, norm_final_g)
    return (y_prompt, y_sample,
            jnp.stack(ak_p), jnp.stack(av_p), jnp.stack(bl_p), jnp.stack(br_p),
            jnp.stack(cc_p), jnp.stack(dp_p), jnp.stack(fc_p),
            jnp.stack(ak_s), jnp.stack(av_s), jnp.stack(bl_s), jnp.stack(br_s),
            jnp.stack(cc_s), jnp.stack(dp_s), jnp.stack(fc_s))
```

```cpp
#include <hip/hip_runtime.h>
#include <hip/hip_cooperative_groups.h>
#include <cstdio>
#include <cstdint>
namespace cg = cooperative_groups;

#define LAS __attribute__((address_space(3)))
#define GAS __attribute__((address_space(1)))
typedef unsigned short bf16_t;
typedef short bf16x8 __attribute__((ext_vector_type(8)));
typedef short s16x4 __attribute__((ext_vector_type(4)));
typedef float f32x4 __attribute__((ext_vector_type(4)));
typedef float f32x16 __attribute__((ext_vector_type(16)));
typedef unsigned u32x4 __attribute__((ext_vector_type(4)));
typedef unsigned u32x2 __attribute__((ext_vector_type(2)));

constexpr int D = 1024, SEQ = 16384, NBP = 2, MP = NBP * SEQ, SBN = 8, STN = 32, MS = SBN * STN, M = MP + MS;
constexpr int PAST = 1024, NKS = PAST + STN, NKSP = 1152, FF = 2816, MCACHE = SBN * PAST, MX = M + MCACHE;
constexpr float NORM_EPS = 1e-6f;
constexpr int NTHREADS = 512;
constexpr int LDS_BYTES = 131072 + 4096 + 8192;
#ifndef PROBE_CONV_REPS
#define PROBE_CONV_REPS 1
#endif
#ifndef PROBE_SYNC_REPS
#define PROBE_SYNC_REPS 3
#endif
#ifndef PROBE_ATTN_REPS
#define PROBE_ATTN_REPS 1
#endif

constexpr size_t O_Y = 0;
constexpr size_t O_AKP = (size_t)M * D;
constexpr size_t O_AVP = O_AKP + (size_t)MP * D;
constexpr size_t O_BLP = O_AVP + (size_t)MP * D;
constexpr size_t O_BRP = O_BLP + (size_t)MP * 256;
constexpr size_t O_CCP = O_BRP + (size_t)MP * 64;
constexpr size_t O_DPP = O_CCP + (size_t)NBP * 2 * D;
constexpr size_t O_FCP = O_DPP + (size_t)NBP * 15 * D;
constexpr size_t O_AKS = O_FCP + (size_t)4 * NBP * 2 * FF;
constexpr size_t O_AVS = O_AKS + (size_t)MS * D;
constexpr size_t O_BLS = O_AVS + (size_t)MS * D;
constexpr size_t O_BRS = O_BLS + (size_t)MS * 256;
constexpr size_t O_CCS = O_BRS + (size_t)MS * 64;
constexpr size_t O_DPS = O_CCS + (size_t)SBN * 2 * D;
constexpr size_t O_FCS = O_DPS + (size_t)SBN * 15 * D;
constexpr size_t O_END = O_FCS + (size_t)4 * SBN * 2 * FF;

constexpr size_t MiB = 1u << 20;
constexpr size_t WS_SSQ = 0;
constexpr size_t WS_ROPE = 2 * MiB;
constexpr size_t WS_WMIX = 6 * MiB;
constexpr size_t WS_WFFN = 29 * MiB;
constexpr size_t WS_XB = 46 * MiB;
constexpr size_t WS_BIG = 111 * MiB;
constexpr size_t WS_TAIL = 467 * MiB;
constexpr size_t WS_END = 512 * MiB;
constexpr size_t WS_SSQP = WS_TAIL + 38 * MiB;
static_assert((size_t)M * 16 * 4 <= 3 * MiB && WS_SSQP + 6 * MiB <= WS_END, "ssqp");
constexpr size_t W_QKV = 0, W_OA = W_QKV + 3072u * 1024, W_DB = W_OA + 1024u * 1024, W_UQ = W_DB + 768u * 1024, W_UKV = W_UQ + 1536u * 384,
                 W_OB = W_UKV + 2048u * 256, W_CIN = W_OB + 1024u * 1024, W_COUT = W_CIN + 3072u * 1024, W_DG = W_COUT + 1024u * 1024, W_MIX_END = W_DG + 1024u * 256;
static_assert(WS_WMIX + W_MIX_END * 2 <= WS_WFFN, "mixer weights");
constexpr size_t W_GU = 0, W_DN = 5632u * 1024, W_FFN_END = W_DN + 1024u * 2816;
static_assert(WS_WFFN + W_FFN_END * 2 <= WS_XB, "ffn weights");
static_assert(WS_XB + (size_t)M * D * 2 <= WS_BIG, "xb");
static_assert(WS_BIG + (size_t)M * 5632 * 2 <= WS_TAIL, "U");
constexpr size_t B0_Q = 0, B0_K = 65 * MiB, B0_V = 130 * MiB, B0_OS = 195 * MiB;
constexpr size_t B1_DOWN = 0, B1_CQ = 97 * MiB, B1_CKV = 122 * MiB, B1_KN = 143 * MiB, B1_KR = 208 * MiB, B1_V = 213 * MiB, B1_AO = 278 * MiB;
constexpr size_t B2_CIN = 0, B2_CP = 194 * MiB;
static_assert(B0_OS + (size_t)M * D * 4 <= 356 * MiB && B1_AO + 65 * MiB <= 356 * MiB, "big");
static_assert((size_t)MX * 256 * 2 <= 21 * MiB && (size_t)M * 1536 * 2 <= 97 * MiB && (size_t)M * 768 * 4 <= 97 * MiB, "big2");
constexpr size_t T_K = 0, T_V = 18 * MiB, T_KR = 36 * MiB;
static_assert((size_t)SBN * NKSP * D * 2 <= 18 * MiB && WS_TAIL + T_KR + (size_t)SBN * NKSP * 64 * 2 <= WS_END, "tail");

__device__ __forceinline__ unsigned cvt_pk(float lo, float hi) { unsigned r; asm volatile("v_cvt_pk_bf16_f32 %0, %1, %2" : "=v"(r) : "v"(lo), "v"(hi)); return r; }
__device__ __forceinline__ bf16_t f2bf(float f) { return (bf16_t)(cvt_pk(f, 0.f) & 0xffffu); }
__device__ __forceinline__ u32x2 pack4(f32x4 v) { u32x2 w; w.x = cvt_pk(v[0], v[1]); w.y = cvt_pk(v[2], v[3]); return w; }
__device__ __forceinline__ u32x4 pack8(f32x4 a, f32x4 b) { u32x4 w; w.x = cvt_pk(a[0], a[1]); w.y = cvt_pk(a[2], a[3]); w.z = cvt_pk(b[0], b[1]); w.w = cvt_pk(b[2], b[3]); return w; }
__device__ __forceinline__ float bflo(unsigned w) { return __uint_as_float(w << 16); }
__device__ __forceinline__ float bfhi(unsigned w) { return __uint_as_float(w & 0xffff0000u); }
__device__ __forceinline__ void unpack8(u32x4 w, float* f) { f[0] = bflo(w.x); f[1] = bfhi(w.x); f[2] = bflo(w.y); f[3] = bfhi(w.y); f[4] = bflo(w.z); f[5] = bfhi(w.z); f[6] = bflo(w.w); f[7] = bfhi(w.w); }
__device__ __forceinline__ float rstd_of(float ssq) { return rsqrtf(ssq * (1.0f / 1024.0f) + NORM_EPS); }
__device__ __forceinline__ float rstd_row(const float* __restrict__ p, int row) {
    const f32x4* q = (const f32x4*)(p + (size_t)row * 16);
    const f32x4 a = q[0], b = q[1], c = q[2], d = q[3];
    const float s = (((a[0] + a[1]) + (a[2] + a[3])) + ((b[0] + b[1]) + (b[2] + b[3]))) + (((c[0] + c[1]) + (c[2] + c[3])) + ((d[0] + d[1]) + (d[2] + d[3])));
    return rstd_of(s);
}
__device__ __forceinline__ float wave_sum(float v) {
#pragma unroll
    for (int o = 32; o >= 1; o >>= 1) v += __shfl_xor(v, o);
    return v;
}

namespace pg8 {
constexpr int BM = 256, BK = 64, HALF = 128, HTB = HALF * BK * 2, STAGE_BYTES = 8 * HTB, NXCD = 8, WGM = 8;
__host__ __device__ __forceinline__ int lds_byte(int r, int c) { const int st = (r >> 4) * 2 + (c >> 5), rr = r & 15, cc = c & 31, ob = rr * 64 + cc * 2; return st * 1024 + (ob ^ (((ob >> 9) & 1) << 5)); }
__host__ __device__ __forceinline__ void stage_rc(int b, int& R, int& C) { const int st = b / 1024, sb = b % 1024, swz = sb ^ (((sb >> 9) & 1) << 5); R = (st >> 1) * 16 + swz / 64; C = (st & 1) * 32 + (swz % 64) / 2; }
struct Unit { int pm, pn; };
struct Gemm { const bf16_t* A; const bf16_t* Bt; int M, N, K, lda, a_pn_step; int mrows = 256, moff = 0, ldb = 0; };
struct StaticOrder {
    int nM, nN, nwg, G, c;
    __device__ void init(int M_, int N_, int G_, int c_) { nM = M_ / BM; nN = N_ / BM; nwg = nM * nN; G = G_; c = c_; }
    __device__ void init2(int nM_, int nN_, int G_, int c_) { nM = nM_; nN = nN_; nwg = nM * nN; G = G_; c = c_; }
    __device__ bool next(int i, Unit& u) const {
        const long L = (long)i * G + c; if (L >= nwg) return false;
        int wgid = (int)L; { const int q = nwg / NXCD, r = nwg % NXCD, xcd = wgid % NXCD, off = wgid / NXCD; wgid = (xcd < r ? xcd * (q + 1) : r * (q + 1) + (xcd - r) * q) + off; }
        const int nig = WGM * nN, gid = wgid / nig, fm = gid * WGM, gsz = (nM - fm) < WGM ? (nM - fm) : WGM;
        u.pm = fm + ((wgid % nig) % gsz); u.pn = (wgid % nig) / gsz; return true;
    }
};
struct SingleUnit { int pm, pn; __device__ bool next(int i, Unit& u) const { if (i != 0) return false; u.pm = pm; u.pn = pn; return true; } };
template <class Epi, class Sched>
__device__ __forceinline__ void gemm_phase(LAS unsigned char* lds, const Gemm g, const Sched& S, const Epi& E) {
    int tid = threadIdx.x; asm volatile("" : "+v"(tid));
    const int wid = __builtin_amdgcn_readfirstlane(tid >> 6), lane = tid & 63, wr = wid >> 2, wc = wid & 3, fr = lane & 15, fq = lane >> 4;
    const int K = g.K, nt = K / BK;
    unsigned voffA[2], voffB[2];
#pragma unroll
    for (int i = 0; i < 2; ++i) { int R, C; stage_rc(tid * 16 + i * 8192, R, C); voffA[i] = (unsigned)(R * g.lda + C) * 2u; voffB[i] = (unsigned)(R * (g.ldb ? g.ldb : K) + C) * 2u; }
    const size_t kstep = (size_t)(BK * 2);
    const size_t hstepA = (size_t)HALF * g.lda * 2, hstepB = (size_t)HALF * (g.ldb ? g.ldb : K) * 2;
    const size_t tstepA = (size_t)g.mrows * g.lda * 2, tstepB = 2 * hstepB, apn = (size_t)g.a_pn_step * 2;
    const char* const Abase = (const char*)g.A + (long)g.moff * g.lda * 2;
    const unsigned ldsw = (unsigned)wid * 1024u;
    const int aoff = lds_byte(wr * 64 + fr, fq * 8), boff = lds_byte(wc * 32 + fr, fq * 8);
#define PG8_SA(b, h) (((b) * 2 + (h)) * HTB)
#define PG8_SB(b, h) ((4 + (b) * 2 + (h)) * HTB)
#define PG8_STAGE(bufoff, gbase, voff) do { _Pragma("unroll") for (int _i = 0; _i < 2; ++_i) \
        __builtin_amdgcn_global_load_lds((const unsigned*)((const char*)(gbase) + (voff)[_i]), (LAS unsigned*)(lds + (bufoff) + ldsw + _i * 8192), 16, 0, 0); } while (0)
#define PG8_LDA(dst, b, h) do { _Pragma("unroll") for (int m = 0; m < 4; ++m) _Pragma("unroll") for (int k = 0; k < 2; ++k) dst[m][k] = *(const LAS bf16x8*)(lds + PG8_SA(b, h) + aoff + m * 2048 + k * 1024); } while (0)
#define PG8_LDB(dst, b, h) do { _Pragma("unroll") for (int n = 0; n < 2; ++n) _Pragma("unroll") for (int k = 0; k < 2; ++k) dst[n][k] = *(const LAS bf16x8*)(lds + PG8_SB(b, h) + boff + n * 2048 + k * 1024); } while (0)
#define PG8_MMA(ai, bj, At, Bt) do { __builtin_amdgcn_s_setprio(1); _Pragma("unroll") for (int m = 0; m < 4; ++m) _Pragma("unroll") for (int n = 0; n < 2; ++n) _Pragma("unroll") for (int k = 0; k < 2; ++k) \
        acc[ai][bj][m][n] = __builtin_amdgcn_mfma_f32_16x16x32_bf16(Bt[n][k], At[m][k], acc[ai][bj][m][n], 0, 0, 0); __builtin_amdgcn_s_setprio(0); } while (0)
#define PG8_WAIT_V(n) asm volatile("s_waitcnt vmcnt(" #n ")" ::: "memory")
#define PG8_WAIT_L(n) asm volatile("s_waitcnt lgkmcnt(" #n ")" ::: "memory")
#define PG8_BAR __builtin_amdgcn_s_barrier()
#define PG8_SCHED __builtin_amdgcn_sched_barrier(0)
    Unit cur, nxt; int ui = 0;
    if (!S.next(0, cur)) return;
    f32x4 acc[2][2][4][2];
#pragma unroll
    for (int a = 0; a < 2; ++a)
#pragma unroll
        for (int b = 0; b < 2; ++b)
#pragma unroll
            for (int m = 0; m < 4; ++m)
#pragma unroll
                for (int n = 0; n < 2; ++n) acc[a][b][m][n] = (f32x4){0.f, 0.f, 0.f, 0.f};
    bf16x8 At[4][2], B0[2][2], B1[2][2];
    const char* cA = Abase + (size_t)cur.pm * tstepA + (size_t)cur.pn * apn; const char* cB = (const char*)g.Bt + (size_t)cur.pn * tstepB;
    PG8_STAGE(PG8_SB(0, 0), cB, voffB); PG8_STAGE(PG8_SB(0, 1), cB + hstepB, voffB); PG8_STAGE(PG8_SA(0, 0), cA, voffA); PG8_STAGE(PG8_SA(0, 1), cA + hstepA, voffA);
    if (wr == 1) PG8_BAR;
    PG8_WAIT_V(2); PG8_BAR;
    PG8_STAGE(PG8_SB(1, 0), cB + kstep, voffB); PG8_STAGE(PG8_SA(1, 0), cA + kstep, voffA); PG8_STAGE(PG8_SB(1, 1), cB + hstepB + kstep, voffB);
    PG8_WAIT_V(6); PG8_BAR;
    for (;;) {
        const bool has_next = S.next(ui + 1, nxt);
        const char* nA = has_next ? Abase + (size_t)nxt.pm * tstepA + (size_t)nxt.pn * apn : cA; const char* nB = has_next ? (const char*)g.Bt + (size_t)nxt.pn * tstepB : cB;
#pragma unroll 1
        for (int t = 0; t < nt; t += 2) {
            const bool last = (t == nt - 2);
            const char* a1 = cA + (size_t)(t + 1) * kstep;
            const char* a2 = last ? nA : cA + (size_t)(t + 2) * kstep; const char* b2 = last ? nB : cB + (size_t)(t + 2) * kstep;
            const char* a3 = a2 + kstep; const char* b3 = b2 + kstep;
            PG8_LDB(B0, 0, 0); PG8_LDB(B1, 0, 1); PG8_SCHED; PG8_LDA(At, 0, 0); PG8_STAGE(PG8_SA(1, 1), a1 + hstepA, voffA);
            PG8_WAIT_V(8); PG8_WAIT_L(0); PG8_BAR; PG8_MMA(0, 0, At, B0); PG8_MMA(0, 1, At, B1); PG8_BAR; PG8_SCHED;
            PG8_LDA(At, 0, 1); PG8_STAGE(PG8_SB(0, 0), b2, voffB); PG8_STAGE(PG8_SB(0, 1), b2 + hstepB, voffB); PG8_STAGE(PG8_SA(0, 0), a2, voffA);
            PG8_WAIT_V(8); PG8_WAIT_L(0); PG8_BAR; PG8_MMA(1, 0, At, B0); PG8_MMA(1, 1, At, B1); PG8_BAR; PG8_SCHED;
            PG8_LDB(B0, 1, 0); PG8_LDB(B1, 1, 1); PG8_SCHED; PG8_LDA(At, 1, 0); PG8_STAGE(PG8_SA(0, 1), a2 + hstepA, voffA);
            PG8_WAIT_V(8); PG8_WAIT_L(0); PG8_BAR; PG8_MMA(0, 0, At, B0); PG8_MMA(0, 1, At, B1); PG8_BAR; PG8_SCHED;
            PG8_LDA(At, 1, 1); PG8_STAGE(PG8_SB(1, 0), b3, voffB); PG8_STAGE(PG8_SB(1, 1), b3 + hstepB, voffB); PG8_STAGE(PG8_SA(1, 0), a3, voffA);
            PG8_WAIT_V(8); PG8_WAIT_L(0); PG8_BAR; PG8_MMA(1, 0, At, B0); PG8_MMA(1, 1, At, B1); PG8_BAR; PG8_SCHED;
        }
        if (wr == 0) PG8_BAR;
        E(acc, cur, wr, wc, fr, fq);
        if (!has_next) break;
#pragma unroll
        for (int a = 0; a < 2; ++a)
#pragma unroll
            for (int b = 0; b < 2; ++b)
#pragma unroll
                for (int m = 0; m < 4; ++m)
#pragma unroll
                    for (int n = 0; n < 2; ++n) acc[a][b][m][n] = (f32x4){0.f, 0.f, 0.f, 0.f};
        cur = nxt; cA = nA; cB = nB; ++ui;
        if (wr == 1) PG8_BAR;
    }
    PG8_WAIT_V(0);
    PG8_BAR;
#undef PG8_SA
#undef PG8_SB
#undef PG8_STAGE
#undef PG8_LDA
#undef PG8_LDB
#undef PG8_MMA
#undef PG8_WAIT_V
#undef PG8_WAIT_L
#undef PG8_BAR
#undef PG8_SCHED
}
}
using pg8::Unit;
typedef f32x4 Acc[2][2][4][2];

struct EpiBf16 {
    bf16_t* O; int ldc; const float* ssq; float* tap_p; float* tap_s; int tap_cols;
    __device__ __forceinline__ void operator()(const Acc& acc, const Unit& u, int wr, int wc, int fr, int fq) const {
#pragma unroll
        for (int ai = 0; ai < 2; ++ai)
#pragma unroll
            for (int m = 0; m < 4; ++m) {
                asm volatile("" ::: "memory");
                const int row = u.pm * 256 + ai * 128 + wr * 64 + m * 16 + fr;
                const float rs = ssq ? rstd_row(ssq, row) : 1.f;
                float* trow = nullptr;
                if (tap_cols) {
                    if (row < MP) { const int s = row & (SEQ - 1); if (s >= SEQ - 2) trow = tap_p + (size_t)((row >> 14) * 2 + (s - (SEQ - 2))) * FF; }
                    else { const int t = (row - MP) & 31; if (t >= 30) trow = tap_s + (size_t)(((row - MP) >> 5) * 2 + (t - 30)) * FF; }
                }
#pragma unroll
                for (int bj = 0; bj < 2; ++bj) {
                    const int col0 = u.pn * 256 + bj * 128 + wc * 32 + fq * 8;
                    const f32x4 v0 = acc[ai][bj][m][0] * rs, v1 = acc[ai][bj][m][1] * rs;
                    *(GAS u32x4*)(O + (size_t)row * ldc + col0) = pack8(v0, v1);
                    if (trow && col0 < tap_cols) { *(GAS f32x4*)(trow + col0) = v0; *(GAS f32x4*)(trow + col0 + 4) = v1; }
                }
            }
    }
};
struct EpiF32 {
    float* O; int ldc; const float* ssq;
    __device__ __forceinline__ void operator()(const Acc& acc, const Unit& u, int wr, int wc, int fr, int fq) const {
#pragma unroll
        for (int ai = 0; ai < 2; ++ai)
#pragma unroll
            for (int m = 0; m < 4; ++m) {
                asm volatile("" ::: "memory");
                const int row = u.pm * 256 + ai * 128 + wr * 64 + m * 16 + fr;
                const float rs = rstd_row(ssq, row);
#pragma unroll
                for (int bj = 0; bj < 2; ++bj) {
                    const int col0 = u.pn * 256 + bj * 128 + wc * 32 + fq * 8;
                    *(GAS f32x4*)(O + (size_t)row * ldc + col0) = acc[ai][bj][m][0] * rs;
                    *(GAS f32x4*)(O + (size_t)row * ldc + col0 + 4) = acc[ai][bj][m][1] * rs;
                }
            }
    }
};
struct EpiSlab {
    float* P;
    __device__ __forceinline__ void operator()(const Acc& acc, const Unit& u, int wr, int wc, int fr, int fq) const {
#pragma unroll
        for (int ai = 0; ai < 2; ++ai)
#pragma unroll
            for (int m = 0; m < 4; ++m) {
                const int row_l = ai * 128 + wr * 64 + m * 16 + fr;
#pragma unroll
                for (int bj = 0; bj < 2; ++bj) {
                    const int col_l = bj * 128 + wc * 32 + fq * 8;
                    *(GAS f32x4*)(P + row_l * 256 + col_l) = acc[ai][bj][m][0]; *(GAS f32x4*)(P + row_l * 256 + col_l + 4) = acc[ai][bj][m][1];
                }
            }
    }
};
template <bool F32IN> struct EpiResidT {
    const float* rp; const float* rsm; bf16_t* Xb; float* ssq_out;
    __device__ __forceinline__ void operator()(const Acc& acc, const Unit& u, int wr, int wc, int fr, int fq) const {
#pragma unroll
        for (int ai = 0; ai < 2; ++ai)
#pragma unroll
            for (int m = 0; m < 4; ++m) {
                if ((m & 1) == 0) asm volatile("" ::: "memory");
                const int row = u.pm * 256 + ai * 128 + wr * 64 + m * 16 + fr;
                float ss = 0.f;
#pragma unroll
                for (int bj = 0; bj < 2; ++bj) {
                    const int col0 = u.pn * 256 + bj * 128 + wc * 32 + fq * 8;
                    f32x4 r0, r1;
                    if (F32IN) { const float* rrow = (row < MP) ? rp + (size_t)row * D : rsm + (size_t)(row - MP) * D; r0 = *(const GAS f32x4*)(rrow + col0); r1 = *(const GAS f32x4*)(rrow + col0 + 4); }
                    else { const u32x4 w = *(const GAS u32x4*)(Xb + (size_t)row * D + col0); r0 = (f32x4){bflo(w.x), bfhi(w.x), bflo(w.y), bfhi(w.y)}; r1 = (f32x4){bflo(w.z), bfhi(w.z), bflo(w.w), bfhi(w.w)}; }
                    const f32x4 v0 = r0 + acc[ai][bj][m][0], v1 = r1 + acc[ai][bj][m][1];
                    *(GAS u32x4*)(Xb + (size_t)row * D + col0) = pack8(v0, v1);
                    ss += (v0[0] * v0[0] + v0[1] * v0[1]) + (v0[2] * v0[2] + v0[3] * v0[3]) + (v1[0] * v1[0] + v1[1] * v1[1]) + (v1[2] * v1[2] + v1[3] * v1[3]);
                }
                ss += __shfl_xor(ss, 16); ss += __shfl_xor(ss, 32);
                if (fq == 0) ssq_out[(size_t)row * 16 + u.pn * 4 + wc] = ss;
            }
    }
};

__device__ __forceinline__ float dpp_shr1(float oldv, float x) { return __int_as_float(__builtin_amdgcn_update_dpp(__float_as_int(oldv), __float_as_int(x), 0x111, 0xf, 0xf, false)); }
__device__ __forceinline__ float dpp_shr2(float oldv, float x) { return __int_as_float(__builtin_amdgcn_update_dpp(__float_as_int(oldv), __float_as_int(x), 0x112, 0xf, 0xf, false)); }
__device__ __forceinline__ float dpp_ror1(float x) { return __int_as_float(__builtin_amdgcn_update_dpp(0, __float_as_int(x), 0x121, 0xf, 0xf, false)); }
__device__ __forceinline__ float dpp_ror2(float x) { return __int_as_float(__builtin_amdgcn_update_dpp(0, __float_as_int(x), 0x122, 0xf, 0xf, false)); }
struct EpiFfn {
    bf16_t* ACT; const float* ssq; const float* cw; const float* cb; const float* st; float* tap_p; float* tap_s; LAS unsigned char* slab;
    __device__ __forceinline__ void operator()(Acc& acc, const Unit& u, int wr, int wc, int fr, int fq) const {
        asm volatile("" : "+v"(fr), "+v"(fq), "+s"(wr), "+s"(wc));
        const int r_lo = u.pm * 254 - 2;
        const bool has_start = (r_lo <= 0) || (r_lo <= SEQ && r_lo + 255 >= SEQ) || (r_lo + 255 >= MP);
        LAS float* rl = (LAS float*)(slab + 6144);
        { const int t_ = (wr * 4 + wc) * 64 + fq * 16 + fr, rw = t_ >> 1;
          const float* pp = ssq + (size_t)(r_lo + rw) * 16 + (t_ & 1) * 8;
          const f32x4 a_ = *(const GAS f32x4*)pp, b_ = *(const GAS f32x4*)(pp + 4);
          float sm = ((a_[0] + a_[1]) + (a_[2] + a_[3])) + ((b_[0] + b_[1]) + (b_[2] + b_[3]));
          sm += __shfl_xor(sm, 1);
          if ((t_ & 1) == 0) rl[rw] = rstd_of(sm); }
        asm volatile("s_waitcnt lgkmcnt(0)" ::: "memory"); __builtin_amdgcn_s_barrier(); asm volatile("" ::: "memory");
#pragma unroll
        for (int ai = 0; ai < 2; ++ai)
#pragma unroll
            for (int m = 0; m < 4; ++m) { const float rs = rl[ai * 128 + wr * 64 + m * 16 + fr];
#pragma unroll
                for (int bj = 0; bj < 2; ++bj) { acc[ai][bj][m][0] = acc[ai][bj][m][0] * rs; acc[ai][bj][m][1] = acc[ai][bj][m][1] * rs; } }
        LAS f32x4* sl = (LAS f32x4*)slab;
        if (fr >= 14) {
#pragma unroll
            for (int ai = 0; ai < 2; ++ai)
#pragma unroll
                for (int bj = 0; bj < 2; ++bj) sl[((((ai * 2 + wr) * 4 + wc) * 2 + bj) * 2 + (fr - 14)) * 4 + fq] = acc[ai][bj][3][0];
        }
        asm volatile("s_waitcnt lgkmcnt(0)" ::: "memory"); __builtin_amdgcn_s_barrier(); asm volatile("" ::: "memory");
#pragma unroll
        for (int bj = 0; bj < 2; ++bj) {
            const int cbase = u.pn * 128 + bj * 64 + wc * 16 + fq * 4;
            u32x2 wq0, wq1, wq2, wqb;
            { const f32x4 t0 = *(const GAS f32x4*)(cw + cbase), t1 = *(const GAS f32x4*)(cw + FF + cbase), t2 = *(const GAS f32x4*)(cw + 2 * FF + cbase), tb = *(const GAS f32x4*)(cb + cbase);
              wq0 = pack4(t0); wq1 = pack4(t1); wq2 = pack4(t2); wqb = pack4(tb); }
#pragma unroll
            for (int ai = 0; ai < 2; ++ai) {
                asm volatile("" ::: "memory");
                f32x4 H = {0.f, 0.f, 0.f, 0.f};
                if ((ai | wr) != 0 && fr >= 14) { const int sai = wr ? ai : ai - 1, swr = wr ? 0 : 1; H = sl[((((sai * 2 + swr) * 4 + wc) * 2 + bj) * 2 + (fr - 14)) * 4 + fq]; }
                f32x4 uprev = H;
#pragma unroll
                for (int m = 0; m < 4; ++m) {
                    asm volatile("" ::: "memory");
                    const int row_l = ai * 128 + wr * 64 + m * 16 + fr, grow = r_lo + row_l;
                    const f32x4 uu = acc[ai][bj][m][0], up = acc[ai][bj][m][1];
                    f32x4 p1, p2;
#pragma unroll
                    for (int i = 0; i < 4; ++i) { p1[i] = dpp_shr1(dpp_ror1(uprev[i]), uu[i]); p2[i] = dpp_shr2(dpp_ror2(uprev[i]), uu[i]); }
                    if (has_start) {
                        const bool samp = grow >= MP;
                        const int sp = samp ? ((grow - MP) & 31) : (grow & (SEQ - 1));
                        if (grow >= 0 && grow < M && sp < 2) {
                            f32x4 h0 = {0.f, 0.f, 0.f, 0.f}, h1 = {0.f, 0.f, 0.f, 0.f};
                            if (samp) { const int sbb = (grow - MP) >> 5; h0 = *(const GAS f32x4*)(st + (size_t)(sbb * 2 + 0) * FF + cbase); h1 = *(const GAS f32x4*)(st + (size_t)(sbb * 2 + 1) * FF + cbase); }
                            if (sp == 0) { p1 = h1; p2 = h0; } else { p2 = h1; }
                        }
                    }
                    f32x4 gs = (f32x4){bflo(wqb.x), bfhi(wqb.x), bflo(wqb.y), bfhi(wqb.y)} + (f32x4){bflo(wq2.x), bfhi(wq2.x), bflo(wq2.y), bfhi(wq2.y)} * uu;
                    gs += (f32x4){bflo(wq1.x), bfhi(wq1.x), bflo(wq1.y), bfhi(wq1.y)} * p1;
                    gs += (f32x4){bflo(wq0.x), bfhi(wq0.x), bflo(wq0.y), bfhi(wq0.y)} * p2;
                    f32x4 act;
#pragma unroll
                    for (int i = 0; i < 4; ++i) act[i] = gs[i] * __builtin_amdgcn_rcpf(1.f + __expf(-gs[i])) * up[i];
                    if (row_l >= 2 && grow < M) {
                        *(GAS u32x2*)(ACT + (size_t)grow * FF + cbase) = pack4(act);
                        float* trow = nullptr;
                        if (grow < MP) { const int s_ = grow & (SEQ - 1); if (s_ >= SEQ - 2) trow = tap_p + (size_t)((grow >> 14) * 2 + (s_ - (SEQ - 2))) * FF; }
                        else { const int t_ = (grow - MP) & 31; if (t_ >= 30) trow = tap_s + (size_t)(((grow - MP) >> 5) * 2 + (t_ - 30)) * FF; }
                        if (trow) *(GAS f32x4*)(trow + cbase) = uu;
                    }
                    uprev = uu;
                }
            }
        }
    }
};
struct EpiQKV {
    const float* ssq; const float* rope; bf16_t* Q; bf16_t* Kb; bf16_t* Vb; bf16_t* Ks; bf16_t* Vs; float* okp; float* ovp; float* oks; float* ovs;
    __device__ __forceinline__ void operator()(const Acc& acc, const Unit& u, int wr, int wc, int fr, int fq) const {
        const int part = u.pn >> 2;
#pragma unroll
        for (int ai = 0; ai < 2; ++ai)
#pragma unroll
            for (int m = 0; m < 4; ++m) {
                asm volatile("" ::: "memory");
                const int row = u.pm * 256 + ai * 128 + wr * 64 + m * 16 + fr;
                const float rs = rstd_row(ssq, row);
                const bool samp = row >= MP;
                const int sr_ = row - MP, sbb = sr_ >> 5, tt = sr_ & 31;
                const int pos = samp ? PAST + tt : (row & (SEQ - 1));
                const size_t crow = (size_t)(sbb * NKSP + PAST + tt);
                if (part < 2) {
                    const int w = wc & 1, d0 = 16 * w + 4 * fq;
                    const f32x4 cs = *(const GAS f32x4*)(rope + (size_t)pos * 64 + d0), sn = *(const GAS f32x4*)(rope + (size_t)pos * 64 + 32 + d0);
#pragma unroll
                    for (int bj = 0; bj < 2; ++bj) {
                        const int lc = ((u.pn & 3) * 256 + bj * 128 + (wc >> 1) * 64) + d0;
                        const f32x4 x1 = acc[ai][bj][m][0] * rs, x2 = acc[ai][bj][m][1] * rs;
                        const f32x4 y1 = x1 * cs - x2 * sn, y2 = x2 * cs + x1 * sn;
                        if (part == 0) {
                            *(GAS u32x2*)(Q + (size_t)row * D + lc) = pack4(y1); *(GAS u32x2*)(Q + (size_t)row * D + lc + 32) = pack4(y2);
                        } else if (!samp) {
                            *(GAS u32x2*)(Kb + (size_t)row * D + lc) = pack4(y1); *(GAS u32x2*)(Kb + (size_t)row * D + lc + 32) = pack4(y2);
                            *(GAS f32x4*)(okp + (size_t)row * D + lc) = y1; *(GAS f32x4*)(okp + (size_t)row * D + lc + 32) = y2;
                        } else {
                            *(GAS u32x2*)(Ks + crow * D + lc) = pack4(y1); *(GAS u32x2*)(Ks + crow * D + lc + 32) = pack4(y2);
                            *(GAS f32x4*)(oks + (size_t)sr_ * D + lc) = y1; *(GAS f32x4*)(oks + (size_t)sr_ * D + lc + 32) = y2;
                        }
                    }
                } else {
#pragma unroll
                    for (int bj = 0; bj < 2; ++bj) {
                        const int lc = (u.pn & 3) * 256 + bj * 128 + wc * 32 + fq * 8;
                        const f32x4 v0 = acc[ai][bj][m][0] * rs, v1 = acc[ai][bj][m][1] * rs;
                        if (!samp) {
                            *(GAS u32x4*)(Vb + (size_t)row * D + lc) = pack8(v0, v1);
                            *(GAS f32x4*)(ovp + (size_t)row * D + lc) = v0; *(GAS f32x4*)(ovp + (size_t)row * D + lc + 4) = v1;
                        } else {
                            *(GAS u32x4*)(Vs + crow * D + lc) = pack8(v0, v1);
                            *(GAS f32x4*)(ovs + (size_t)sr_ * D + lc) = v0; *(GAS f32x4*)(ovs + (size_t)sr_ * D + lc + 4) = v1;
                        }
                    }
                }
            }
    }
};
struct EpiUQ {
    const float* rope; bf16_t* QB;
    __device__ __forceinline__ void operator()(const Acc& acc, const Unit& u, int wr, int wc, int fr, int fq) const {
#pragma unroll
        for (int ai = 0; ai < 2; ++ai)
#pragma unroll
            for (int m = 0; m < 4; ++m) {
                asm volatile("" ::: "memory");
                const int row = u.pm * 256 + ai * 128 + wr * 64 + m * 16 + fr;
                const int pos = row >= MP ? PAST + ((row - MP) & 31) : (row & (SEQ - 1));
#pragma unroll
                for (int bj = 0; bj < 2; ++bj) {
                    const int G = u.pn * 4 + bj * 2 + (wc >> 1);
                    if (G % 3 == 2) {
                        const int d0 = 16 * (wc & 1) + 4 * fq, lc = G * 64 + d0;
                        const f32x4 cs = *(const GAS f32x4*)(rope + (size_t)pos * 64 + d0), sn = *(const GAS f32x4*)(rope + (size_t)pos * 64 + 32 + d0);
                        const f32x4 x1 = acc[ai][bj][m][0], x2 = acc[ai][bj][m][1];
                        *(GAS u32x2*)(QB + (size_t)row * 1536 + lc) = pack4(x1 * cs - x2 * sn); *(GAS u32x2*)(QB + (size_t)row * 1536 + lc + 32) = pack4(x2 * cs + x1 * sn);
                    } else {
                        const int lc = u.pn * 256 + bj * 128 + wc * 32 + fq * 8;
                        *(GAS u32x4*)(QB + (size_t)row * 1536 + lc) = pack8(acc[ai][bj][m][0], acc[ai][bj][m][1]);
                    }
                }
            }
    }
};
struct EpiExpand {
    bf16_t* KN; bf16_t* VB; bf16_t* KsN; bf16_t* VsB;
    __device__ __forceinline__ void operator()(const Acc& acc, const Unit& u, int wr, int wc, int fr, int fq) const {
        const bool isk = u.pn < 4;
        bf16_t* const pbase = isk ? KN : VB; bf16_t* const sbase = isk ? KsN : VsB;
#pragma unroll
        for (int ai = 0; ai < 2; ++ai)
#pragma unroll
            for (int m = 0; m < 4; ++m) {
                asm volatile("" ::: "memory");
                const int row = u.pm * 256 + ai * 128 + wr * 64 + m * 16 + fr;
                int cr = row;
                if (row >= M) { const int s = row - M; cr = (s >> 10) * NKSP + (s & 1023); }
                else if (row >= MP) { const int s = row - MP; cr = (s >> 5) * NKSP + PAST + (s & 31); }
                bf16_t* dst = (row < MP ? pbase : sbase) + (size_t)cr * D;
#pragma unroll
                for (int bj = 0; bj < 2; ++bj) {
                    const int lc = (u.pn & 3) * 256 + bj * 128 + wc * 32 + fq * 8;
                    *(GAS u32x4*)(dst + lc) = pack8(acc[ai][bj][m][0], acc[ai][bj][m][1]);
                }
            }
    }
};

__device__ __forceinline__ void prep_w(LAS float* tile, const float* __restrict__ W, int ldw, int K, int nsrc, bf16_t* __restrict__ Bt, int nrows,
                                       int ropemode, int ropeG, const float* __restrict__ ks, int kper, float kmul, const float* __restrict__ ns, int rank = -1, int nwork = 0) {
    if (rank < 0) { rank = blockIdx.x; nwork = gridDim.x; }
    int tid = threadIdx.x; asm volatile("" : "+v"(tid));
    const int nkt = K / 64, nnt = nrows / 64;
    for (int t = rank; t < nkt * nnt; t += nwork) {
        const int kt = t % nkt, ntl = t / nkt, k0 = kt * 64, n0 = ntl * 64;
        {
            const int kk = tid >> 3, c8 = (tid & 7) * 8;
            f32x4 a = {0.f, 0.f, 0.f, 0.f}, b = {0.f, 0.f, 0.f, 0.f};
            if (n0 < nsrc) {
                a = *(const GAS f32x4*)(W + (size_t)(k0 + kk) * ldw + n0 + c8); b = *(const GAS f32x4*)(W + (size_t)(k0 + kk) * ldw + n0 + c8 + 4);
                float sc = kmul; if (ks) sc *= ks[(k0 + kk) % kper];
                a = a * sc; b = b * sc;
                if (ns) { a = a * *(const GAS f32x4*)(ns + n0 + c8); b = b * *(const GAS f32x4*)(ns + n0 + c8 + 4); }
            }
            LAS float* tp = tile + kk * 65 + c8;
            tp[0] = a[0]; tp[1] = a[1]; tp[2] = a[2]; tp[3] = a[3]; tp[4] = b[0]; tp[5] = b[1]; tp[6] = b[2]; tp[7] = b[3];
        }
        __syncthreads();
        {
            const int nl = tid >> 3, kc = (tid & 7) * 8, G = n0 >> 6;
            const bool rp = (ropemode == 1) ? (G < ropeG) : (ropemode == 3 ? (G % 3 == 2) : false);
            const int hi32 = nl >> 5, n = (nl >> 4) & 1, fq = (nl >> 2) & 3, i = nl & 3;
            const int sl = rp ? (32 * n + 16 * hi32 + 4 * fq + i) : (32 * hi32 + 8 * fq + 4 * n + i);
            float v[8];
#pragma unroll
            for (int j = 0; j < 8; ++j) v[j] = tile[(kc + j) * 65 + sl];
            u32x4 w; w.x = cvt_pk(v[0], v[1]); w.y = cvt_pk(v[2], v[3]); w.z = cvt_pk(v[4], v[5]); w.w = cvt_pk(v[6], v[7]);
            *(GAS u32x4*)(Bt + (size_t)(n0 + nl) * K + k0 + kc) = w;
        }
        __syncthreads();
    }
}


__device__ __forceinline__ void prep_gu(LAS float* tile, const float* __restrict__ Wg, const float* __restrict__ Wu, bf16_t* __restrict__ Bt, const float* __restrict__ ks, int rank = -1, int nwork = 0) {
    if (rank < 0) { rank = blockIdx.x; nwork = gridDim.x; }
    int tid = threadIdx.x; asm volatile("" : "+v"(tid));
    constexpr int K = D, nkt = K / 64, nnt = 2 * FF / 64;
    for (int t = rank; t < nkt * nnt; t += nwork) {
        const int kt = t % nkt, ntl = t / nkt, k0 = kt * 64, n0 = ntl * 64, cb0 = (n0 >> 5) * 16;
        {
            const int kk = tid >> 3, c8 = (tid & 7) * 8;
            const float* src = (c8 < 32 ? Wg + cb0 + c8 : Wu + cb0 + (c8 - 32)) + (size_t)(k0 + kk) * FF;
            f32x4 a = *(const GAS f32x4*)src, b = *(const GAS f32x4*)(src + 4);
            const float sc = ks[k0 + kk]; a = a * sc; b = b * sc;
            LAS float* tp = tile + kk * 65 + c8;
            tp[0] = a[0]; tp[1] = a[1]; tp[2] = a[2]; tp[3] = a[3]; tp[4] = b[0]; tp[5] = b[1]; tp[6] = b[2]; tp[7] = b[3];
        }
        __syncthreads();
        {
            const int nl = tid >> 3, kc = (tid & 7) * 8;
            const int sl = ((nl >> 4) & 1) * 32 + (nl >> 5) * 16 + (nl & 15);
            float v[8];
#pragma unroll
            for (int j = 0; j < 8; ++j) v[j] = tile[(kc + j) * 65 + sl];
            u32x4 w; w.x = cvt_pk(v[0], v[1]); w.y = cvt_pk(v[2], v[3]); w.z = cvt_pk(v[4], v[5]); w.w = cvt_pk(v[6], v[7]);
            *(GAS u32x4*)(Bt + (size_t)(n0 + nl) * K + k0 + kc) = w;
        }
        __syncthreads();
    }
}
__device__ __forceinline__ int crow(int r, int hi) { return (r & 3) + 8 * (r >> 2) + 4 * hi; }
#define SBAR() __builtin_amdgcn_sched_barrier(0)
__device__ __forceinline__ void partialSM(f32x16& p0, f32x16& p1, float& m_reg, float& mn, float& alpha, const float C, const float thr_raw) {
    float pmax = p0[0];
#pragma unroll
    for (int r = 1; r < 16; ++r) pmax = fmaxf(pmax, p0[r]);
#pragma unroll
    for (int r = 0; r < 16; ++r) pmax = fmaxf(pmax, p1[r]);
    { auto rr = __builtin_amdgcn_permlane32_swap(__float_as_uint(pmax), __float_as_uint(pmax), false, false);
      pmax = fmaxf(__uint_as_float(rr[0]), __uint_as_float(rr[1])); }
    if (__builtin_expect(__all(pmax - m_reg <= thr_raw), 1)) { mn = m_reg; alpha = 1.f; }
    else { mn = fmaxf(m_reg, pmax); alpha = __builtin_amdgcn_exp2f((m_reg - mn) * C); m_reg = mn; }
    const float mnC = -mn * C;
#pragma unroll
    for (int r = 0; r < 16; ++r) p0[r] = __builtin_amdgcn_exp2f(fmaf(p0[r], C, mnC));
#pragma unroll
    for (int r = 0; r < 16; ++r) p1[r] = __builtin_amdgcn_exp2f(fmaf(p1[r], C, mnC));
}
__device__ __forceinline__ void finishSM(f32x16& p0, f32x16& p1, float alpha, float& l_reg, bf16x8& pa0, bf16x8& pa1, bf16x8& pa2, bf16x8& pa3) {
    float ps = 0;
#pragma unroll
    for (int r = 0; r < 16; ++r) ps += p0[r];
#pragma unroll
    for (int r = 0; r < 16; ++r) ps += p1[r];
    { auto rr = __builtin_amdgcn_permlane32_swap(__float_as_uint(ps), __float_as_uint(ps), false, false);
      ps = __uint_as_float(rr[0]) + __uint_as_float(rr[1]); }
    l_reg = l_reg * alpha + ps;
#define PK4(P, BASE, OUT) do { unsigned a0 = cvt_pk(P[BASE + 0], P[BASE + 1]), a1 = cvt_pk(P[BASE + 2], P[BASE + 3]);   \
    unsigned b0 = cvt_pk(P[BASE + 4], P[BASE + 5]), b1 = cvt_pk(P[BASE + 6], P[BASE + 7]);                              \
    auto r0 = __builtin_amdgcn_permlane32_swap(a0, b0, false, false); auto r1 = __builtin_amdgcn_permlane32_swap(a1, b1, false, false); \
    u32x4 w = {r0[0], r1[0], r0[1], r1[1]}; OUT = *reinterpret_cast<bf16x8*>(&w); } while (0)
    PK4(p0, 0, pa0); PK4(p0, 8, pa1); PK4(p1, 0, pa2); PK4(p1, 8, pa3);
#undef PK4
}
__device__ __forceinline__ int v_st(int k, int c) { const int kk = (k & ~0xC) | ((k & 4) << 1) | ((k & 8) >> 1); return ((kk >> 3) * 4 + (c >> 5)) * 512 + ((kk & 7) * 32 + (c & 31)) * 2; }
__device__ __forceinline__ int v_rd_base(int lane) { return ((lane & 3) << 3) | (((lane >> 2) & 3) << 6) | (((lane >> 4) & 1) << 5) | (((lane >> 5) & 1) << 8); }
constexpr int v_rd_off(int d0, int ks, int half) { return d0 * 512 + ks * 4096 + half * 2048; }
template <int OFF> __device__ __forceinline__ s16x4 tr_read(unsigned vb) {
    s16x4 r; asm volatile("ds_read_b64_tr_b16 %0, %1 offset:%2" : "=&v"(r) : "v"(vb), "i"(OFF) : "memory"); return r;
}
template <int D0> __device__ __forceinline__ void pv_one(f32x16& od, unsigned vb, bf16x8 pa0, bf16x8 pa1, bf16x8 pa2, bf16x8 pa3) {
    const s16x4 l0 = tr_read<v_rd_off(D0, 0, 0)>(vb), h0 = tr_read<v_rd_off(D0, 0, 1)>(vb), l1 = tr_read<v_rd_off(D0, 1, 0)>(vb), h1 = tr_read<v_rd_off(D0, 1, 1)>(vb);
    const s16x4 l2 = tr_read<v_rd_off(D0, 2, 0)>(vb), h2 = tr_read<v_rd_off(D0, 2, 1)>(vb), l3 = tr_read<v_rd_off(D0, 3, 0)>(vb), h3 = tr_read<v_rd_off(D0, 3, 1)>(vb);
    asm volatile("s_waitcnt lgkmcnt(0)" ::: "memory"); SBAR();
#define PKV(L, H) (bf16x8){L[0], L[1], L[2], L[3], H[0], H[1], H[2], H[3]}
    od = __builtin_amdgcn_mfma_f32_32x32x16_bf16(pa0, PKV(l0, h0), od, 0, 0, 0);
    od = __builtin_amdgcn_mfma_f32_32x32x16_bf16(pa1, PKV(l1, h1), od, 0, 0, 0);
    od = __builtin_amdgcn_mfma_f32_32x32x16_bf16(pa2, PKV(l2, h2), od, 0, 0, 0);
    od = __builtin_amdgcn_mfma_f32_32x32x16_bf16(pa3, PKV(l3, h3), od, 0, 0, 0);
#undef PKV
}

__device__ __forceinline__ void partialSM2(f32x16& p0, f32x16& p1, float& m_reg, float& alpha, const float C, const float thr_raw) {
    float pmax = p0[0];
#pragma unroll
    for (int r = 1; r < 16; ++r) pmax = fmaxf(pmax, p0[r]);
#pragma unroll
    for (int r = 0; r < 16; ++r) pmax = fmaxf(pmax, p1[r]);
    { auto rr = __builtin_amdgcn_permlane32_swap(__float_as_uint(pmax), __float_as_uint(pmax), false, false);
      pmax = fmaxf(__uint_as_float(rr[0]), __uint_as_float(rr[1])); }
    float mn;
    if (__builtin_expect(__all(pmax - m_reg <= thr_raw), 1)) { mn = m_reg; alpha = 1.f; }
    else { mn = fmaxf(m_reg, pmax); alpha = __builtin_amdgcn_exp2f((m_reg - mn) * C); m_reg = mn; }
    const float mnC = -mn * C;
    typedef float f32x2 __attribute__((ext_vector_type(2)));
    const f32x2 C2 = {C, C}, M2 = {mnC, mnC};
#pragma unroll
    for (int r = 0; r < 16; r += 2) { f32x2 t = {p0[r], p0[r + 1]}; t = __builtin_elementwise_fma(t, C2, M2); p0[r] = t.x; p0[r + 1] = t.y; }
#pragma unroll
    for (int r = 0; r < 16; r += 2) { f32x2 t = {p1[r], p1[r + 1]}; t = __builtin_elementwise_fma(t, C2, M2); p1[r] = t.x; p1[r + 1] = t.y; }
#pragma unroll
    for (int r = 0; r < 16; ++r) p0[r] = __builtin_amdgcn_exp2f(p0[r]);
}
__device__ __forceinline__ void finishSM2(f32x16& p0, f32x16& p1, float alpha, float& l_reg, bf16x8& pa0, bf16x8& pa1, bf16x8& pa2, bf16x8& pa3) {
#pragma unroll
    for (int r = 0; r < 16; ++r) p1[r] = __builtin_amdgcn_exp2f(p1[r]);
    typedef float f32x2 __attribute__((ext_vector_type(2)));
    f32x2 s2 = {0.f, 0.f};
#pragma unroll
    for (int r = 0; r < 16; r += 2) { const f32x2 t = {p0[r], p0[r + 1]}; s2 += t; }
#pragma unroll
    for (int r = 0; r < 16; r += 2) { const f32x2 t = {p1[r], p1[r + 1]}; s2 += t; }
    float ps = s2.x + s2.y;
    { auto rr = __builtin_amdgcn_permlane32_swap(__float_as_uint(ps), __float_as_uint(ps), false, false);
      ps = __uint_as_float(rr[0]) + __uint_as_float(rr[1]); }
    l_reg = l_reg * alpha + ps;
#define PK4(P, BASE, OUT) do { unsigned a0 = cvt_pk(P[BASE + 0], P[BASE + 1]), a1 = cvt_pk(P[BASE + 2], P[BASE + 3]);   \
    unsigned b0 = cvt_pk(P[BASE + 4], P[BASE + 5]), b1 = cvt_pk(P[BASE + 6], P[BASE + 7]);                              \
    auto r0 = __builtin_amdgcn_permlane32_swap(a0, b0, false, false); auto r1 = __builtin_amdgcn_permlane32_swap(a1, b1, false, false); \
    u32x4 w = {r0[0], r1[0], r0[1], r1[1]}; OUT = *reinterpret_cast<bf16x8*>(&w); } while (0)
    PK4(p0, 0, pa0); PK4(p0, 8, pa1); PK4(p1, 0, pa2); PK4(p1, 8, pa3);
#undef PK4
}
template <int DQK>
__device__ __forceinline__ void attn_unit(const bf16_t* __restrict__ Qp, int ldq, const bf16_t* __restrict__ Kp, int ldk, const bf16_t* __restrict__ Kr,
                                          const bf16_t* __restrict__ Vp, int ldv, const int NT, const int nkw, LAS unsigned char* lds, f32x16 (&o)[4], float scale) {
    constexpr int ND = DQK / 16, KCH = DQK / 64, KRB = DQK * 2, KTB = 64 * KRB, CPR = DQK / 8;
    int tid = threadIdx.x; asm volatile("" : "+v"(tid));
    const int wid = tid >> 6, lane = tid & 63, r32 = lane & 31, hi = lane >> 5;
    LAS unsigned char* Vl = lds; LAS unsigned char* Kl = lds + 32768; LAS float* wsc = (LAS float*)(lds + 32768 + 49152) + wid * 64;
    const float C = scale * 1.4426950408889634f, thr_raw = 8.0f / scale;
    bf16x8 qr[ND];
    {
        const bf16_t* qw = Qp + (size_t)(wid * 32 + r32) * ldq + hi * 8;
#pragma unroll
        for (int d0 = 0; d0 < ND; ++d0) qr[d0] = *(const GAS bf16x8*)(qw + d0 * 16);
    }
    const bf16_t* kp[KCH]; unsigned kl[KCH]; int kst[KCH];
#pragma unroll
    for (int i = 0; i < KCH; ++i) {
        const int q = tid + i * 512, row = q / CPR, cc = q % CPR;
        if (DQK == 192 && cc >= 16) { kp[i] = Kr + (size_t)row * 64 + (cc - 16) * 8; kst[i] = 64 * 64; }
        else { kp[i] = Kp + (size_t)row * ldk + cc * 8; kst[i] = 64 * ldk; }
        kl[i] = (unsigned)(row * KRB + ((cc ^ ((row >> 1) & 7)) << 4));
    }
    const int sr = tid >> 4, sc = (tid & 15) * 8;
    const bf16_t* vp0 = Vp + (size_t)sr * ldv + sc; const bf16_t* vp1 = vp0 + (size_t)32 * ldv; const int vstp = 64 * ldv;
    const int vs0 = v_st(sr, sc), vs1 = v_st(32 + sr, sc);
    const unsigned vbase = (unsigned)(uintptr_t)Vl + (unsigned)v_rd_base(lane);
    const unsigned sw = (unsigned)((r32 >> 1) & 7);
    u32x4 kreg[KCH], vreg0, vreg1;
#define A_SLOAD() do { _Pragma("unroll") for (int i = 0; i < KCH; ++i) { kreg[i] = *(const GAS u32x4*)kp[i]; kp[i] += kst[i]; } \
        vreg0 = *(const GAS u32x4*)vp0; vreg1 = *(const GAS u32x4*)vp1; vp0 += vstp; vp1 += vstp; } while (0)
#define A_SWRITE(b) do { LAS unsigned char* Kn_ = Kl + (b) * KTB; LAS unsigned char* Vn_ = Vl + (b) * 16384; \
        _Pragma("unroll") for (int i = 0; i < KCH; ++i) *(LAS u32x4*)(Kn_ + kl[i]) = kreg[i]; \
        *(LAS u32x4*)(Vn_ + vs0) = vreg0; *(LAS u32x4*)(Vn_ + vs1) = vreg1; } while (0)
#define A_QKT(P0, P1, b) do { LAS unsigned char* Kc_ = Kl + (b) * KTB; \
        _Pragma("unroll") for (int r = 0; r < 16; ++r) { P0[r] = 0.f; P1[r] = 0.f; } \
        _Pragma("unroll") for (int d0 = 0; d0 < ND; ++d0) { const unsigned off_ = (unsigned)(r32 * KRB) + ((((unsigned)(d0 * 2 + hi)) ^ sw) << 4); \
            const bf16x8 b0_ = *(const LAS bf16x8*)(Kc_ + off_); const bf16x8 b1_ = *(const LAS bf16x8*)(Kc_ + off_ + 32 * KRB); \
            P0 = __builtin_amdgcn_mfma_f32_32x32x16_bf16(b0_, qr[d0], P0, 0, 0, 0); P1 = __builtin_amdgcn_mfma_f32_32x32x16_bf16(b1_, qr[d0], P1, 0, 0, 0); } } while (0)
#define A_MASK(P0, P1, j) do { if (((j) + 1) * 64 > nkw) { asm volatile("" ::: "memory"); _Pragma("unroll") for (int r = 0; r < 16; ++r) { const int kb_ = (j) * 64 + crow(r, hi); \
        if (kb_ >= nkw) P0[r] = -1e30f; if (kb_ + 32 >= nkw) P1[r] = -1e30f; } } } while (0)
#define A_RESC(al) do { if (__any((al) < 1.f)) { if (hi == 0) wsc[r32] = (al); asm volatile("s_waitcnt lgkmcnt(0)" ::: "memory"); \
        _Pragma("unroll") for (int r = 0; r < 16; ++r) { const float al_ = wsc[crow(r, hi)]; _Pragma("unroll") for (int d = 0; d < 4; ++d) o[d][r] *= al_; } } } while (0)
#define A_PV(b) do { const unsigned vb_ = vbase + (unsigned)((b) * 16384); \
        pv_one<0>(o[0], vb_, pa0, pa1, pa2, pa3); pv_one<1>(o[1], vb_, pa0, pa1, pa2, pa3); pv_one<2>(o[2], vb_, pa0, pa1, pa2, pa3); pv_one<3>(o[3], vb_, pa0, pa1, pa2, pa3); } while (0)
    float m_reg = -1e30f, l_reg = 0.f;
#pragma unroll
    for (int d = 0; d < 4; ++d)
#pragma unroll
        for (int r = 0; r < 16; ++r) o[d][r] = 0.f;
    f32x16 pA0, pA1, pB0, pB1; float alA, alB; bf16x8 pa0, pa1, pa2, pa3;
    A_SLOAD(); A_SWRITE(0); __syncthreads();
    A_QKT(pA0, pA1, 0); A_MASK(pA0, pA1, 0); partialSM2(pA0, pA1, m_reg, alA, C, thr_raw);
    A_SLOAD(); A_SWRITE(1); __syncthreads();
#pragma unroll 1
    for (int j = 1; j + 1 < NT; j += 2) {
        SBAR(); A_QKT(pB0, pB1, 1);
        finishSM2(pA0, pA1, alA, l_reg, pa0, pa1, pa2, pa3); SBAR();
        A_SLOAD(); SBAR();
        A_PV(0); A_MASK(pB0, pB1, j); partialSM2(pB0, pB1, m_reg, alB, C, thr_raw);
        __syncthreads(); A_SWRITE(0);
        A_RESC(alB); __syncthreads();
        SBAR(); A_QKT(pA0, pA1, 0);
        finishSM2(pB0, pB1, alB, l_reg, pa0, pa1, pa2, pa3); SBAR();
        A_SLOAD(); SBAR();
        A_PV(1); A_MASK(pA0, pA1, j + 1); partialSM2(pA0, pA1, m_reg, alA, C, thr_raw);
        __syncthreads(); A_SWRITE(1);
        A_RESC(alA); __syncthreads();
    }
    SBAR(); A_QKT(pB0, pB1, 1);
    finishSM2(pA0, pA1, alA, l_reg, pa0, pa1, pa2, pa3); SBAR();
    A_PV(0); A_MASK(pB0, pB1, NT - 1); partialSM2(pB0, pB1, m_reg, alB, C, thr_raw);
    A_RESC(alB);
    finishSM2(pB0, pB1, alB, l_reg, pa0, pa1, pa2, pa3); SBAR();
    A_PV(1);
    __syncthreads();
    {
        if (hi == 0) wsc[32 + r32] = l_reg;
        asm volatile("s_waitcnt lgkmcnt(0)" ::: "memory");
#pragma unroll
        for (int r = 0; r < 16; ++r) { const float rl = __builtin_amdgcn_rcpf(wsc[32 + crow(r, hi)]);
#pragma unroll
            for (int d = 0; d < 4; ++d) o[d][r] *= rl; }
    }
#undef A_SLOAD
#undef A_SWRITE
#undef A_QKT
#undef A_MASK
#undef A_RESC
#undef A_PV
}

template <int DQK>
__device__ __forceinline__ void attn_unit_np(const bf16_t* __restrict__ Qp, int ldq, const bf16_t* __restrict__ Kp, int ldk, const bf16_t* __restrict__ Kr,
                                          const bf16_t* __restrict__ Vp, int ldv, int NT, int lim, int nkeys, LAS unsigned char* lds, f32x16 (&o)[4], float scale) {
    constexpr int ND = DQK / 16, KCH = DQK / 64, KRB = DQK * 2, KTB = 64 * KRB, CPR = DQK / 8;
    int tid = threadIdx.x; asm volatile("" : "+v"(tid));
    const int wid = tid >> 6, lane = tid & 63, r32 = lane & 31, hi = lane >> 5;
    LAS unsigned char* Vl = lds; LAS unsigned char* Kl = lds + 32768; LAS float* wsc = (LAS float*)(lds + 32768 + 49152) + wid * 64;
    const float C = scale * 1.4426950408889634f, thr_raw = 8.0f / scale;
    bf16x8 qr[ND];
    if (lim >= 0) {
        const bf16_t* qw = Qp + (size_t)(wid * 32 + r32) * ldq + hi * 8;
#pragma unroll
        for (int d0 = 0; d0 < ND; ++d0) qr[d0] = *(const GAS bf16x8*)(qw + d0 * 16);
    } else {
#pragma unroll
        for (int d0 = 0; d0 < ND; ++d0) qr[d0] = (bf16x8){0, 0, 0, 0, 0, 0, 0, 0};
    }
    const bf16_t* kp[KCH]; unsigned kl[KCH]; int kst[KCH];
#pragma unroll
    for (int i = 0; i < KCH; ++i) {
        const int q = tid + i * 512, row = q / CPR, cc = q % CPR;
        if (DQK == 192 && cc >= 16) { kp[i] = Kr + (size_t)row * 64 + (cc - 16) * 8; kst[i] = 64 * 64; }
        else { kp[i] = Kp + (size_t)row * ldk + cc * 8; kst[i] = 64 * ldk; }
        kl[i] = (unsigned)(row * KRB + ((cc ^ ((row >> 1) & 7)) << 4));
    }
    const int sr = tid >> 4, sc = (tid & 15) * 8;
    const bf16_t* vp0 = Vp + (size_t)sr * ldv + sc; const bf16_t* vp1 = vp0 + (size_t)32 * ldv; const int vstp = 64 * ldv;
    const int vs0 = v_st(sr, sc), vs1 = v_st(32 + sr, sc);
    const unsigned vbase = (unsigned)(uintptr_t)Vl + (unsigned)v_rd_base(lane);
    u32x4 kreg[KCH], vreg0, vreg1;
#pragma unroll
    for (int i = 0; i < KCH; ++i) { kreg[i] = *(const GAS u32x4*)kp[i]; kp[i] += kst[i]; }
    vreg0 = *(const GAS u32x4*)vp0; vreg1 = *(const GAS u32x4*)vp1; vp0 += vstp; vp1 += vstp;
#pragma unroll
    for (int i = 0; i < KCH; ++i) *(LAS u32x4*)(Kl + kl[i]) = kreg[i];
    *(LAS u32x4*)(Vl + vs0) = vreg0; *(LAS u32x4*)(Vl + vs1) = vreg1;
    __syncthreads();
    float m_reg = -1e30f, l_reg = 0.f;
#pragma unroll
    for (int d = 0; d < 4; ++d)
#pragma unroll
        for (int r = 0; r < 16; ++r) o[d][r] = 0.f;
    const unsigned sw = (unsigned)((r32 >> 1) & 7);
    for (int j = 0; j < NT; ++j) {
        const int cur = j & 1;
        const bool more = (j + 1 < NT);
        if (more) {
#pragma unroll
            for (int i = 0; i < KCH; ++i) { kreg[i] = *(const GAS u32x4*)kp[i]; kp[i] += kst[i]; }
            vreg0 = *(const GAS u32x4*)vp0; vreg1 = *(const GAS u32x4*)vp1; vp0 += vstp; vp1 += vstp;
        }
        if (j <= lim) {
            f32x16 p0, p1;
#pragma unroll
            for (int r = 0; r < 16; ++r) { p0[r] = 0.f; p1[r] = 0.f; }
            LAS unsigned char* Kc = Kl + cur * KTB;
#define NP_KOFF(d0) ((unsigned)(r32 * KRB) + ((((unsigned)((d0) * 2 + hi)) ^ sw) << 4))
            bf16x8 kb0[3], kb1[3];
            kb0[0] = *(const LAS bf16x8*)(Kc + NP_KOFF(0)); kb1[0] = *(const LAS bf16x8*)(Kc + NP_KOFF(0) + 32 * KRB);
            if (ND > 1) { kb0[1] = *(const LAS bf16x8*)(Kc + NP_KOFF(1)); kb1[1] = *(const LAS bf16x8*)(Kc + NP_KOFF(1) + 32 * KRB); }
#pragma unroll
            for (int d0 = 0; d0 < ND; ++d0) {
                if (d0 + 2 < ND) { kb0[(d0 + 2) % 3] = *(const LAS bf16x8*)(Kc + NP_KOFF(d0 + 2)); kb1[(d0 + 2) % 3] = *(const LAS bf16x8*)(Kc + NP_KOFF(d0 + 2) + 32 * KRB); }
                SBAR();
                p0 = __builtin_amdgcn_mfma_f32_32x32x16_bf16(kb0[d0 % 3], qr[d0], p0, 0, 0, 0);
                p1 = __builtin_amdgcn_mfma_f32_32x32x16_bf16(kb1[d0 % 3], qr[d0], p1, 0, 0, 0);
                SBAR();
            }
#undef NP_KOFF
            if (j == NT - 1 && nkeys < NT * 64) {
#pragma unroll
                for (int r = 0; r < 16; ++r) { const int kb = j * 64 + crow(r, hi); if (kb >= nkeys) p0[r] = -1e30f; if (kb + 32 >= nkeys) p1[r] = -1e30f; }
            }
            float mn, alpha; bf16x8 pa0, pa1, pa2, pa3;
            partialSM(p0, p1, m_reg, mn, alpha, C, thr_raw);
            finishSM(p0, p1, alpha, l_reg, pa0, pa1, pa2, pa3);
            if (__any(alpha < 1.f)) {
                if (hi == 0) wsc[r32] = alpha;
                asm volatile("s_waitcnt lgkmcnt(0)" ::: "memory");
#pragma unroll
                for (int r = 0; r < 16; ++r) { const float al = wsc[crow(r, hi)];
#pragma unroll
                    for (int d = 0; d < 4; ++d) o[d][r] *= al; }
            }
            const unsigned vb = vbase + (unsigned)(cur * 16384);
            pv_one<0>(o[0], vb, pa0, pa1, pa2, pa3); pv_one<1>(o[1], vb, pa0, pa1, pa2, pa3); pv_one<2>(o[2], vb, pa0, pa1, pa2, pa3); pv_one<3>(o[3], vb, pa0, pa1, pa2, pa3);
        }
        if (more) {
            LAS unsigned char* Kn = Kl + (cur ^ 1) * KTB; LAS unsigned char* Vn = Vl + (cur ^ 1) * 16384;
#pragma unroll
            for (int i = 0; i < KCH; ++i) *(LAS u32x4*)(Kn + kl[i]) = kreg[i];
            *(LAS u32x4*)(Vn + vs0) = vreg0; *(LAS u32x4*)(Vn + vs1) = vreg1;
        }
        __syncthreads();
    }
    if (lim >= 0) {
        if (hi == 0) wsc[32 + r32] = l_reg;
        asm volatile("s_waitcnt lgkmcnt(0)" ::: "memory");
#pragma unroll
        for (int r = 0; r < 16; ++r) { const float rl = __builtin_amdgcn_rcpf(wsc[32 + crow(r, hi)]);
#pragma unroll
            for (int d = 0; d < 4; ++d) o[d][r] *= rl; }
    }
}


template <int D0, int SUB> __device__ __forceinline__ void pv_one128(f32x16& od, unsigned vb, bf16x8 pa0, bf16x8 pa1, bf16x8 pa2, bf16x8 pa3) {
    constexpr int B = SUB * 16384;
    const s16x4 l0 = tr_read<B + v_rd_off(D0, 0, 0)>(vb), h0 = tr_read<B + v_rd_off(D0, 0, 1)>(vb), l1 = tr_read<B + v_rd_off(D0, 1, 0)>(vb), h1 = tr_read<B + v_rd_off(D0, 1, 1)>(vb);
    const s16x4 l2 = tr_read<B + v_rd_off(D0, 2, 0)>(vb), h2 = tr_read<B + v_rd_off(D0, 2, 1)>(vb), l3 = tr_read<B + v_rd_off(D0, 3, 0)>(vb), h3 = tr_read<B + v_rd_off(D0, 3, 1)>(vb);
    asm volatile("s_waitcnt lgkmcnt(0)" ::: "memory"); SBAR();
#define PKV(L, H) (bf16x8){L[0], L[1], L[2], L[3], H[0], H[1], H[2], H[3]}
    od = __builtin_amdgcn_mfma_f32_32x32x16_bf16(pa0, PKV(l0, h0), od, 0, 0, 0);
    od = __builtin_amdgcn_mfma_f32_32x32x16_bf16(pa1, PKV(l1, h1), od, 0, 0, 0);
    od = __builtin_amdgcn_mfma_f32_32x32x16_bf16(pa2, PKV(l2, h2), od, 0, 0, 0);
    od = __builtin_amdgcn_mfma_f32_32x32x16_bf16(pa3, PKV(l3, h3), od, 0, 0, 0);
#undef PKV
}
__device__ __forceinline__ void attn_unit_k128(const bf16_t* __restrict__ Qp, int ldq, const bf16_t* __restrict__ Kp, int ldk, const bf16_t* __restrict__ Vp, int ldv,
                                               const int NT, const int nkw, LAS unsigned char* lds, f32x16 (&o)[4], float scale) {
    constexpr int ND = 4, KRB = 128, KTB = 128 * KRB, VTB = 32768;
    int tid = threadIdx.x; asm volatile("" : "+v"(tid));
    const int wid = tid >> 6, lane = tid & 63, r32 = lane & 31, hi = lane >> 5;
    LAS unsigned char* Vl = lds; LAS unsigned char* Kl = lds + 2 * VTB; LAS float* wsc = (LAS float*)(lds + 2 * VTB + 2 * KTB) + wid * 64;
    const float C = scale * 1.4426950408889634f, thr_raw = 8.0f / scale;
    bf16x8 qr[ND];
    if (nkw > 0) {
        const bf16_t* qw = Qp + (size_t)(wid * 32 + r32) * ldq + hi * 8;
#pragma unroll
        for (int d0 = 0; d0 < ND; ++d0) qr[d0] = *(const GAS bf16x8*)(qw + d0 * 16);
    } else {
#pragma unroll
        for (int d0 = 0; d0 < ND; ++d0) qr[d0] = (bf16x8){0, 0, 0, 0, 0, 0, 0, 0};
    }
    const bf16_t* kp0; unsigned kl0;
    { const int row = tid >> 3, cc = tid & 7; kp0 = Kp + (size_t)row * ldk + cc * 8; kl0 = (unsigned)(row * KRB + ((cc ^ ((row >> 1) & 7)) << 4)); }
    const int sr = tid >> 4, sc = (tid & 15) * 8;
    const bf16_t* vp0 = Vp + (size_t)sr * ldv + sc; const unsigned vs0 = (unsigned)v_st(sr, sc);
    const long k64 = 64L * ldk, v32 = 32L * ldv;
    const int kstp = 128 * ldk, vstp = 128 * ldv;
#define K128_LOAD() do { kreg[0] = *(const GAS u32x4*)kp0; kreg[1] = *(const GAS u32x4*)(kp0 + k64); kp0 += kstp; \
        vreg[0] = *(const GAS u32x4*)vp0; vreg[1] = *(const GAS u32x4*)(vp0 + v32); vreg[2] = *(const GAS u32x4*)(vp0 + 2 * v32); vreg[3] = *(const GAS u32x4*)(vp0 + 3 * v32); vp0 += vstp; } while (0)
#define K128_WRITE(Kb_, Vb_) do { *(LAS u32x4*)((Kb_) + kl0) = kreg[0]; *(LAS u32x4*)((Kb_) + kl0 + 8192) = kreg[1]; \
        *(LAS u32x4*)((Vb_) + vs0) = vreg[0]; *(LAS u32x4*)((Vb_) + vs0 + 8192) = vreg[1]; *(LAS u32x4*)((Vb_) + vs0 + 16384) = vreg[2]; *(LAS u32x4*)((Vb_) + vs0 + 24576) = vreg[3]; } while (0)
    const unsigned vbase = (unsigned)(uintptr_t)Vl + (unsigned)v_rd_base(lane);
    const unsigned sw = (unsigned)((r32 >> 1) & 7);
    u32x4 kreg[2], vreg[4];
    K128_LOAD(); K128_WRITE(Kl, Vl);
    __syncthreads();
    float m_reg = -1e30f, l_reg = 0.f;
#pragma unroll
    for (int d = 0; d < 4; ++d)
#pragma unroll
        for (int r = 0; r < 16; ++r) o[d][r] = 0.f;
#pragma unroll 1
    for (int j = 0; j < NT; ++j) {
        const int cur = j & 1;
        const bool more = (j + 1 < NT);
        if (more) K128_LOAD();
        if (j * 128 < nkw) {
            f32x16 p[4];
#pragma unroll
            for (int k = 0; k < 4; ++k)
#pragma unroll
                for (int r = 0; r < 16; ++r) p[k][r] = 0.f;
            LAS unsigned char* Kc = Kl + cur * KTB;
#define K128_OFF(d0, k) ((unsigned)((32 * (k) + r32) * KRB) + ((((unsigned)((d0) * 2 + hi)) ^ sw) << 4))
            bf16x8 fa[4], fb[4];
#pragma unroll
            for (int k = 0; k < 4; ++k) fa[k] = *(const LAS bf16x8*)(Kc + K128_OFF(0, k));
#pragma unroll
            for (int k = 0; k < 4; ++k) fb[k] = *(const LAS bf16x8*)(Kc + K128_OFF(1, k));
            SBAR();
#pragma unroll
            for (int k = 0; k < 4; ++k) p[k] = __builtin_amdgcn_mfma_f32_32x32x16_bf16(fa[k], qr[0], p[k], 0, 0, 0);
            SBAR();
#pragma unroll
            for (int k = 0; k < 4; ++k) fa[k] = *(const LAS bf16x8*)(Kc + K128_OFF(2, k));
            SBAR();
#pragma unroll
            for (int k = 0; k < 4; ++k) p[k] = __builtin_amdgcn_mfma_f32_32x32x16_bf16(fb[k], qr[1], p[k], 0, 0, 0);
            SBAR();
#pragma unroll
            for (int k = 0; k < 4; ++k) fb[k] = *(const LAS bf16x8*)(Kc + K128_OFF(3, k));
            SBAR();
#pragma unroll
            for (int k = 0; k < 4; ++k) p[k] = __builtin_amdgcn_mfma_f32_32x32x16_bf16(fa[k], qr[2], p[k], 0, 0, 0);
            SBAR();
#pragma unroll
            for (int k = 0; k < 4; ++k) p[k] = __builtin_amdgcn_mfma_f32_32x32x16_bf16(fb[k], qr[3], p[k], 0, 0, 0);
#undef K128_OFF
            if ((j + 1) * 128 > nkw) {
                asm volatile("" ::: "memory");
#pragma unroll
                for (int k = 0; k < 4; ++k)
#pragma unroll
                    for (int r = 0; r < 16; ++r) { const int kb = j * 128 + 32 * k + crow(r, hi); if (kb >= nkw) p[k][r] = -1e30f; }
            }
            float pmax = p[0][0];
#pragma unroll
            for (int k = 0; k < 4; ++k)
#pragma unroll
                for (int r = 0; r < 16; ++r) pmax = fmaxf(pmax, p[k][r]);
            { auto rr = __builtin_amdgcn_permlane32_swap(__float_as_uint(pmax), __float_as_uint(pmax), false, false);
              pmax = fmaxf(__uint_as_float(rr[0]), __uint_as_float(rr[1])); }
            float mn, alpha;
            if (__builtin_expect(__all(pmax - m_reg <= thr_raw), 1)) { mn = m_reg; alpha = 1.f; }
            else { mn = fmaxf(m_reg, pmax); alpha = __builtin_amdgcn_exp2f((m_reg - mn) * C); m_reg = mn; }
            const float mnC = -mn * C;
            typedef float f32x2 __attribute__((ext_vector_type(2)));
            const f32x2 C2 = {C, C}, M2 = {mnC, mnC};
            f32x2 s2 = {0.f, 0.f};
#pragma unroll
            for (int k = 0; k < 4; ++k)
#pragma unroll
                for (int r = 0; r < 16; r += 2) { f32x2 t = {p[k][r], p[k][r + 1]}; t = __builtin_elementwise_fma(t, C2, M2);
                    t.x = __builtin_amdgcn_exp2f(t.x); t.y = __builtin_amdgcn_exp2f(t.y); p[k][r] = t.x; p[k][r + 1] = t.y; s2 += t; }
            float ps = s2.x + s2.y;
            { auto rr = __builtin_amdgcn_permlane32_swap(__float_as_uint(ps), __float_as_uint(ps), false, false);
              ps = __uint_as_float(rr[0]) + __uint_as_float(rr[1]); }
            l_reg = l_reg * alpha + ps;
            bf16x8 pa[8];
#define PK4(P, BASE, OUT) do { unsigned a0 = cvt_pk(P[BASE + 0], P[BASE + 1]), a1 = cvt_pk(P[BASE + 2], P[BASE + 3]);   \
    unsigned b0 = cvt_pk(P[BASE + 4], P[BASE + 5]), b1 = cvt_pk(P[BASE + 6], P[BASE + 7]);                              \
    auto r0 = __builtin_amdgcn_permlane32_swap(a0, b0, false, false); auto r1 = __builtin_amdgcn_permlane32_swap(a1, b1, false, false); \
    u32x4 w = {r0[0], r1[0], r0[1], r1[1]}; OUT = *reinterpret_cast<bf16x8*>(&w); } while (0)
#pragma unroll
            for (int k = 0; k < 4; ++k) { PK4(p[k], 0, pa[2 * k]); PK4(p[k], 8, pa[2 * k + 1]); }
#undef PK4
            if (__any(alpha < 1.f)) {
                if (hi == 0) wsc[r32] = alpha;
                asm volatile("s_waitcnt lgkmcnt(0)" ::: "memory");
#pragma unroll
                for (int r = 0; r < 16; ++r) { const float al = wsc[crow(r, hi)];
#pragma unroll
                    for (int d = 0; d < 4; ++d) o[d][r] *= al; }
            }
            const unsigned vb = vbase + (unsigned)(cur * VTB);
            pv_one128<0, 0>(o[0], vb, pa[0], pa[1], pa[2], pa[3]); pv_one128<0, 1>(o[0], vb, pa[4], pa[5], pa[6], pa[7]);
            pv_one128<1, 0>(o[1], vb, pa[0], pa[1], pa[2], pa[3]); pv_one128<1, 1>(o[1], vb, pa[4], pa[5], pa[6], pa[7]);
            pv_one128<2, 0>(o[2], vb, pa[0], pa[1], pa[2], pa[3]); pv_one128<2, 1>(o[2], vb, pa[4], pa[5], pa[6], pa[7]);
            pv_one128<3, 0>(o[3], vb, pa[0], pa[1], pa[2], pa[3]); pv_one128<3, 1>(o[3], vb, pa[4], pa[5], pa[6], pa[7]);
        }
        if (more) {
            LAS unsigned char* Kn = Kl + (cur ^ 1) * KTB; LAS unsigned char* Vn = Vl + (cur ^ 1) * VTB;
            K128_WRITE(Kn, Vn);
        }
        __syncthreads();
    }
    if (nkw > 0) {
        if (hi == 0) wsc[32 + r32] = l_reg;
        asm volatile("s_waitcnt lgkmcnt(0)" ::: "memory");
#pragma unroll
        for (int r = 0; r < 16; ++r) { const float rl = __builtin_amdgcn_rcpf(wsc[32 + crow(r, hi)]);
#pragma unroll
            for (int d = 0; d < 4; ++d) o[d][r] *= rl; }
    }
#undef K128_LOAD
#undef K128_WRITE
}

__device__ __forceinline__ void ffn_conv_phase(bf16_t* U, const float* __restrict__ st, const float* __restrict__ cw, const float* __restrict__ cb, long gt_, long NTH_, int dummy) {
        const long ntask = (long)(M / 4) * (FF / 8);
        for (long t = gt_; t < ntask; t += NTH_) {
            const int cch = (int)(t % (FF / 8)), rb = (int)(t / (FF / 8)), r0 = rb * 4, c0 = cch * 8;
            const bool samp = r0 >= MP;
            const int spos = samp ? ((r0 - MP) & 31) : (r0 & (SEQ - 1));
            const int sbb = (r0 - MP) >> 5;
            float gv[6][8];
#pragma unroll
            for (int k = 0; k < 6; ++k) {
                if (k >= 2 || spos != 0) unpack8(*(const GAS u32x4*)(U + (size_t)(r0 - 2 + k) * 5632 + c0), gv[k]);
                else if (samp) { const f32x4 h0 = *(const GAS f32x4*)(st + (size_t)(sbb * 2 + k) * FF + c0), h1 = *(const GAS f32x4*)(st + (size_t)(sbb * 2 + k) * FF + c0 + 4);
                    gv[k][0] = h0[0]; gv[k][1] = h0[1]; gv[k][2] = h0[2]; gv[k][3] = h0[3]; gv[k][4] = h1[0]; gv[k][5] = h1[1]; gv[k][6] = h1[2]; gv[k][7] = h1[3]; }
                else {
#pragma unroll
                    for (int e = 0; e < 8; ++e) gv[k][e] = 0.f; }
            }
            float w0[8], w1[8], w2[8], bb[8];
#pragma unroll
            for (int e = 0; e < 8; ++e) { w0[e] = cw[c0 + e]; w1[e] = cw[FF + c0 + e]; w2[e] = cw[2 * FF + c0 + e]; bb[e] = cb[c0 + e]; }
#pragma unroll
            for (int j = 0; j < 4; ++j) {
                bf16_t* up = U + (size_t)(r0 + j) * 5632 + FF + c0;
                float uv[8]; unpack8(*(const GAS u32x4*)up, uv);
                float ov[8];
#pragma unroll
                for (int e = 0; e < 8; ++e) { const float gs = w0[e] * gv[j][e] + w1[e] * gv[j + 1][e] + w2[e] * gv[j + 2][e] + bb[e];
                    ov[e] = gs / (1.f + __expf(-gs)) * uv[e]; }
                u32x4 w; w.x = cvt_pk(ov[0], ov[1]); w.y = cvt_pk(ov[2], ov[3]); w.z = cvt_pk(ov[4], ov[5]); w.w = cvt_pk(ov[6], ov[7]);
                if (!dummy || ov[0] == 1.2345e-37f) *(GAS u32x4*)up = w;
            }
        }
}

#define XB_TMO      128
#define XB_XCNT(j)  (256  + 64 * (j))
#define XB_XSUB(j)  (1280 + 64 * (j))
#define XB_XGEN(j)  (2304 + 64 * (j))
#define XB_TOP      3328
#define XB_TOPGEN   3392
#define XCD_BAR_WORDS 3456
#define XB_SPIN_CAP (1u << 18)

__device__ __forceinline__ unsigned xb_ld(unsigned* p)              { return __hip_atomic_load(p, __ATOMIC_RELAXED, __HIP_MEMORY_SCOPE_AGENT); }
__device__ __forceinline__ unsigned xb_add(unsigned* p, unsigned v) { return __hip_atomic_fetch_add(p, v, __ATOMIC_RELAXED, __HIP_MEMORY_SCOPE_AGENT); }
__device__ __forceinline__ unsigned xb_xcc_id() { return (unsigned)__builtin_amdgcn_s_getreg((3 << 11) | 20) & 0xFu; }
#define XB_SPIN(cond, bar) do { unsigned _sp = 0; while (cond) { __builtin_amdgcn_s_sleep(1); \
    if ((++_sp & 255u) == 0u) { if (xb_ld(&(bar)[XB_TMO])) break; if (_sp > XB_SPIN_CAP) { atomicAdd(&(bar)[XB_TMO], 1u); break; } } } } while (0)

struct XcdBarrier {
    unsigned* bar; unsigned x;
    volatile LAS unsigned* st;
};

__device__ __forceinline__ XcdBarrier xcd_barrier_post(unsigned* bar, volatile LAS unsigned* st) {
    XcdBarrier b; b.bar = bar; b.x = (unsigned)__builtin_amdgcn_readfirstlane((int)xb_xcc_id()); b.st = st;
    if (threadIdx.x == 0) (void)xb_add(&bar[XB_XCNT(b.x)], 1u);
    return b;
}
__device__ __forceinline__ void xcd_barrier_complete(unsigned* bar, unsigned x, unsigned& nloc, unsigned& nx) {
    const unsigned G = gridDim.x * gridDim.y * gridDim.z;
    unsigned sum, cnt, mine, sp = 0u;
    for (;;) {
        sum = 0u; cnt = 0u; mine = 0u;
#pragma unroll
        for (unsigned j = 0; j < 16; ++j) { const unsigned c = xb_ld(&bar[XB_XCNT(j)]); sum += c; cnt += (c > 0u) ? 1u : 0u; mine = (j == x) ? c : mine; }
        if (sum == G) break;
        __builtin_amdgcn_s_sleep(1);
        if ((++sp & 255u) == 0u) { if (xb_ld(&bar[XB_TMO])) break; if (sp > XB_SPIN_CAP) { atomicAdd(&bar[XB_TMO], 1u); break; } }
    }
    nloc = mine > 0u ? mine : 1u; nx = cnt > 0u ? cnt : 1u;
}

__device__ __forceinline__ void xcd_barrier(const XcdBarrier& b) {
    asm volatile("s_waitcnt vmcnt(0)" ::: "memory");
    __syncthreads();
    if (threadIdx.x == 0) {
        unsigned* bar = b.bar;
        __builtin_amdgcn_s_waitcnt(0);
        unsigned nloc = b.st[0], nx = b.st[1];
        if (nloc == 0u) { xcd_barrier_complete(bar, b.x, nloc, nx); b.st[0] = nloc; b.st[1] = nx; }
        const unsigned old = xb_add(&bar[XB_XSUB(b.x)], 1u);
        const unsigned gen = old / nloc;
        if (old + 1u == (gen + 1u) * nloc) {
            __builtin_amdgcn_fence(__ATOMIC_RELEASE, "agent");
            asm volatile("s_waitcnt vmcnt(0)" ::: "memory");
            const unsigned og = xb_add(&bar[XB_TOP], 1u);
            const unsigned tg = og / nx;
            if (og + 1u == (tg + 1u) * nx) xb_add(&bar[XB_TOPGEN], 1u);
            else XB_SPIN(xb_ld(&bar[XB_TOPGEN]) == tg, bar);
            __builtin_amdgcn_fence(__ATOMIC_ACQUIRE, "agent");
            xb_add(&bar[XB_XGEN(b.x)], 1u);
            asm volatile("s_waitcnt vmcnt(0)" ::: "memory");
        } else {
            XB_SPIN(xb_ld(&bar[XB_XGEN(b.x)]) == gen, bar);
            __builtin_amdgcn_fence(__ATOMIC_ACQUIRE, "agent");
            asm volatile("s_waitcnt vmcnt(0)" ::: "memory");
        }
    }
    __syncthreads();
}


struct Args { const float* in[33]; float* out; unsigned char* ws; };
__device__ __forceinline__ const float* ld_in(const Args& a, int k) { asm volatile("" : "+s"(k)); return a.in[k]; }
#define INP(k) ld_in(a, (k))
struct Ctx {
    unsigned char* ws; float* out; int tid, wid, lane, r32, hi, G, bid; long gt, NTH; int gw, NWV;
    float* ssq; float* rope; bf16_t* wmix; bf16_t* wffn; bf16_t* Xb; unsigned char* big; unsigned char* tail; float* X;
};
__device__ __forceinline__ Ctx mkctx(const Args& a) {
    Ctx c;
    { unsigned long long w = (unsigned long long)(uintptr_t)a.ws, o = (unsigned long long)(uintptr_t)a.out;
      unsigned wl = __builtin_amdgcn_readfirstlane((unsigned)w), wh = __builtin_amdgcn_readfirstlane((unsigned)(w >> 32));
      unsigned ol = __builtin_amdgcn_readfirstlane((unsigned)o), oh = __builtin_amdgcn_readfirstlane((unsigned)(o >> 32));
      asm volatile("" : "+s"(wl), "+s"(wh), "+s"(ol), "+s"(oh));
      c.ws = (unsigned char*)(uintptr_t)(((unsigned long long)wh << 32) | wl); c.out = (float*)(uintptr_t)(((unsigned long long)oh << 32) | ol); }
    int t = threadIdx.x; asm volatile("" : "+v"(t)); c.tid = t; c.wid = t >> 6; c.lane = t & 63; c.r32 = t & 31; c.hi = (t >> 5) & 1;
    int g = gridDim.x, b = blockIdx.x; asm volatile("" : "+s"(g), "+s"(b)); c.G = g; c.bid = b;
    c.gt = (long)b * NTHREADS + t; c.NTH = (long)g * NTHREADS; c.gw = b * 8 + c.wid; c.NWV = g * 8;
    c.ssq = (float*)(c.ws + WS_SSQP); c.rope = (float*)(c.ws + WS_ROPE); c.wmix = (bf16_t*)(c.ws + WS_WMIX); c.wffn = (bf16_t*)(c.ws + WS_WFFN);
    c.Xb = (bf16_t*)(c.ws + WS_XB); c.big = c.ws + WS_BIG; c.tail = c.ws + WS_TAIL; c.X = c.out + O_Y;
    return c;
}

__device__ __forceinline__ float* ssqb(const Ctx& c, int s) { return (float*)((unsigned char*)c.ssq + (size_t)(s & 1) * 3 * MiB); }
constexpr size_t B_WDN1 = 346 * MiB;
static_assert(B_WDN1 + 1024u * 2816 * 2 <= 356 * MiB, "wdn1");
__device__ __forceinline__ bf16_t* wdn_buf(const Ctx& c, int i) { return (i & 1) ? (bf16_t*)(c.big + B_WDN1) : c.wffn + W_DN; }
__device__ __forceinline__ void prep_ffn(const Args& a, const Ctx& c, LAS float* ltile, int i, int rank = -1, int nwork = 0) {
    prep_gu(ltile, INP(28) + (size_t)i * D * FF, INP(29) + (size_t)i * D * FF, c.wffn + W_GU, INP(10) + i * D, rank, nwork);
    prep_w(ltile, INP(32) + (size_t)i * FF * D, D, FF, D, wdn_buf(c, i), D, 0, 0, nullptr, 1, 1.f, nullptr, rank, nwork);
}

__device__ __forceinline__ void prep_mixer_rest(const Args& a, const Ctx& c, LAS float* ltile) {
    prep_w(ltile, INP(15), 1024, 1024, 1024, c.wmix + W_OA, 1024, 0, 0, INP(14), 128, 0.8f, nullptr);
    prep_w(ltile, INP(16), 704, 1024, 704, c.wmix + W_DB, 768, 0, 0, INP(9) + D, D, 1.f, nullptr);
    prep_w(ltile, INP(18), 1536, 384, 1536, c.wmix + W_UQ, 1536, 3, 0, nullptr, 1, 1.f, nullptr);
    prep_w(ltile, INP(20), 1024, 256, 1024, c.wmix + W_UKV, 1024, 0, 0, nullptr, 1, 1.f, nullptr);
    prep_w(ltile, INP(21), 1024, 256, 1024, c.wmix + W_UKV + 1024u * 256, 1024, 0, 0, nullptr, 1, 1.f, nullptr);
    prep_w(ltile, INP(22), 1024, 1024, 1024, c.wmix + W_OB, 1024, 0, 0, nullptr, 1, 1.f, nullptr);
    prep_w(ltile, INP(23), 3072, 1024, 3072, c.wmix + W_CIN, 3072, 0, 0, INP(9) + 2 * D, D, 1.f, nullptr);
    prep_w(ltile, INP(25), 1024, 1024, 1024, c.wmix + W_COUT, 1024, 0, 0, nullptr, 1, 1.f, nullptr);
#pragma unroll 1
    for (int g4 = 0; g4 < 4; ++g4)
        prep_w(ltile, INP(26) + (size_t)g4 * 65536, 256, 256, 256, c.wmix + W_DG + (size_t)g4 * 65536, 256, 0, 0, nullptr, 1, 1.f, INP(27) + g4 * 256);
}
__device__ __forceinline__ void ph_prologue(const Args& a, LAS unsigned char* lds) {
    const Ctx c = mkctx(a); LAS float* ltile = (LAS float*)lds;
    prep_w(ltile, INP(12), 3072, 1024, 3072, c.wmix + W_QKV, 3072, 1, 32, INP(9), D, 1.f, nullptr);
    for (long i = c.gt; i < 16384L * 32; i += c.NTH) {
        const int pos = (int)(i >> 5), k = (int)(i & 31);
        double inv = 1.0; for (int q = 0; q < k; ++q) inv *= 0.7498942093324559;
        const float invf = (float)inv;
        const double rev = (double)pos * (double)invf * 0.15915494309189535;
        const float fr = (float)(rev - floor(rev));
        c.rope[(size_t)pos * 64 + k] = __builtin_amdgcn_cosf(fr); c.rope[(size_t)pos * 64 + 32 + k] = __builtin_amdgcn_sinf(fr);
    }
    {
        const float* xp = INP(0); const float* xs = INP(1);
        for (int r = c.gw; r < M; r += c.NWV) {
            const float* src = r < MP ? xp + (size_t)r * D : xs + (size_t)(r - MP) * D;
            float ss = 0.f;
#pragma unroll
            for (int j = 0; j < 4; ++j) { const f32x4 v = *(const GAS f32x4*)(src + j * 256 + c.lane * 4); ss += v[0] * v[0] + v[1] * v[1] + v[2] * v[2] + v[3] * v[3];
                *(GAS u32x2*)(c.Xb + (size_t)r * D + j * 256 + c.lane * 4) = pack4(v); }
            ss = wave_sum(ss);
            if (c.lane < 16) ssqb(c, 0)[(size_t)r * 16 + c.lane] = c.lane == 0 ? ss : 0.f;
        }
    }
    {
        const float* ck = INP(2); const float* cv = INP(3);
        bf16_t* Ks = (bf16_t*)(c.tail + T_K); bf16_t* Vs = (bf16_t*)(c.tail + T_V);
        for (long i = c.gt; i < (long)SBN * PAST * D / 8; i += c.NTH) {
            const long e = i * 8; const int sbb = (int)(e / ((long)PAST * D)); const long rem = e % ((long)PAST * D);
            const size_t dst = (size_t)sbb * NKSP * D + rem;
            *(GAS u32x4*)(Ks + dst) = pack8(*(const GAS f32x4*)(ck + e), *(const GAS f32x4*)(ck + e + 4));
            *(GAS u32x4*)(Vs + dst) = pack8(*(const GAS f32x4*)(cv + e), *(const GAS f32x4*)(cv + e + 4));
        }
        for (long i = c.gt; i < (long)SBN * (NKSP - NKS) * D / 8; i += c.NTH) {
            const long e = i * 8; const int sbb = (int)(e / ((long)(NKSP - NKS) * D)); const long rem = e % ((long)(NKSP - NKS) * D);
            const size_t dst = ((size_t)sbb * NKSP + NKS) * D + rem;
            *(GAS u32x4*)(Ks + dst) = (u32x4){0, 0, 0, 0}; *(GAS u32x4*)(Vs + dst) = (u32x4){0, 0, 0, 0};
        }
    }
}

__device__ __forceinline__ void ph_l0_qkv(const Args& a, LAS unsigned char* lds) {
    const Ctx c = mkctx(a);
    bf16_t* Q = (bf16_t*)(c.big + B0_Q); bf16_t* Kb = (bf16_t*)(c.big + B0_K); bf16_t* Vb = (bf16_t*)(c.big + B0_V);
    bf16_t* Ks = (bf16_t*)(c.tail + T_K); bf16_t* Vs = (bf16_t*)(c.tail + T_V);
    pg8::Gemm g{c.Xb, c.wmix + W_QKV, M, 3072, 1024, 1024, 0}; pg8::StaticOrder S; S.init(M, 3072, c.G, c.bid);
    EpiQKV E{ssqb(c, 0), c.rope, Q, Kb, Vb, Ks, Vs, c.out + O_AKP, c.out + O_AVP, c.out + O_AKS, c.out + O_AVS};
    pg8::gemm_phase(lds, g, S, E);
    prep_mixer_rest(a, c, (LAS float*)lds);
}
struct AUnit { int b, h, qb, sbb; bool samp; };
__device__ __forceinline__ AUnit attn_unit_of(int G, int bid, int ui) {
    AUnit u; u.samp = false; u.sbb = 0; u.b = 0; u.qb = 0; u.h = 0;
    if (G == 256) {
        if (ui < 4) { const int combo = (bid & 7) * 2 + (ui >> 1); u.b = combo >> 3; u.h = combo & 7; u.qb = (ui & 1) ? (bid >> 3) : 63 - (bid >> 3); }
        else { u.samp = true; u.sbb = bid >> 3; u.h = bid & 7; }
    } else {
        const int id = bid + ui * G;
        if (id < 1024) { u.b = id >> 9; u.h = (id >> 6) & 7; u.qb = id & 63; } else { u.samp = true; u.sbb = (id - 1024) >> 3; u.h = (id - 1024) & 7; }
    }
    return u;
}
__device__ __forceinline__ int attn_ucount(int G, int bid) { return (G == 256) ? 4 + (bid < 64 ? 1 : 0) : (1024 + 64 - bid + G - 1) / G; }

__device__ __forceinline__ void ph_l0_attn(const Args& a, LAS unsigned char* lds, int dummy) {
    const Ctx c = mkctx(a);
    bf16_t* Q = (bf16_t*)(c.big + B0_Q); bf16_t* Kb = (bf16_t*)(c.big + B0_K); bf16_t* Vb = (bf16_t*)(c.big + B0_V); GAS float* OS = (GAS float*)(c.big + B0_OS);
    GAS bf16_t* Qg = (GAS bf16_t*)Q;
    bf16_t* Ks = (bf16_t*)(c.tail + T_K); bf16_t* Vs = (bf16_t*)(c.tail + T_V);
    float lam;
    { const float* al = INP(13); const float pa = al[c.lane] * al[64 + c.lane], pb = al[128 + c.lane] * al[192 + c.lane];
      lam = __expf(wave_sum(pa)) - __expf(wave_sum(pb)) + 0.2f; }
    const int ucount = attn_ucount(c.G, c.bid);
    if (__builtin_amdgcn_readfirstlane(c.tid) >= 256) __builtin_amdgcn_s_setprio(1);
#pragma unroll 1
    for (int ui = 0; ui < ucount; ++ui) {
        const AUnit u = attn_unit_of(c.G, c.bid, ui);
        const int row0 = u.samp ? MP + u.sbb * 32 : u.b * SEQ + u.qb * 256;
        const int NT = u.samp ? 9 : 2 * u.qb + 2;
        const int nkw = __builtin_amdgcn_readfirstlane(u.samp ? (c.wid == 0 ? NKS : 0) : (4 * u.qb + (c.wid >> 1) + 1) * 64);
        const bool act = nkw > 0;
#pragma unroll 1
        for (int cc = 0; cc < 2; ++cc) {
            const bf16_t* Kp = u.samp ? Ks + (size_t)u.sbb * NKSP * D + u.h * 128 + cc * 64 : Kb + (size_t)u.b * SEQ * D + u.h * 128 + cc * 64;
            const bf16_t* Vp = u.samp ? Vs + (size_t)u.sbb * NKSP * D + u.h * 128 : Vb + (size_t)u.b * SEQ * D + u.h * 128;
            f32x16 o[4];
            attn_unit_k128(Q + (size_t)row0 * D + u.h * 128 + cc * 64, D, Kp, D, Vp, D, NT, nkw, lds, o, 0.125f);
            if (act && (!dummy || o[0][0] == 1.2345e-37f)) {
                unsigned ebase = (unsigned)((row0 + c.wid * 32 + 4 * c.hi) * D + u.h * 128 + c.r32);
                asm volatile("" : "+v"(ebase));
                if (cc == 0) {
#pragma unroll
                    for (int r = 0; r < 16; ++r)
#pragma unroll
                        for (int d = 0; d < 4; ++d) OS[ebase + (unsigned)(((r & 3) + 8 * (r >> 2)) * D + d * 32)] = o[d][r];
                } else {
#pragma unroll
                    for (int r = 0; r < 16; ++r) {
                        asm volatile("" ::: "memory");
                        const unsigned base = ebase + (unsigned)(((r & 3) + 8 * (r >> 2)) * D);
                        float x[4]; float ss = 0.f;
#pragma unroll
                        for (int d = 0; d < 4; ++d) { x[d] = OS[base + d * 32] - lam * o[d][r]; ss += x[d] * x[d]; }
                        ss += __shfl_xor(ss, 1); ss += __shfl_xor(ss, 2); ss += __shfl_xor(ss, 4); ss += __shfl_xor(ss, 8); ss += __shfl_xor(ss, 16);
                        const float rs = rsqrtf(ss * (1.0f / 128.0f) + 1e-5f);
#pragma unroll
                        for (int d = 0; d < 4; ++d) Qg[base + d * 32] = f2bf(x[d] * rs);
                    }
                }
            }
        }
    }
    __builtin_amdgcn_s_setprio(0);
}
__device__ __forceinline__ void ph_l0_out(const Args& a, LAS unsigned char* lds) {
    const Ctx c = mkctx(a);
    bf16_t* Q = (bf16_t*)(c.big + B0_Q);
    pg8::Gemm g{Q, c.wmix + W_OA, M, 1024, 1024, 1024, 0}; pg8::StaticOrder S; S.init(M, 1024, c.G, c.bid);
    EpiResidT<true> E{INP(0), INP(1), c.Xb, ssqb(c, 1)};
    pg8::gemm_phase(lds, g, S, E);
    prep_ffn(a, c, (LAS float*)lds, 0);
}

__device__ __forceinline__ void ph_ffn_up(const Args& a, LAS unsigned char* lds, int i) {
    const Ctx c = mkctx(a);
    pg8::Gemm g{c.Xb, c.wffn + W_GU, M, 5632, 1024, 1024, 0}; g.mrows = 254; g.moff = -2;
    pg8::StaticOrder S; S.init2(131, 22, c.G, c.bid);
    EpiFfn E{(bf16_t*)c.big, ssqb(c, 2 * i + 1), INP(30) + (size_t)i * 3 * FF, INP(31) + (size_t)i * FF, INP(8) + (size_t)i * SBN * 2 * FF,
             c.out + O_FCP + (size_t)i * NBP * 2 * FF, c.out + O_FCS + (size_t)i * SBN * 2 * FF, lds + 131072 + 4096};
    pg8::gemm_phase(lds, g, S, E);
}
constexpr size_t B_SLAB = 180 * MiB;
__device__ __forceinline__ void ph_ffn_down(const Args& a, LAS unsigned char* lds, int i) {
    const Ctx c = mkctx(a);
    constexpr int NS = FF / 256;
    const bool split = c.G >= 8 * NS;
    {
        pg8::Gemm g{(bf16_t*)c.big, wdn_buf(c, i), M, 1024, FF, FF, 0}; pg8::StaticOrder S; S.init(split ? MP : M, 1024, c.G, c.bid);
        EpiResidT<false> E{nullptr, nullptr, c.Xb, ssqb(c, 2 * i + 2)};
        pg8::gemm_phase(lds, g, S, E);
    }
    if (!split) { if (i < 3) prep_ffn(a, c, (LAS float*)lds, i + 1); return; }
    if (c.bid >= 4 * NS) {
        if (i < 3) prep_ffn(a, c, (LAS float*)lds, i + 1, c.bid - 4 * NS, c.G - 4 * NS);
        return;
    }
    unsigned* cnt = (unsigned*)c.ws + 3600 + i;
    float* slab = (float*)(c.big + B_SLAB);
    {
        const int pn = c.bid & 3, ks = c.bid >> 2;
        pg8::Gemm g{(bf16_t*)c.big + ks * 256, wdn_buf(c, i) + ks * 256, M, 1024, 256, FF, 0}; g.ldb = FF;
        pg8::SingleUnit S{128, pn};
        EpiSlab E{slab + (size_t)(pn * NS + ks) * 65536};
        pg8::gemm_phase(lds, g, S, E);
        __builtin_amdgcn_fence(__ATOMIC_RELEASE, "agent"); asm volatile("s_waitcnt vmcnt(0)" ::: "memory");
        __syncthreads();
        if (c.tid == 0) __hip_atomic_fetch_add(cnt, 1u, __ATOMIC_RELAXED, __HIP_MEMORY_SCOPE_AGENT);
    }
    if (c.bid < 16) {
        if (c.tid == 0) { unsigned sp = 0; while (__hip_atomic_load(cnt, __ATOMIC_RELAXED, __HIP_MEMORY_SCOPE_AGENT) < 4u * NS) { __builtin_amdgcn_s_sleep(2); if (++sp > (1u << 22)) break; } }
        __syncthreads();
        __builtin_amdgcn_fence(__ATOMIC_ACQUIRE, "agent"); asm volatile("s_waitcnt vmcnt(0)" ::: "memory");
        const int sl = c.bid, pn = sl >> 2, row = c.tid >> 1, cq = (sl & 3) * 64 + (c.tid & 1) * 32;
        const size_t xoff = (size_t)(MP + row) * D + pn * 256 + cq;
        float ss = 0.f;
#pragma unroll
        for (int k8 = 0; k8 < 4; ++k8) {
            const u32x4 w = *(const GAS u32x4*)(c.Xb + xoff + k8 * 8);
            f32x4 v0 = {bflo(w.x), bfhi(w.x), bflo(w.y), bfhi(w.y)}, v1 = {bflo(w.z), bfhi(w.z), bflo(w.w), bfhi(w.w)};
#pragma unroll
            for (int ks = 0; ks < NS; ++ks) { const float* p = slab + (size_t)(pn * NS + ks) * 65536 + row * 256 + cq + k8 * 8;
                v0 += *(const GAS f32x4*)p; v1 += *(const GAS f32x4*)(p + 4); }
            *(GAS u32x4*)(c.Xb + xoff + k8 * 8) = pack8(v0, v1);
            ss += (v0[0] * v0[0] + v0[1] * v0[1]) + (v0[2] * v0[2] + v0[3] * v0[3]) + (v1[0] * v1[0] + v1[1] * v1[1]) + (v1[2] * v1[2] + v1[3] * v1[3]);
        }
        ss += __shfl_xor(ss, 1);
        if ((c.tid & 1) == 0) ssqb(c, 2 * i + 2)[(size_t)(MP + row) * 16 + sl] = ss;
    }
}

__device__ __forceinline__ void ph_l1_down(const Args& a, LAS unsigned char* lds) {
    const Ctx c = mkctx(a);
    pg8::Gemm g{c.Xb, c.wmix + W_DB, M, 768, 1024, 1024, 0}; pg8::StaticOrder S; S.init(M, 768, c.G, c.bid);
    EpiF32 E{(float*)(c.big + B1_DOWN), 768, ssqb(c, 2)};
    pg8::gemm_phase(lds, g, S, E);
}
__device__ __forceinline__ void ph_l1_rows(const Args& a) {
    const Ctx c = mkctx(a);
    const float* DOWN = (const float*)(c.big + B1_DOWN); bf16_t* CQ = (bf16_t*)(c.big + B1_CQ); bf16_t* CKV = (bf16_t*)(c.big + B1_CKV); bf16_t* KR = (bf16_t*)(c.big + B1_KR);
    bf16_t* KsN = (bf16_t*)(c.tail + T_K); bf16_t* VsB = (bf16_t*)(c.tail + T_V); bf16_t* KRs = (bf16_t*)(c.tail + T_KR);
    const float* gq = INP(17); const float* gkv = INP(19); const int lane = c.lane;
    for (int r = c.gw; r < M; r += c.NWV) {
        const float* dr = DOWN + (size_t)r * 768;
        const bool samp = r >= MP; const int sr_ = r - MP, sbb = sr_ >> 5, tt = sr_ & 31;
        const int pos = samp ? PAST + tt : (r & (SEQ - 1));
        float cq[6]; float s1 = 0.f;
#pragma unroll
        for (int j = 0; j < 6; ++j) { cq[j] = dr[j * 64 + lane]; s1 += cq[j] * cq[j]; }
        s1 = wave_sum(s1); const float r1 = rsqrtf(s1 * (1.0f / 384.0f) + NORM_EPS);
#pragma unroll
        for (int j = 0; j < 6; ++j) CQ[(size_t)r * 384 + j * 64 + lane] = f2bf(cq[j] * r1 * gq[j * 64 + lane]);
        float kv[4]; float s2 = 0.f;
#pragma unroll
        for (int j = 0; j < 4; ++j) { kv[j] = dr[384 + j * 64 + lane]; s2 += kv[j] * kv[j]; }
        s2 = wave_sum(s2); const float r2 = rsqrtf(s2 * (1.0f / 256.0f) + NORM_EPS);
        float* lo = samp ? c.out + O_BLS + (size_t)sr_ * 256 : c.out + O_BLP + (size_t)r * 256;
#pragma unroll
        for (int j = 0; j < 4; ++j) { const float v = kv[j] * r2 * gkv[j * 64 + lane]; lo[j * 64 + lane] = v; CKV[(size_t)r * 256 + j * 64 + lane] = f2bf(v); }
        const float xk = dr[640 + lane], xo = __shfl_xor(xk, 32);
        const float cs = c.rope[(size_t)pos * 64 + (lane & 31)], sn = c.rope[(size_t)pos * 64 + 32 + (lane & 31)];
        const float y = lane < 32 ? xk * cs - xo * sn : xk * cs + xo * sn;
        if (samp) { c.out[O_BRS + (size_t)sr_ * 64 + lane] = y; KRs[((size_t)sbb * NKSP + PAST + tt) * 64 + lane] = f2bf(y); }
        else { c.out[O_BRP + (size_t)r * 64 + lane] = y; KR[(size_t)r * 64 + lane] = f2bf(y); }
    }
    const float* cl = INP(4); const float* ckr = INP(5);
    for (long i = c.gt; i < (long)MCACHE * 256 / 8; i += c.NTH) {
        const long e = i * 8;
        *(GAS u32x4*)(CKV + (size_t)M * 256 + e) = pack8(*(const GAS f32x4*)(cl + e), *(const GAS f32x4*)(cl + e + 4));
    }
    for (long i = c.gt; i < (long)MCACHE * 64 / 8; i += c.NTH) {
        const long e = i * 8; const int sbb = (int)(e / (PAST * 64)); const long rem = e % (PAST * 64);
        *(GAS u32x4*)(KRs + (size_t)sbb * NKSP * 64 + rem) = pack8(*(const GAS f32x4*)(ckr + e), *(const GAS f32x4*)(ckr + e + 4));
    }
    for (long i = c.gt; i < (long)SBN * (NKSP - NKS) * D / 8; i += c.NTH) {
        const long e = i * 8; const int sbb = (int)(e / ((long)(NKSP - NKS) * D)); const long rem = e % ((long)(NKSP - NKS) * D);
        const size_t dst = ((size_t)sbb * NKSP + NKS) * D + rem;
        *(GAS u32x4*)(KsN + dst) = (u32x4){0, 0, 0, 0}; *(GAS u32x4*)(VsB + dst) = (u32x4){0, 0, 0, 0};
    }
    for (long i = c.gt; i < (long)SBN * (NKSP - NKS) * 64 / 8; i += c.NTH) {
        const long e = i * 8; const int sbb = (int)(e / ((long)(NKSP - NKS) * 64)); const long rem = e % ((long)(NKSP - NKS) * 64);
        *(GAS u32x4*)(KRs + ((size_t)sbb * NKSP + NKS) * 64 + rem) = (u32x4){0, 0, 0, 0};
    }
}
__device__ __forceinline__ void ph_l1_uq(const Args& a, LAS unsigned char* lds) {
    const Ctx c = mkctx(a);
    pg8::Gemm g{(bf16_t*)(c.big + B1_CQ), c.wmix + W_UQ, M, 1536, 384, 384, 0}; pg8::StaticOrder S; S.init(M, 1536, c.G, c.bid);
    EpiUQ E{c.rope, (bf16_t*)(c.big + B1_DOWN)};
    pg8::gemm_phase(lds, g, S, E);
}
__device__ __forceinline__ void ph_l1_expand(const Args& a, LAS unsigned char* lds) {
    const Ctx c = mkctx(a);
    pg8::Gemm g{(bf16_t*)(c.big + B1_CKV), c.wmix + W_UKV, MX, 2048, 256, 256, 0}; pg8::StaticOrder S; S.init(MX, 2048, c.G, (c.bid + c.G / 2) % c.G);
    EpiExpand E{(bf16_t*)(c.big + B1_KN), (bf16_t*)(c.big + B1_V), (bf16_t*)(c.tail + T_K), (bf16_t*)(c.tail + T_V)};
    pg8::gemm_phase(lds, g, S, E);
}
__device__ __forceinline__ void ph_l1_attn(const Args& a, LAS unsigned char* lds, int dummy) {
    const Ctx c = mkctx(a);
    bf16_t* QB = (bf16_t*)(c.big + B1_DOWN); bf16_t* KN = (bf16_t*)(c.big + B1_KN); bf16_t* KR = (bf16_t*)(c.big + B1_KR); bf16_t* VB = (bf16_t*)(c.big + B1_V); GAS bf16_t* AO = (GAS bf16_t*)(c.big + B1_AO);
    bf16_t* KsN = (bf16_t*)(c.tail + T_K); bf16_t* VsB = (bf16_t*)(c.tail + T_V); bf16_t* KRs = (bf16_t*)(c.tail + T_KR);
    const int ucount = attn_ucount(c.G, c.bid);
    if (__builtin_amdgcn_readfirstlane(c.tid) >= 256) __builtin_amdgcn_s_setprio(1);
#pragma unroll 1
    for (int ui = 0; ui < ucount; ++ui) {
        const AUnit u = attn_unit_of(c.G, c.bid, ui);
        const int row0 = u.samp ? MP + u.sbb * 32 : u.b * SEQ + u.qb * 256;
        const int NT = u.samp ? 17 : 4 * u.qb + 4;
        const int lim = u.samp ? (c.wid == 0 ? 16 : -1) : 4 * u.qb + (c.wid >> 1);
        const int nkeys = u.samp ? NKS : NT * 64;
        const bool act = lim >= 0;
        const bf16_t* Kp = u.samp ? KsN + (size_t)u.sbb * NKSP * D + u.h * 128 : KN + (size_t)u.b * SEQ * D + u.h * 128;
        const bf16_t* Krp = u.samp ? KRs + (size_t)u.sbb * NKSP * 64 : KR + (size_t)u.b * SEQ * 64;
        const bf16_t* Vp = u.samp ? VsB + (size_t)u.sbb * NKSP * D + u.h * 128 : VB + (size_t)u.b * SEQ * D + u.h * 128;
        f32x16 o[4];
        attn_unit_np<192>(QB + (size_t)row0 * 1536 + u.h * 192, 1536, Kp, D, Krp, Vp, D, NT, lim, nkeys, lds, o, 0.07216878364870322f);
        if (act && (!dummy || o[0][0] == 1.2345e-37f)) {
            unsigned ebase = (unsigned)((row0 + c.wid * 32 + 4 * c.hi) * D + u.h * 128 + c.r32);
            asm volatile("" : "+v"(ebase));
#pragma unroll
            for (int r = 0; r < 16; ++r)
#pragma unroll
                for (int d = 0; d < 4; ++d) AO[ebase + (unsigned)(((r & 3) + 8 * (r >> 2)) * D + d * 32)] = f2bf(o[d][r]);
        }
    }
    __builtin_amdgcn_s_setprio(0);
}
__device__ __forceinline__ void ph_mix_out(const Args& a, LAS unsigned char* lds, size_t a_off, size_t w_off, int K, int lda, int apn, int so) {
    const Ctx c = mkctx(a);
    pg8::Gemm g{(bf16_t*)(c.big + a_off), c.wmix + w_off, M, 1024, K, lda, apn}; pg8::StaticOrder S; S.init(M, 1024, c.G, c.bid);
    EpiResidT<false> E{nullptr, nullptr, c.Xb, ssqb(c, so)};
    pg8::gemm_phase(lds, g, S, E);
}

__device__ __forceinline__ void ph_l2_in(const Args& a, LAS unsigned char* lds) {
    const Ctx c = mkctx(a);
    pg8::Gemm g{c.Xb, c.wmix + W_CIN, M, 3072, 1024, 1024, 0}; pg8::StaticOrder S; S.init(M, 3072, c.G, c.bid);
    EpiBf16 E{(bf16_t*)(c.big + B2_CIN), 3072, ssqb(c, 4), nullptr, nullptr, 0};
    pg8::gemm_phase(lds, g, S, E);
}
__device__ __forceinline__ void ph_l2_conv(const Args& a) {
    const Ctx c = mkctx(a);
    const bf16_t* CIN = (const bf16_t*)(c.big + B2_CIN); bf16_t* CP = (bf16_t*)(c.big + B2_CP);
    const float* state_c = INP(6); const float* cw = INP(24);
    const long ntask = (long)(M / 4) * (D / 8);
    for (long t = c.gt; t < ntask; t += c.NTH) {
        const int cch = (int)(t % (D / 8)), rb = (int)(t / (D / 8)), r0 = rb * 4, c0 = cch * 8;
        const bool samp = r0 >= MP;
        const int spos = samp ? ((r0 - MP) & 31) : (r0 & (SEQ - 1));
        const int sbb = (r0 - MP) >> 5, bb_ = r0 >> 14;
        float z[6][8];
#pragma unroll
        for (int k = 0; k < 6; ++k) {
            if (k >= 2 || spos != 0) { float gc[8], vv[8]; const bf16_t* rp_ = CIN + (size_t)(r0 - 2 + k) * 3072 + c0;
                unpack8(*(const GAS u32x4*)(rp_ + 1024), gc); unpack8(*(const GAS u32x4*)(rp_ + 2048), vv);
#pragma unroll
                for (int e = 0; e < 8; ++e) z[k][e] = gc[e] * vv[e]; }
            else if (samp) {
#pragma unroll
                for (int e = 0; e < 8; ++e) z[k][e] = state_c[(size_t)(sbb * 2 + k) * D + c0 + e]; }
            else {
#pragma unroll
                for (int e = 0; e < 8; ++e) z[k][e] = 0.f; }
        }
        float w0[8], w1[8], w2[8];
#pragma unroll
        for (int e = 0; e < 8; ++e) { w0[e] = cw[c0 + e]; w1[e] = cw[D + c0 + e]; w2[e] = cw[2 * D + c0 + e]; }
#pragma unroll
        for (int j = 0; j < 4; ++j) {
            const int r = r0 + j;
            float gb[8]; unpack8(*(const GAS u32x4*)(CIN + (size_t)r * 3072 + c0), gb);
            float ov[8];
#pragma unroll
            for (int e = 0; e < 8; ++e) ov[e] = gb[e] * (w0[e] * z[j][e] + w1[e] * z[j + 1][e] + w2[e] * z[j + 2][e]);
            u32x4 w; w.x = cvt_pk(ov[0], ov[1]); w.y = cvt_pk(ov[2], ov[3]); w.z = cvt_pk(ov[4], ov[5]); w.w = cvt_pk(ov[6], ov[7]);
            *(GAS u32x4*)(CP + (size_t)r * D + c0) = w;
            float* so = nullptr;
            if (!samp) { const int s = spos + j; if (s >= SEQ - 2) so = c.out + O_CCP + (size_t)(bb_ * 2 + (s - (SEQ - 2))) * D + c0; }
            else { const int tq = spos + j; if (tq >= 30) so = c.out + O_CCS + (size_t)(sbb * 2 + (tq - 30)) * D + c0; }
            if (so) {
#pragma unroll
                for (int e = 0; e < 8; ++e) so[e] = z[j + 2][e]; }
        }
    }
}

__device__ __forceinline__ void ph_l3_rstd(const Args& a) {
    const Ctx c = mkctx(a);
    float* rst = (float*)(c.ws + 65536); const float* sq = ssqb(c, 6);
    for (long r = c.gt; r < M; r += c.NTH) rst[r] = rstd_row(sq, (int)r);
}
__device__ __forceinline__ void ph_l3_pool(const Args& a, LAS unsigned char* lds) {
    const Ctx c = mkctx(a);
    bf16_t* DP = (bf16_t*)c.big;
    const float* rst = (const float*)(c.ws + 65536); const float* gm = INP(9) + 3 * D; const float* state_d = INP(7);
    const long ntask = (long)M * (D / 4);
    for (long t = c.gt; t < ntask; t += c.NTH) {
        const int c0 = (int)(t % (D / 4)) * 4, r = (int)(t / (D / 4));
        const bool samp = r >= MP; const int sr_ = r - MP, sbb = sr_ >> 5;
        const int spos = samp ? (sr_ & 31) : (r & (SEQ - 1));
        const int w = 2 << (c0 >> 8);
        const f32x4 gv = *(const GAS f32x4*)(gm + c0);
        const u32x2 wt = *(const GAS u32x2*)(c.Xb + (size_t)r * D + c0);
        const f32x4 ht = (f32x4){bflo(wt.x), bfhi(wt.x), bflo(wt.y), bfhi(wt.y)} * rst[r] * gv;
        f32x4 sum = ht;
        for (int i = 1; i < w; ++i) {
            const int sp = spos - i;
            if (sp >= 0) { const u32x2 wi = *(const GAS u32x2*)(c.Xb + (size_t)(r - i) * D + c0); sum += (f32x4){bflo(wi.x), bfhi(wi.x), bflo(wi.y), bfhi(wi.y)} * rst[r - i] * gv; }
            else if (samp) sum += *(const GAS f32x4*)(state_d + (size_t)(sbb * 15 + 15 + sp) * D + c0);
        }
        const float cnt = samp ? (float)w : (float)((spos + 1) < w ? (spos + 1) : w);
        const f32x4 dp = sum / cnt - ht;
        *(GAS u32x2*)(DP + (size_t)r * D + c0) = pack4(dp);
        if (!samp) { if (spos >= SEQ - 15) *(GAS f32x4*)(c.out + O_DPP + (size_t)((r >> 14) * 15 + (spos - (SEQ - 15))) * D + c0) = ht; }
        else { if (spos >= 17) *(GAS f32x4*)(c.out + O_DPS + (size_t)(sbb * 15 + (spos - 17)) * D + c0) = ht; }
    }
}
__device__ __forceinline__ void ph_final(const Args& a) {
    const Ctx c = mkctx(a);
    const float* sq = ssqb(c, 8); const float* gf = INP(11);
    for (int r = c.gw; r < M; r += c.NWV) {
        const float rs = rstd_row(sq, r);
#pragma unroll
        for (int j = 0; j < 4; ++j) { const int cc_ = j * 256 + c.lane * 4; const u32x2 w = *(const GAS u32x2*)(c.Xb + (size_t)r * D + cc_);
            const f32x4 xv = {bflo(w.x), bfhi(w.x), bflo(w.y), bfhi(w.y)};
            *(GAS f32x4*)(c.X + (size_t)r * D + cc_) = xv * rs * *(const GAS f32x4*)(gf + cc_); }
    }
}

#ifdef SKIP_PH_PROLOGUE
#define ON_PH_PROLOGUE(x)
#else
#define ON_PH_PROLOGUE(x) x
#endif
#ifdef SKIP_PH_L0_QKV
#define ON_PH_L0_QKV(x)
#else
#define ON_PH_L0_QKV(x) x
#endif
#ifdef SKIP_PH_L0_ATTN
#define ON_PH_L0_ATTN(x)
#else
#define ON_PH_L0_ATTN(x) x
#endif
#ifdef SKIP_PH_L0_OUT
#define ON_PH_L0_OUT(x)
#else
#define ON_PH_L0_OUT(x) x
#endif
#ifdef SKIP_PH_L1_DOWN
#define ON_PH_L1_DOWN(x)
#else
#define ON_PH_L1_DOWN(x) x
#endif
#ifdef SKIP_PH_L1_ROWS
#define ON_PH_L1_ROWS(x)
#else
#define ON_PH_L1_ROWS(x) x
#endif
#ifdef SKIP_PH_L1_UQ
#define ON_PH_L1_UQ(x)
#else
#define ON_PH_L1_UQ(x) x
#endif
#ifdef SKIP_PH_L1_EXPAND
#define ON_PH_L1_EXPAND(x)
#else
#define ON_PH_L1_EXPAND(x) x
#endif
#ifdef SKIP_PH_L1_ATTN
#define ON_PH_L1_ATTN(x)
#else
#define ON_PH_L1_ATTN(x) x
#endif
#ifdef SKIP_PH_MIX_OUT
#define ON_PH_MIX_OUT(x)
#else
#define ON_PH_MIX_OUT(x) x
#endif
#ifdef SKIP_PH_L2_IN
#define ON_PH_L2_IN(x)
#else
#define ON_PH_L2_IN(x) x
#endif
#ifdef SKIP_PH_L2_CONV
#define ON_PH_L2_CONV(x)
#else
#define ON_PH_L2_CONV(x) x
#endif
#ifdef SKIP_PH_L3_POOL
#define ON_PH_L3_POOL(x)
#else
#define ON_PH_L3_POOL(x) x
#endif
#ifdef SKIP_PH_FFN_UP
#define ON_PH_FFN_UP(x)
#else
#define ON_PH_FFN_UP(x) x
#endif
#ifdef SKIP_PH_FFN_CONV
#define ON_PH_FFN_CONV(x)
#else
#define ON_PH_FFN_CONV(x) x
#endif
#ifdef SKIP_PH_FFN_DOWN
#define ON_PH_FFN_DOWN(x)
#else
#define ON_PH_FFN_DOWN(x) x
#endif
#ifdef SKIP_PH_FINAL
#define ON_PH_FINAL(x)
#else
#define ON_PH_FINAL(x) x
#endif
__global__ void __launch_bounds__(NTHREADS, 2) mega_fwd(Args a) {
    extern __shared__ __attribute__((aligned(16))) unsigned char lds_raw[];
    LAS unsigned char* lds = (LAS unsigned char*)lds_raw;
    cg::grid_group grid = cg::this_grid();
    if (gridDim.x == 0xffffffffu) grid.sync();
    int nrep_attn = PROBE_ATTN_REPS; asm volatile("" : "+s"(nrep_attn));
    int nrep_conv = PROBE_CONV_REPS; asm volatile("" : "+s"(nrep_conv));
    int nrep_sync = PROBE_SYNC_REPS; asm volatile("" : "+s"(nrep_sync));
    LAS unsigned* bst = (LAS unsigned*)(lds + 131072 + 2048);
    if (threadIdx.x < 2) bst[threadIdx.x] = 0u;
    __syncthreads();
    unsigned char* wsb = a.ws; asm volatile("" : "+s"(wsb));
    const XcdBarrier xbar = xcd_barrier_post((unsigned*)wsb, (volatile LAS unsigned*)bst);
#define GSYNC() do { for (int q_ = 0; q_ < nrep_sync; ++q_) { xcd_barrier(xbar); } } while (0)
    ON_PH_PROLOGUE(ph_prologue(a, lds);) GSYNC();
#pragma unroll 1
    for (int layer = 0; layer < 4; ++layer) {
        if (layer == 0) {
            ON_PH_L0_QKV(ph_l0_qkv(a, lds);) GSYNC();
            ON_PH_L0_ATTN(for (int rep = nrep_attn - 1; rep >= 0; --rep) ph_l0_attn(a, lds, rep);) GSYNC();
            ON_PH_L0_OUT(ph_l0_out(a, lds);) GSYNC();
        } else if (layer == 1) {
            ON_PH_L1_DOWN(ph_l1_down(a, lds);) GSYNC();
            ON_PH_L1_ROWS(ph_l1_rows(a);) GSYNC();
            ON_PH_L1_UQ(ph_l1_uq(a, lds);) ON_PH_L1_EXPAND(ph_l1_expand(a, lds);) GSYNC();
            ON_PH_L1_ATTN(for (int rep = nrep_attn - 1; rep >= 0; --rep) ph_l1_attn(a, lds, rep);) GSYNC();
            ON_PH_MIX_OUT(ph_mix_out(a, lds, B1_AO, W_OB, 1024, 1024, 0, 3);) GSYNC();
        } else if (layer == 2) {
            ON_PH_L2_IN(ph_l2_in(a, lds);) GSYNC();
            ON_PH_L2_CONV(ph_l2_conv(a);) GSYNC();
            ON_PH_MIX_OUT(ph_mix_out(a, lds, B2_CP, W_COUT, 1024, 1024, 0, 5);) GSYNC();
        } else {
            ON_PH_L3_POOL(ph_l3_rstd(a);) GSYNC();
            ON_PH_L3_POOL(ph_l3_pool(a, lds);) GSYNC();
            ON_PH_MIX_OUT(ph_mix_out(a, lds, 0, W_DG, 256, 1024, 256, 7);) GSYNC();
        }
        ON_PH_FFN_UP(ph_ffn_up(a, lds, layer);) GSYNC();
        ON_PH_FFN_DOWN(ph_ffn_down(a, lds, layer);) GSYNC();
    }
    ON_PH_FINAL(ph_final(a);)
}
extern "C" void kernel_launch(void* const* d_in, const int* in_sizes, int n_in, void* d_out, int out_size, void* d_ws, size_t ws_size, hipStream_t stream) {
    static int grid = 0;
    if (grid == 0) {
        if (n_in != 33 || (size_t)out_size != O_END || ws_size < WS_END) {
            fprintf(stderr, "kernel_launch: shape mismatch n_in %d out %d (want %zu) ws %zu (want %zu)\n", n_in, out_size, (size_t)O_END, ws_size, (size_t)WS_END);
            grid = -1; return; }
        int dev = 0, cus = 0, per_cu = 0;
        hipGetDevice(&dev);
        hipDeviceGetAttribute(&cus, hipDeviceAttributeMultiprocessorCount, dev);
        if (hipFuncSetAttribute((const void*)mega_fwd, hipFuncAttributeMaxDynamicSharedMemorySize, LDS_BYTES) != hipSuccess) { fprintf(stderr, "kernel_launch: hipFuncSetAttribute failed\n"); grid = -1; return; }
        if (hipOccupancyMaxActiveBlocksPerMultiprocessor(&per_cu, (const void*)mega_fwd, NTHREADS, LDS_BYTES) != hipSuccess || per_cu < 1) { fprintf(stderr, "kernel_launch: occupancy query failed (%d)\n", per_cu); per_cu = 1; }
        (void)hipGetLastError();
        grid = cus * 1;
        fprintf(stderr, "kernel_launch: cus %d per_cu %d grid %d\n", cus, per_cu, grid);
    }
    if (grid < 0) return;
    Args a{};
    for (int i = 0; i < 33; ++i) a.in[i] = (const float*)d_in[i];
    a.out = (float*)d_out; a.ws = (unsigned char*)d_ws;
    if (hipMemsetAsync(d_ws, 0, 16384, stream) != hipSuccess) { fprintf(stderr, "kernel_launch: memset failed\n"); return; }
    void* args[] = {&a};
    hipError_t e = hipLaunchCooperativeKernel((const void*)mega_fwd, dim3(grid), dim3(NTHREADS), args, LDS_BYTES, stream);
    if (e != hipSuccess) fprintf(stderr, "kernel_launch: cooperative launch failed: %s (grid %d)\n", hipGetErrorString(e), grid);
}
```

```cpp
#include <hip/hip_runtime.h>
#include <hip/hip_cooperative_groups.h>
#include <cstdio>
#include <cstdint>
namespace cg = cooperative_groups;

#define LAS __attribute__((address_space(3)))
#define GAS __attribute__((address_space(1)))
typedef unsigned short bf16_t;
typedef short bf16x8 __attribute__((ext_vector_type(8)));
typedef short s16x4 __attribute__((ext_vector_type(4)));
typedef float f32x4 __attribute__((ext_vector_type(4)));
typedef float f32x16 __attribute__((ext_vector_type(16)));
typedef unsigned u32x4 __attribute__((ext_vector_type(4)));
typedef unsigned u32x2 __attribute__((ext_vector_type(2)));

constexpr int D = 1024, SEQ = 16384, NBP = 2, MP = NBP * SEQ, SBN = 8, STN = 32, MS = SBN * STN, M = MP + MS;
constexpr int PAST = 1024, NKS = PAST + STN, NKSP = 1152, FF = 2816, MCACHE = SBN * PAST, MX = M + MCACHE;
constexpr float NORM_EPS = 1e-6f;
constexpr int NTHREADS = 512;
constexpr int LDS_BYTES = 131072 + 4096 + 8192;
#ifndef PROBE_CONV_REPS
#define PROBE_CONV_REPS 1
#endif
#ifndef PROBE_SYNC_REPS
#define PROBE_SYNC_REPS 3
#endif
#ifndef PROBE_ATTN_REPS
#define PROBE_ATTN_REPS 1
#endif

constexpr size_t O_Y = 0;
constexpr size_t O_AKP = (size_t)M * D;
constexpr size_t O_AVP = O_AKP + (size_t)MP * D;
constexpr size_t O_BLP = O_AVP + (size_t)MP * D;
constexpr size_t O_BRP = O_BLP + (size_t)MP * 256;
constexpr size_t O_CCP = O_BRP + (size_t)MP * 64;
constexpr size_t O_DPP = O_CCP + (size_t)NBP * 2 * D;
constexpr size_t O_FCP = O_DPP + (size_t)NBP * 15 * D;
constexpr size_t O_AKS = O_FCP + (size_t)4 * NBP * 2 * FF;
constexpr size_t O_AVS = O_AKS + (size_t)MS * D;
constexpr size_t O_BLS = O_AVS + (size_t)MS * D;
constexpr size_t O_BRS = O_BLS + (size_t)MS * 256;
constexpr size_t O_CCS = O_BRS + (size_t)MS * 64;
constexpr size_t O_DPS = O_CCS + (size_t)SBN * 2 * D;
constexpr size_t O_FCS = O_DPS + (size_t)SBN * 15 * D;
constexpr size_t O_END = O_FCS + (size_t)4 * SBN * 2 * FF;

constexpr size_t MiB = 1u << 20;
constexpr size_t WS_SSQ = 0;
constexpr size_t WS_ROPE = 2 * MiB;
constexpr size_t WS_WMIX = 6 * MiB;
constexpr size_t WS_WFFN = 29 * MiB;
constexpr size_t WS_XB = 46 * MiB;
constexpr size_t WS_BIG = 111 * MiB;
constexpr size_t WS_TAIL = 467 * MiB;
constexpr size_t WS_END = 512 * MiB;
constexpr size_t WS_SSQP = WS_TAIL + 38 * MiB;
static_assert((size_t)M * 16 * 4 <= 3 * MiB && WS_SSQP + 6 * MiB <= WS_END, "ssqp");
constexpr size_t W_QKV = 0, W_OA = W_QKV + 3072u * 1024, W_DB = W_OA + 1024u * 1024, W_UQ = W_DB + 768u * 1024, W_UKV = W_UQ + 1536u * 384,
                 W_OB = W_UKV + 2048u * 256, W_CIN = W_OB + 1024u * 1024, W_COUT = W_CIN + 3072u * 1024, W_DG = W_COUT + 1024u * 1024, W_MIX_END = W_DG + 1024u * 256;
static_assert(WS_WMIX + W_MIX_END * 2 <= WS_WFFN, "mixer weights");
constexpr size_t W_GU = 0, W_DN = 5632u * 1024, W_FFN_END = W_DN + 1024u * 2816;
static_assert(WS_WFFN + W_FFN_END * 2 <= WS_XB, "ffn weights");
static_assert(WS_XB + (size_t)M * D * 2 <= WS_BIG, "xb");
static_assert(WS_BIG + (size_t)M * 5632 * 2 <= WS_TAIL, "U");
constexpr size_t B0_Q = 0, B0_K = 65 * MiB, B0_V = 130 * MiB, B0_OS = 195 * MiB;
constexpr size_t B1_DOWN = 0, B1_CQ = 97 * MiB, B1_CKV = 122 * MiB, B1_KN = 143 * MiB, B1_KR = 208 * MiB, B1_V = 213 * MiB, B1_AO = 278 * MiB;
constexpr size_t B2_CIN = 0, B2_CP = 194 * MiB;
static_assert(B0_OS + (size_t)M * D * 4 <= 356 * MiB && B1_AO + 65 * MiB <= 356 * MiB, "big");
static_assert((size_t)MX * 256 * 2 <= 21 * MiB && (size_t)M * 1536 * 2 <= 97 * MiB && (size_t)M * 768 * 4 <= 97 * MiB, "big2");
constexpr size_t T_K = 0, T_V = 18 * MiB, T_KR = 36 * MiB;
static_assert((size_t)SBN * NKSP * D * 2 <= 18 * MiB && WS_TAIL + T_KR + (size_t)SBN * NKSP * 64 * 2 <= WS_END, "tail");

__device__ __forceinline__ unsigned cvt_pk(float lo, float hi) { unsigned r; asm volatile("v_cvt_pk_bf16_f32 %0, %1, %2" : "=v"(r) : "v"(lo), "v"(hi)); return r; }
__device__ __forceinline__ bf16_t f2bf(float f) { return (bf16_t)(cvt_pk(f, 0.f) & 0xffffu); }
__device__ __forceinline__ u32x2 pack4(f32x4 v) { u32x2 w; w.x = cvt_pk(v[0], v[1]); w.y = cvt_pk(v[2], v[3]); return w; }
__device__ __forceinline__ u32x4 pack8(f32x4 a, f32x4 b) { u32x4 w; w.x = cvt_pk(a[0], a[1]); w.y = cvt_pk(a[2], a[3]); w.z = cvt_pk(b[0], b[1]); w.w = cvt_pk(b[2], b[3]); return w; }
__device__ __forceinline__ float bflo(unsigned w) { return __uint_as_float(w << 16); }
__device__ __forceinline__ float bfhi(unsigned w) { return __uint_as_float(w & 0xffff0000u); }
__device__ __forceinline__ void unpack8(u32x4 w, float* f) { f[0] = bflo(w.x); f[1] = bfhi(w.x); f[2] = bflo(w.y); f[3] = bfhi(w.y); f[4] = bflo(w.z); f[5] = bfhi(w.z); f[6] = bflo(w.w); f[7] = bfhi(w.w); }
__device__ __forceinline__ float rstd_of(float ssq) { return rsqrtf(ssq * (1.0f / 1024.0f) + NORM_EPS); }
__device__ __forceinline__ float rstd_row(const float* __restrict__ p, int row) {
    const f32x4* q = (const f32x4*)(p + (size_t)row * 16);
    const f32x4 a = q[0], b = q[1], c = q[2], d = q[3];
    const float s = (((a[0] + a[1]) + (a[2] + a[3])) + ((b[0] + b[1]) + (b[2] + b[3]))) + (((c[0] + c[1]) + (c[2] + c[3])) + ((d[0] + d[1]) + (d[2] + d[3])));
    return rstd_of(s);
}
__device__ __forceinline__ float wave_sum(float v) {
#pragma unroll
    for (int o = 32; o >= 1; o >>= 1) v += __shfl_xor(v, o);
    return v;
}

namespace pg8 {
constexpr int BM = 256, BK = 64, HALF = 128, HTB = HALF * BK * 2, STAGE_BYTES = 8 * HTB, NXCD = 8, WGM = 8;
__host__ __device__ __forceinline__ int lds_byte(int r, int c) { const int st = (r >> 4) * 2 + (c >> 5), rr = r & 15, cc = c & 31, ob = rr * 64 + cc * 2; return st * 1024 + (ob ^ (((ob >> 9) & 1) << 5)); }
__host__ __device__ __forceinline__ void stage_rc(int b, int& R, int& C) { const int st = b / 1024, sb = b % 1024, swz = sb ^ (((sb >> 9) & 1) << 5); R = (st >> 1) * 16 + swz / 64; C = (st & 1) * 32 + (swz % 64) / 2; }
struct Unit { int pm, pn; };
struct Gemm { const bf16_t* A; const bf16_t* Bt; int M, N, K, lda, a_pn_step; int mrows = 256, moff = 0, ldb = 0; };
struct StaticOrder {
    int nM, nN, nwg, G, c;
    __device__ void init(int M_, int N_, int G_, int c_) { nM = M_ / BM; nN = N_ / BM; nwg = nM * nN; G = G_; c = c_; }
    __device__ void init2(int nM_, int nN_, int G_, int c_) { nM = nM_; nN = nN_; nwg = nM * nN; G = G_; c = c_; }
    __device__ bool next(int i, Unit& u) const {
        const long L = (long)i * G + c; if (L >= nwg) return false;
        int wgid = (int)L; { const int q = nwg / NXCD, r = nwg % NXCD, xcd = wgid % NXCD, off = wgid / NXCD; wgid = (xcd < r ? xcd * (q + 1) : r * (q + 1) + (xcd - r) * q) + off; }
        const int nig = WGM * nN, gid = wgid / nig, fm = gid * WGM, gsz = (nM - fm) < WGM ? (nM - fm) : WGM;
        u.pm = fm + ((wgid % nig) % gsz); u.pn = (wgid % nig) / gsz; return true;
    }
};
struct SingleUnit { int pm, pn; __device__ bool next(int i, Unit& u) const { if (i != 0) return false; u.pm = pm; u.pn = pn; return true; } };
template <class Epi, class Sched>
__device__ __forceinline__ void gemm_phase(LAS unsigned char* lds, const Gemm g, const Sched& S, const Epi& E) {
    int tid = threadIdx.x; asm volatile("" : "+v"(tid));
    const int wid = __builtin_amdgcn_readfirstlane(tid >> 6), lane = tid & 63, wr = wid >> 2, wc = wid & 3, fr = lane & 15, fq = lane >> 4;
    const int K = g.K, nt = K / BK;
    unsigned voffA[2], voffB[2];
#pragma unroll
    for (int i = 0; i < 2; ++i) { int R, C; stage_rc(tid * 16 + i * 8192, R, C); voffA[i] = (unsigned)(R * g.lda + C) * 2u; voffB[i] = (unsigned)(R * (g.ldb ? g.ldb : K) + C) * 2u; }
    const size_t kstep = (size_t)(BK * 2);
    const size_t hstepA = (size_t)HALF * g.lda * 2, hstepB = (size_t)HALF * (g.ldb ? g.ldb : K) * 2;
    const size_t tstepA = (size_t)g.mrows * g.lda * 2, tstepB = 2 * hstepB, apn = (size_t)g.a_pn_step * 2;
    const char* const Abase = (const char*)g.A + (long)g.moff * g.lda * 2;
    const unsigned ldsw = (unsigned)wid * 1024u;
    const int aoff = lds_byte(wr * 64 + fr, fq * 8), boff = lds_byte(wc * 32 + fr, fq * 8);
#define PG8_SA(b, h) (((b) * 2 + (h)) * HTB)
#define PG8_SB(b, h) ((4 + (b) * 2 + (h)) * HTB)
#define PG8_STAGE(bufoff, gbase, voff) do { _Pragma("unroll") for (int _i = 0; _i < 2; ++_i) \
        __builtin_amdgcn_global_load_lds((const unsigned*)((const char*)(gbase) + (voff)[_i]), (LAS unsigned*)(lds + (bufoff) + ldsw + _i * 8192), 16, 0, 0); } while (0)
#define PG8_LDA(dst, b, h) do { _Pragma("unroll") for (int m = 0; m < 4; ++m) _Pragma("unroll") for (int k = 0; k < 2; ++k) dst[m][k] = *(const LAS bf16x8*)(lds + PG8_SA(b, h) + aoff + m * 2048 + k * 1024); } while (0)
#define PG8_LDB(dst, b, h) do { _Pragma("unroll") for (int n = 0; n < 2; ++n) _Pragma("unroll") for (int k = 0; k < 2; ++k) dst[n][k] = *(const LAS bf16x8*)(lds + PG8_SB(b, h) + boff + n * 2048 + k * 1024); } while (0)
#define PG8_MMA(ai, bj, At, Bt) do { __builtin_amdgcn_s_setprio(1); _Pragma("unroll") for (int m = 0; m < 4; ++m) _Pragma("unroll") for (int n = 0; n < 2; ++n) _Pragma("unroll") for (int k = 0; k < 2; ++k) \
        acc[ai][bj][m][n] = __builtin_amdgcn_mfma_f32_16x16x32_bf16(Bt[n][k], At[m][k], acc[ai][bj][m][n], 0, 0, 0); __builtin_amdgcn_s_setprio(0); } while (0)
#define PG8_WAIT_V(n) asm volatile("s_waitcnt vmcnt(" #n ")" ::: "memory")
#define PG8_WAIT_L(n) asm volatile("s_waitcnt lgkmcnt(" #n ")" ::: "memory")
#define PG8_BAR __builtin_amdgcn_s_barrier()
#define PG8_SCHED __builtin_amdgcn_sched_barrier(0)
    Unit cur, nxt; int ui = 0;
    if (!S.next(0, cur)) return;
    f32x4 acc[2][2][4][2];
#pragma unroll
    for (int a = 0; a < 2; ++a)
#pragma unroll
        for (int b = 0; b < 2; ++b)
#pragma unroll
            for (int m = 0; m < 4; ++m)
#pragma unroll
                for (int n = 0; n < 2; ++n) acc[a][b][m][n] = (f32x4){0.f, 0.f, 0.f, 0.f};
    bf16x8 At[4][2], B0[2][2], B1[2][2];
    const char* cA = Abase + (size_t)cur.pm * tstepA + (size_t)cur.pn * apn; const char* cB = (const char*)g.Bt + (size_t)cur.pn * tstepB;
    PG8_STAGE(PG8_SB(0, 0), cB, voffB); PG8_STAGE(PG8_SB(0, 1), cB + hstepB, voffB); PG8_STAGE(PG8_SA(0, 0), cA, voffA); PG8_STAGE(PG8_SA(0, 1), cA + hstepA, voffA);
    if (wr == 1) PG8_BAR;
    PG8_WAIT_V(2); PG8_BAR;
    PG8_STAGE(PG8_SB(1, 0), cB + kstep, voffB); PG8_STAGE(PG8_SA(1, 0), cA + kstep, voffA); PG8_STAGE(PG8_SB(1, 1), cB + hstepB + kstep, voffB);
    PG8_WAIT_V(6); PG8_BAR;
    for (;;) {
        const bool has_next = S.next(ui + 1, nxt);
        const char* nA = has_next ? Abase + (size_t)nxt.pm * tstepA + (size_t)nxt.pn * apn : cA; const char* nB = has_next ? (const char*)g.Bt + (size_t)nxt.pn * tstepB : cB;
#pragma unroll 1
        for (int t = 0; t < nt; t += 2) {
            const bool last = (t == nt - 2);
            const char* a1 = cA + (size_t)(t + 1) * kstep;
            const char* a2 = last ? nA : cA + (size_t)(t + 2) * kstep; const char* b2 = last ? nB : cB + (size_t)(t + 2) * kstep;
            const char* a3 = a2 + kstep; const char* b3 = b2 + kstep;
            PG8_LDB(B0, 0, 0); PG8_LDB(B1, 0, 1); PG8_SCHED; PG8_LDA(At, 0, 0); PG8_STAGE(PG8_SA(1, 1), a1 + hstepA, voffA);
            PG8_WAIT_V(8); PG8_WAIT_L(0); PG8_BAR; PG8_MMA(0, 0, At, B0); PG8_MMA(0, 1, At, B1); PG8_BAR; PG8_SCHED;
            PG8_LDA(At, 0, 1); PG8_STAGE(PG8_SB(0, 0), b2, voffB); PG8_STAGE(PG8_SB(0, 1), b2 + hstepB, voffB); PG8_STAGE(PG8_SA(0, 0), a2, voffA);
            PG8_WAIT_V(8); PG8_WAIT_L(0); PG8_BAR; PG8_MMA(1, 0, At, B0); PG8_MMA(1, 1, At, B1); PG8_BAR; PG8_SCHED;
            PG8_LDB(B0, 1, 0); PG8_LDB(B1, 1, 1); PG8_SCHED; PG8_LDA(At, 1, 0); PG8_STAGE(PG8_SA(0, 1), a2 + hstepA, voffA);
            PG8_WAIT_V(8); PG8_WAIT_L(0); PG8_BAR; PG8_MMA(0, 0, At, B0); PG8_MMA(0, 1, At, B1); PG8_BAR; PG8_SCHED;
            PG8_LDA(At, 1, 1); PG8_STAGE(PG8_SB(1, 0), b3, voffB); PG8_STAGE(PG8_SB(1, 1), b3 + hstepB, voffB); PG8_STAGE(PG8_SA(1, 0), a3, voffA);
            PG8_WAIT_V(8); PG8_WAIT_L(0); PG8_BAR; PG8_MMA(1, 0, At, B0); PG8_MMA(1, 1, At, B1); PG8_BAR; PG8_SCHED;
        }
        if (wr == 0) PG8_BAR;
        E(acc, cur, wr, wc, fr, fq);
        if (!has_next) break;
#pragma unroll
        for (int a = 0; a < 2; ++a)
#pragma unroll
            for (int b = 0; b < 2; ++b)
#pragma unroll
                for (int m = 0; m < 4; ++m)
#pragma unroll
                    for (int n = 0; n < 2; ++n) acc[a][b][m][n] = (f32x4){0.f, 0.f, 0.f, 0.f};
        cur = nxt; cA = nA; cB = nB; ++ui;
        if (wr == 1) PG8_BAR;
    }
    PG8_WAIT_V(0);
    PG8_BAR;
#undef PG8_SA
#undef PG8_SB
#undef PG8_STAGE
#undef PG8_LDA
#undef PG8_LDB
#undef PG8_MMA
#undef PG8_WAIT_V
#undef PG8_WAIT_L
#undef PG8_BAR
#undef PG8_SCHED
}
}
using pg8::Unit;
typedef f32x4 Acc[2][2][4][2];

struct EpiBf16 {
    bf16_t* O; int ldc; const float* ssq; float* tap_p; float* tap_s; int tap_cols;
    __device__ __forceinline__ void operator()(const Acc& acc, const Unit& u, int wr, int wc, int fr, int fq) const {
#pragma unroll
        for (int ai = 0; ai < 2; ++ai)
#pragma unroll
            for (int m = 0; m < 4; ++m) {
                asm volatile("" ::: "memory");
                const int row = u.pm * 256 + ai * 128 + wr * 64 + m * 16 + fr;
                const float rs = ssq ? rstd_row(ssq, row) : 1.f;
                float* trow = nullptr;
                if (tap_cols) {
                    if (row < MP) { const int s = row & (SEQ - 1); if (s >= SEQ - 2) trow = tap_p + (size_t)((row >> 14) * 2 + (s - (SEQ - 2))) * FF; }
                    else { const int t = (row - MP) & 31; if (t >= 30) trow = tap_s + (size_t)(((row - MP) >> 5) * 2 + (t - 30)) * FF; }
                }
#pragma unroll
                for (int bj = 0; bj < 2; ++bj) {
                    const int col0 = u.pn * 256 + bj * 128 + wc * 32 + fq * 8;
                    const f32x4 v0 = acc[ai][bj][m][0] * rs, v1 = acc[ai][bj][m][1] * rs;
                    *(GAS u32x4*)(O + (size_t)row * ldc + col0) = pack8(v0, v1);
                    if (trow && col0 < tap_cols) { *(GAS f32x4*)(trow + col0) = v0; *(GAS f32x4*)(trow + col0 + 4) = v1; }
                }
            }
    }
};
struct EpiF32 {
    float* O; int ldc; const float* ssq;
    __device__ __forceinline__ void operator()(const Acc& acc, const Unit& u, int wr, int wc, int fr, int fq) const {
#pragma unroll
        for (int ai = 0; ai < 2; ++ai)
#pragma unroll
            for (int m = 0; m < 4; ++m) {
                asm volatile("" ::: "memory");
                const int row = u.pm * 256 + ai * 128 + wr * 64 + m * 16 + fr;
                const float rs = rstd_row(ssq, row);
#pragma unroll
                for (int bj = 0; bj < 2; ++bj) {
                    const int col0 = u.pn * 256 + bj * 128 + wc * 32 + fq * 8;
                    *(GAS f32x4*)(O + (size_t)row * ldc + col0) = acc[ai][bj][m][0] * rs;
                    *(GAS f32x4*)(O + (size_t)row * ldc + col0 + 4) = acc[ai][bj][m][1] * rs;
                }
            }
    }
};
struct EpiSlab {
    float* P;
    __device__ __forceinline__ void operator()(const Acc& acc, const Unit& u, int wr, int wc, int fr, int fq) const {
#pragma unroll
        for (int ai = 0; ai < 2; ++ai)
#pragma unroll
            for (int m = 0; m < 4; ++m) {
                const int row_l = ai * 128 + wr * 64 + m * 16 + fr;
#pragma unroll
                for (int bj = 0; bj < 2; ++bj) {
                    const int col_l = bj * 128 + wc * 32 + fq * 8;
                    *(GAS f32x4*)(P + row_l * 256 + col_l) = acc[ai][bj][m][0]; *(GAS f32x4*)(P + row_l * 256 + col_l + 4) = acc[ai][bj][m][1];
                }
            }
    }
};
template <bool F32IN> struct EpiResidT {
    const float* rp; const float* rsm; bf16_t* Xb; float* ssq_out;
    __device__ __forceinline__ void operator()(const Acc& acc, const Unit& u, int wr, int wc, int fr, int fq) const {
#pragma unroll
        for (int ai = 0; ai < 2; ++ai)
#pragma unroll
            for (int m = 0; m < 4; ++m) {
                asm volatile("" ::: "memory");
                const int row = u.pm * 256 + ai * 128 + wr * 64 + m * 16 + fr;
                float ss = 0.f;
#pragma unroll
                for (int bj = 0; bj < 2; ++bj) {
                    const int col0 = u.pn * 256 + bj * 128 + wc * 32 + fq * 8;
                    f32x4 r0, r1;
                    if (F32IN) { const float* rrow = (row < MP) ? rp + (size_t)row * D : rsm + (size_t)(row - MP) * D; r0 = *(const GAS f32x4*)(rrow + col0); r1 = *(const GAS f32x4*)(rrow + col0 + 4); }
                    else { const u32x4 w = *(const GAS u32x4*)(Xb + (size_t)row * D + col0); r0 = (f32x4){bflo(w.x), bfhi(w.x), bflo(w.y), bfhi(w.y)}; r1 = (f32x4){bflo(w.z), bfhi(w.z), bflo(w.w), bfhi(w.w)}; }
                    const f32x4 v0 = r0 + acc[ai][bj][m][0], v1 = r1 + acc[ai][bj][m][1];
                    *(GAS u32x4*)(Xb + (size_t)row * D + col0) = pack8(v0, v1);
                    ss += (v0[0] * v0[0] + v0[1] * v0[1]) + (v0[2] * v0[2] + v0[3] * v0[3]) + (v1[0] * v1[0] + v1[1] * v1[1]) + (v1[2] * v1[2] + v1[3] * v1[3]);
                }
                ss += __shfl_xor(ss, 16); ss += __shfl_xor(ss, 32);
                if (fq == 0) ssq_out[(size_t)row * 16 + u.pn * 4 + wc] = ss;
            }
    }
};

__device__ __forceinline__ float dpp_shr1(float oldv, float x) { return __int_as_float(__builtin_amdgcn_update_dpp(__float_as_int(oldv), __float_as_int(x), 0x111, 0xf, 0xf, false)); }
__device__ __forceinline__ float dpp_shr2(float oldv, float x) { return __int_as_float(__builtin_amdgcn_update_dpp(__float_as_int(oldv), __float_as_int(x), 0x112, 0xf, 0xf, false)); }
__device__ __forceinline__ float dpp_ror1(float x) { return __int_as_float(__builtin_amdgcn_update_dpp(0, __float_as_int(x), 0x121, 0xf, 0xf, false)); }
__device__ __forceinline__ float dpp_ror2(float x) { return __int_as_float(__builtin_amdgcn_update_dpp(0, __float_as_int(x), 0x122, 0xf, 0xf, false)); }
struct EpiFfn {
    bf16_t* ACT; const float* ssq; const float* cw; const float* cb; const float* st; float* tap_p; float* tap_s; LAS unsigned char* slab;
    __device__ __forceinline__ void operator()(Acc& acc, const Unit& u, int wr, int wc, int fr, int fq) const {
        asm volatile("" : "+v"(fr), "+v"(fq), "+s"(wr), "+s"(wc));
        const int r_lo = u.pm * 254 - 2;
        const bool has_start = (r_lo <= 0) || (r_lo <= SEQ && r_lo + 255 >= SEQ) || (r_lo + 255 >= MP);
        LAS float* rl = (LAS float*)(slab + 6144);
        { const int t_ = (wr * 4 + wc) * 64 + fq * 16 + fr, rw = t_ >> 1;
          const float* pp = ssq + (size_t)(r_lo + rw) * 16 + (t_ & 1) * 8;
          const f32x4 a_ = *(const GAS f32x4*)pp, b_ = *(const GAS f32x4*)(pp + 4);
          float sm = ((a_[0] + a_[1]) + (a_[2] + a_[3])) + ((b_[0] + b_[1]) + (b_[2] + b_[3]));
          sm += __shfl_xor(sm, 1);
          if ((t_ & 1) == 0) rl[rw] = rstd_of(sm); }
        asm volatile("s_waitcnt lgkmcnt(0)" ::: "memory"); __builtin_amdgcn_s_barrier(); asm volatile("" ::: "memory");
#pragma unroll
        for (int ai = 0; ai < 2; ++ai)
#pragma unroll
            for (int m = 0; m < 4; ++m) { const float rs = rl[ai * 128 + wr * 64 + m * 16 + fr];
#pragma unroll
                for (int bj = 0; bj < 2; ++bj) { acc[ai][bj][m][0] = acc[ai][bj][m][0] * rs; acc[ai][bj][m][1] = acc[ai][bj][m][1] * rs; } }
        LAS f32x4* sl = (LAS f32x4*)slab;
        if (fr >= 14) {
#pragma unroll
            for (int ai = 0; ai < 2; ++ai)
#pragma unroll
                for (int bj = 0; bj < 2; ++bj) sl[((((ai * 2 + wr) * 4 + wc) * 2 + bj) * 2 + (fr - 14)) * 4 + fq] = acc[ai][bj][3][0];
        }
        asm volatile("s_waitcnt lgkmcnt(0)" ::: "memory"); __builtin_amdgcn_s_barrier(); asm volatile("" ::: "memory");
#pragma unroll
        for (int bj = 0; bj < 2; ++bj) {
            const int cbase = u.pn * 128 + bj * 64 + wc * 16 + fq * 4;
            u32x2 wq0, wq1, wq2, wqb;
            { const f32x4 t0 = *(const GAS f32x4*)(cw + cbase), t1 = *(const GAS f32x4*)(cw + FF + cbase), t2 = *(const GAS f32x4*)(cw + 2 * FF + cbase), tb = *(const GAS f32x4*)(cb + cbase);
              wq0 = pack4(t0); wq1 = pack4(t1); wq2 = pack4(t2); wqb = pack4(tb); }
#pragma unroll
            for (int ai = 0; ai < 2; ++ai) {
                asm volatile("" ::: "memory");
                f32x4 H = {0.f, 0.f, 0.f, 0.f};
                if ((ai | wr) != 0 && fr >= 14) { const int sai = wr ? ai : ai - 1, swr = wr ? 0 : 1; H = sl[((((sai * 2 + swr) * 4 + wc) * 2 + bj) * 2 + (fr - 14)) * 4 + fq]; }
                f32x4 uprev = H;
#pragma unroll
                for (int m = 0; m < 4; ++m) {
                    asm volatile("" ::: "memory");
                    const int row_l = ai * 128 + wr * 64 + m * 16 + fr, grow = r_lo + row_l;
                    const f32x4 uu = acc[ai][bj][m][0], up = acc[ai][bj][m][1];
                    f32x4 p1, p2;
#pragma unroll
                    for (int i = 0; i < 4; ++i) { p1[i] = dpp_shr1(dpp_ror1(uprev[i]), uu[i]); p2[i] = dpp_shr2(dpp_ror2(uprev[i]), uu[i]); }
                    if (has_start) {
                        const bool samp = grow >= MP;
                        const int sp = samp ? ((grow - MP) & 31) : (grow & (SEQ - 1));
                        if (grow >= 0 && grow < M && sp < 2) {
                            f32x4 h0 = {0.f, 0.f, 0.f, 0.f}, h1 = {0.f, 0.f, 0.f, 0.f};
                            if (samp) { const int sbb = (grow - MP) >> 5; h0 = *(const GAS f32x4*)(st + (size_t)(sbb * 2 + 0) * FF + cbase); h1 = *(const GAS f32x4*)(st + (size_t)(sbb * 2 + 1) * FF + cbase); }
                            if (sp == 0) { p1 = h1; p2 = h0; } else { p2 = h1; }
                        }
                    }
                    f32x4 gs = (f32x4){bflo(wqb.x), bfhi(wqb.x), bflo(wqb.y), bfhi(wqb.y)} + (f32x4){bflo(wq2.x), bfhi(wq2.x), bflo(wq2.y), bfhi(wq2.y)} * uu;
                    gs += (f32x4){bflo(wq1.x), bfhi(wq1.x), bflo(wq1.y), bfhi(wq1.y)} * p1;
                    gs += (f32x4){bflo(wq0.x), bfhi(wq0.x), bflo(wq0.y), bfhi(wq0.y)} * p2;
                    f32x4 act;
#pragma unroll
                    for (int i = 0; i < 4; ++i) act[i] = gs[i] * __builtin_amdgcn_rcpf(1.f + __expf(-gs[i])) * up[i];
                    if (row_l >= 2 && grow < M) {
                        *(GAS u32x2*)(ACT + (size_t)grow * FF + cbase) = pack4(act);
                        float* trow = nullptr;
                        if (grow < MP) { const int s_ = grow & (SEQ - 1); if (s_ >= SEQ - 2) trow = tap_p + (size_t)((grow >> 14) * 2 + (s_ - (SEQ - 2))) * FF; }
                        else { const int t_ = (grow - MP) & 31; if (t_ >= 30) trow = tap_s + (size_t)(((grow - MP) >> 5) * 2 + (t_ - 30)) * FF; }
                        if (trow) *(GAS f32x4*)(trow + cbase) = uu;
                    }
                    uprev = uu;
                }
            }
        }
    }
};
struct EpiQKV {
    const float* ssq; const float* rope; bf16_t* Q; bf16_t* Kb; bf16_t* Vb; bf16_t* Ks; bf16_t* Vs; float* okp; float* ovp; float* oks; float* ovs;
    __device__ __forceinline__ void operator()(const Acc& acc, const Unit& u, int wr, int wc, int fr, int fq) const {
        const int part = u.pn >> 2;
#pragma unroll
        for (int ai = 0; ai < 2; ++ai)
#pragma unroll
            for (int m = 0; m < 4; ++m) {
                asm volatile("" ::: "memory");
                const int row = u.pm * 256 + ai * 128 + wr * 64 + m * 16 + fr;
                const float rs = rstd_row(ssq, row);
                const bool samp = row >= MP;
                const int sr_ = row - MP, sbb = sr_ >> 5, tt = sr_ & 31;
                const int pos = samp ? PAST + tt : (row & (SEQ - 1));
                const size_t crow = (size_t)(sbb * NKSP + PAST + tt);
                if (part < 2) {
                    const int w = wc & 1, d0 = 16 * w + 4 * fq;
                    const f32x4 cs = *(const GAS f32x4*)(rope + (size_t)pos * 64 + d0), sn = *(const GAS f32x4*)(rope + (size_t)pos * 64 + 32 + d0);
#pragma unroll
                    for (int bj = 0; bj < 2; ++bj) {
                        const int lc = ((u.pn & 3) * 256 + bj * 128 + (wc >> 1) * 64) + d0;
                        const f32x4 x1 = acc[ai][bj][m][0] * rs, x2 = acc[ai][bj][m][1] * rs;
                        const f32x4 y1 = x1 * cs - x2 * sn, y2 = x2 * cs + x1 * sn;
                        if (part == 0) {
                            *(GAS u32x2*)(Q + (size_t)row * D + lc) = pack4(y1); *(GAS u32x2*)(Q + (size_t)row * D + lc + 32) = pack4(y2);
                        } else if (!samp) {
                            *(GAS u32x2*)(Kb + (size_t)row * D + lc) = pack4(y1); *(GAS u32x2*)(Kb + (size_t)row * D + lc + 32) = pack4(y2);
                            *(GAS f32x4*)(okp + (size_t)row * D + lc) = y1; *(GAS f32x4*)(okp + (size_t)row * D + lc + 32) = y2;
                        } else {
                            *(GAS u32x2*)(Ks + crow * D + lc) = pack4(y1); *(GAS u32x2*)(Ks + crow * D + lc + 32) = pack4(y2);
                            *(GAS f32x4*)(oks + (size_t)sr_ * D + lc) = y1; *(GAS f32x4*)(oks + (size_t)sr_ * D + lc + 32) = y2;
                        }
                    }
                } else {
#pragma unroll
                    for (int bj = 0; bj < 2; ++bj) {
                        const int lc = (u.pn & 3) * 256 + bj * 128 + wc * 32 + fq * 8;
                        const f32x4 v0 = acc[ai][bj][m][0] * rs, v1 = acc[ai][bj][m][1] * rs;
                        if (!samp) {
                            *(GAS u32x4*)(Vb + (size_t)row * D + lc) = pack8(v0, v1);
                            *(GAS f32x4*)(ovp + (size_t)row * D + lc) = v0; *(GAS f32x4*)(ovp + (size_t)row * D + lc + 4) = v1;
                        } else {
                            *(GAS u32x4*)(Vs + crow * D + lc) = pack8(v0, v1);
                            *(GAS f32x4*)(ovs + (size_t)sr_ * D + lc) = v0; *(GAS f32x4*)(ovs + (size_t)sr_ * D + lc + 4) = v1;
                        }
                    }
                }
            }
    }
};
struct EpiUQ {
    const float* rope; bf16_t* QB;
    __device__ __forceinline__ void operator()(const Acc& acc, const Unit& u, int wr, int wc, int fr, int fq) const {
#pragma unroll
        for (int ai = 0; ai < 2; ++ai)
#pragma unroll
            for (int m = 0; m < 4; ++m) {
                asm volatile("" ::: "memory");
                const int row = u.pm * 256 + ai * 128 + wr * 64 + m * 16 + fr;
                const int pos = row >= MP ? PAST + ((row - MP) & 31) : (row & (SEQ - 1));
#pragma unroll
                for (int bj = 0; bj < 2; ++bj) {
                    const int G = u.pn * 4 + bj * 2 + (wc >> 1);
                    if (G % 3 == 2) {
                        const int d0 = 16 * (wc & 1) + 4 * fq, lc = G * 64 + d0;
                        const f32x4 cs = *(const GAS f32x4*)(rope + (size_t)pos * 64 + d0), sn = *(const GAS f32x4*)(rope + (size_t)pos * 64 + 32 + d0);
                        const f32x4 x1 = acc[ai][bj][m][0], x2 = acc[ai][bj][m][1];
                        *(GAS u32x2*)(QB + (size_t)row * 1536 + lc) = pack4(x1 * cs - x2 * sn); *(GAS u32x2*)(QB + (size_t)row * 1536 + lc + 32) = pack4(x2 * cs + x1 * sn);
                    } else {
                        const int lc = u.pn * 256 + bj * 128 + wc * 32 + fq * 8;
                        *(GAS u32x4*)(QB + (size_t)row * 1536 + lc) = pack8(acc[ai][bj][m][0], acc[ai][bj][m][1]);
                    }
                }
            }
    }
};
struct EpiExpand {
    bf16_t* KN; bf16_t* VB; bf16_t* KsN; bf16_t* VsB;
    __device__ __forceinline__ void operator()(const Acc& acc, const Unit& u, int wr, int wc, int fr, int fq) const {
        const bool isk = u.pn < 4;
        bf16_t* const pbase = isk ? KN : VB; bf16_t* const sbase = isk ? KsN : VsB;
#pragma unroll
        for (int ai = 0; ai < 2; ++ai)
#pragma unroll
            for (int m = 0; m < 4; ++m) {
                asm volatile("" ::: "memory");
                const int row = u.pm * 256 + ai * 128 + wr * 64 + m * 16 + fr;
                int cr = row;
                if (row >= M) { const int s = row - M; cr = (s >> 10) * NKSP + (s & 1023); }
                else if (row >= MP) { const int s = row - MP; cr = (s >> 5) * NKSP + PAST + (s & 31); }
                bf16_t* dst = (row < MP ? pbase : sbase) + (size_t)cr * D;
#pragma unroll
                for (int bj = 0; bj < 2; ++bj) {
                    const int lc = (u.pn & 3) * 256 + bj * 128 + wc * 32 + fq * 8;
                    *(GAS u32x4*)(dst + lc) = pack8(acc[ai][bj][m][0], acc[ai][bj][m][1]);
                }
            }
    }
};

__device__ __forceinline__ void prep_w(LAS float* tile, const float* __restrict__ W, int ldw, int K, int nsrc, bf16_t* __restrict__ Bt, int nrows,
                                       int ropemode, int ropeG, const float* __restrict__ ks, int kper, float kmul, const float* __restrict__ ns, int rank = -1, int nwork = 0) {
    if (rank < 0) { rank = blockIdx.x; nwork = gridDim.x; }
    int tid = threadIdx.x; asm volatile("" : "+v"(tid));
    const int nkt = K / 64, nnt = nrows / 64;
    for (int t = rank; t < nkt * nnt; t += nwork) {
        const int kt = t % nkt, ntl = t / nkt, k0 = kt * 64, n0 = ntl * 64;
        {
            const int kk = tid >> 3, c8 = (tid & 7) * 8;
            f32x4 a = {0.f, 0.f, 0.f, 0.f}, b = {0.f, 0.f, 0.f, 0.f};
            if (n0 < nsrc) {
                a = *(const GAS f32x4*)(W + (size_t)(k0 + kk) * ldw + n0 + c8); b = *(const GAS f32x4*)(W + (size_t)(k0 + kk) * ldw + n0 + c8 + 4);
                float sc = kmul; if (ks) sc *= ks[(k0 + kk) % kper];
                a = a * sc; b = b * sc;
                if (ns) { a = a * *(const GAS f32x4*)(ns + n0 + c8); b = b * *(const GAS f32x4*)(ns + n0 + c8 + 4); }
            }
            LAS float* tp = tile + kk * 65 + c8;
            tp[0] = a[0]; tp[1] = a[1]; tp[2] = a[2]; tp[3] = a[3]; tp[4] = b[0]; tp[5] = b[1]; tp[6] = b[2]; tp[7] = b[3];
        }
        __syncthreads();
        {
            const int nl = tid >> 3, kc = (tid & 7) * 8, G = n0 >> 6;
            const bool rp = (ropemode == 1) ? (G < ropeG) : (ropemode == 3 ? (G % 3 == 2) : false);
            const int hi32 = nl >> 5, n = (nl >> 4) & 1, fq = (nl >> 2) & 3, i = nl & 3;
            const int sl = rp ? (32 * n + 16 * hi32 + 4 * fq + i) : (32 * hi32 + 8 * fq + 4 * n + i);
            float v[8];
#pragma unroll
            for (int j = 0; j < 8; ++j) v[j] = tile[(kc + j) * 65 + sl];
            u32x4 w; w.x = cvt_pk(v[0], v[1]); w.y = cvt_pk(v[2], v[3]); w.z = cvt_pk(v[4], v[5]); w.w = cvt_pk(v[6], v[7]);
            *(GAS u32x4*)(Bt + (size_t)(n0 + nl) * K + k0 + kc) = w;
        }
        __syncthreads();
    }
}


__device__ __forceinline__ void prep_gu(LAS float* tile, const float* __restrict__ Wg, const float* __restrict__ Wu, bf16_t* __restrict__ Bt, const float* __restrict__ ks, int rank = -1, int nwork = 0) {
    if (rank < 0) { rank = blockIdx.x; nwork = gridDim.x; }
    int tid = threadIdx.x; asm volatile("" : "+v"(tid));
    constexpr int K = D, nkt = K / 64, nnt = 2 * FF / 64;
    for (int t = rank; t < nkt * nnt; t += nwork) {
        const int kt = t % nkt, ntl = t / nkt, k0 = kt * 64, n0 = ntl * 64, cb0 = (n0 >> 5) * 16;
        {
            const int kk = tid >> 3, c8 = (tid & 7) * 8;
            const float* src = (c8 < 32 ? Wg + cb0 + c8 : Wu + cb0 + (c8 - 32)) + (size_t)(k0 + kk) * FF;
            f32x4 a = *(const GAS f32x4*)src, b = *(const GAS f32x4*)(src + 4);
            const float sc = ks[k0 + kk]; a = a * sc; b = b * sc;
            LAS float* tp = tile + kk * 65 + c8;
            tp[0] = a[0]; tp[1] = a[1]; tp[2] = a[2]; tp[3] = a[3]; tp[4] = b[0]; tp[5] = b[1]; tp[6] = b[2]; tp[7] = b[3];
        }
        __syncthreads();
        {
            const int nl = tid >> 3, kc = (tid & 7) * 8;
            const int sl = ((nl >> 4) & 1) * 32 + (nl >> 5) * 16 + (nl & 15);
            float v[8];
#pragma unroll
            for (int j = 0; j < 8; ++j) v[j] = tile[(kc + j) * 65 + sl];
            u32x4 w; w.x = cvt_pk(v[0], v[1]); w.y = cvt_pk(v[2], v[3]); w.z = cvt_pk(v[4], v[5]); w.w = cvt_pk(v[6], v[7]);
            *(GAS u32x4*)(Bt + (size_t)(n0 + nl) * K + k0 + kc) = w;
        }
        __syncthreads();
    }
}
__device__ __forceinline__ int crow(int r, int hi) { return (r & 3) + 8 * (r >> 2) + 4 * hi; }
#define SBAR() __builtin_amdgcn_sched_barrier(0)
__device__ __forceinline__ void partialSM(f32x16& p0, f32x16& p1, float& m_reg, float& mn, float& alpha, const float C, const float thr_raw) {
    float pmax = p0[0];
#pragma unroll
    for (int r = 1; r < 16; ++r) pmax = fmaxf(pmax, p0[r]);
#pragma unroll
    for (int r = 0; r < 16; ++r) pmax = fmaxf(pmax, p1[r]);
    { auto rr = __builtin_amdgcn_permlane32_swap(__float_as_uint(pmax), __float_as_uint(pmax), false, false);
      pmax = fmaxf(__uint_as_float(rr[0]), __uint_as_float(rr[1])); }
    if (__builtin_expect(__all(pmax - m_reg <= thr_raw), 1)) { mn = m_reg; alpha = 1.f; }
    else { mn = fmaxf(m_reg, pmax); alpha = __builtin_amdgcn_exp2f((m_reg - mn) * C); m_reg = mn; }
    const float mnC = -mn * C;
#pragma unroll
    for (int r = 0; r < 16; ++r) p0[r] = __builtin_amdgcn_exp2f(fmaf(p0[r], C, mnC));
#pragma unroll
    for (int r = 0; r < 16; ++r) p1[r] = __builtin_amdgcn_exp2f(fmaf(p1[r], C, mnC));
}
__device__ __forceinline__ void finishSM(f32x16& p0, f32x16& p1, float alpha, float& l_reg, bf16x8& pa0, bf16x8& pa1, bf16x8& pa2, bf16x8& pa3) {
    float ps = 0;
#pragma unroll
    for (int r = 0; r < 16; ++r) ps += p0[r];
#pragma unroll
    for (int r = 0; r < 16; ++r) ps += p1[r];
    { auto rr = __builtin_amdgcn_permlane32_swap(__float_as_uint(ps), __float_as_uint(ps), false, false);
      ps = __uint_as_float(rr[0]) + __uint_as_float(rr[1]); }
    l_reg = l_reg * alpha + ps;
#define PK4(P, BASE, OUT) do { unsigned a0 = cvt_pk(P[BASE + 0], P[BASE + 1]), a1 = cvt_pk(P[BASE + 2], P[BASE + 3]);   \
    unsigned b0 = cvt_pk(P[BASE + 4], P[BASE + 5]), b1 = cvt_pk(P[BASE + 6], P[BASE + 7]);                              \
    auto r0 = __builtin_amdgcn_permlane32_swap(a0, b0, false, false); auto r1 = __builtin_amdgcn_permlane32_swap(a1, b1, false, false); \
    u32x4 w = {r0[0], r1[0], r0[1], r1[1]}; OUT = *reinterpret_cast<bf16x8*>(&w); } while (0)
    PK4(p0, 0, pa0); PK4(p0, 8, pa1); PK4(p1, 0, pa2); PK4(p1, 8, pa3);
#undef PK4
}
__device__ __forceinline__ int v_st(int k, int c) { const int kk = (k & ~0xC) | ((k & 4) << 1) | ((k & 8) >> 1); return ((kk >> 3) * 4 + (c >> 5)) * 512 + ((kk & 7) * 32 + (c & 31)) * 2; }
__device__ __forceinline__ int v_rd_base(int lane) { return ((lane & 3) << 3) | (((lane >> 2) & 3) << 6) | (((lane >> 4) & 1) << 5) | (((lane >> 5) & 1) << 8); }
constexpr int v_rd_off(int d0, int ks, int half) { return d0 * 512 + ks * 4096 + half * 2048; }
template <int OFF> __device__ __forceinline__ s16x4 tr_read(unsigned vb) {
    s16x4 r; asm volatile("ds_read_b64_tr_b16 %0, %1 offset:%2" : "=&v"(r) : "v"(vb), "i"(OFF) : "memory"); return r;
}
template <int D0> __device__ __forceinline__ void pv_one(f32x16& od, unsigned vb, bf16x8 pa0, bf16x8 pa1, bf16x8 pa2, bf16x8 pa3) {
    const s16x4 l0 = tr_read<v_rd_off(D0, 0, 0)>(vb), h0 = tr_read<v_rd_off(D0, 0, 1)>(vb), l1 = tr_read<v_rd_off(D0, 1, 0)>(vb), h1 = tr_read<v_rd_off(D0, 1, 1)>(vb);
    const s16x4 l2 = tr_read<v_rd_off(D0, 2, 0)>(vb), h2 = tr_read<v_rd_off(D0, 2, 1)>(vb), l3 = tr_read<v_rd_off(D0, 3, 0)>(vb), h3 = tr_read<v_rd_off(D0, 3, 1)>(vb);
    asm volatile("s_waitcnt lgkmcnt(0)" ::: "memory"); SBAR();
#define PKV(L, H) (bf16x8){L[0], L[1], L[2], L[3], H[0], H[1], H[2], H[3]}
    od = __builtin_amdgcn_mfma_f32_32x32x16_bf16(pa0, PKV(l0, h0), od, 0, 0, 0);
    od = __builtin_amdgcn_mfma_f32_32x32x16_bf16(pa1, PKV(l1, h1), od, 0, 0, 0);
    od = __builtin_amdgcn_mfma_f32_32x32x16_bf16(pa2, PKV(l2, h2), od, 0, 0, 0);
    od = __builtin_amdgcn_mfma_f32_32x32x16_bf16(pa3, PKV(l3, h3), od, 0, 0, 0);
#undef PKV
}

__device__ __forceinline__ void partialSM2(f32x16& p0, f32x16& p1, float& m_reg, float& alpha, const float C, const float thr_raw) {
    float pmax = p0[0];
#pragma unroll
    for (int r = 1; r < 16; ++r) pmax = fmaxf(pmax, p0[r]);
#pragma unroll
    for (int r = 0; r < 16; ++r) pmax = fmaxf(pmax, p1[r]);
    { auto rr = __builtin_amdgcn_permlane32_swap(__float_as_uint(pmax), __float_as_uint(pmax), false, false);
      pmax = fmaxf(__uint_as_float(rr[0]), __uint_as_float(rr[1])); }
    float mn;
    if (__builtin_expect(__all(pmax - m_reg <= thr_raw), 1)) { mn = m_reg; alpha = 1.f; }
    else { mn = fmaxf(m_reg, pmax); alpha = __builtin_amdgcn_exp2f((m_reg - mn) * C); m_reg = mn; }
    const float mnC = -mn * C;
    typedef float f32x2 __attribute__((ext_vector_type(2)));
    const f32x2 C2 = {C, C}, M2 = {mnC, mnC};
#pragma unroll
    for (int r = 0; r < 16; r += 2) { f32x2 t = {p0[r], p0[r + 1]}; t = __builtin_elementwise_fma(t, C2, M2); p0[r] = t.x; p0[r + 1] = t.y; }
#pragma unroll
    for (int r = 0; r < 16; r += 2) { f32x2 t = {p1[r], p1[r + 1]}; t = __builtin_elementwise_fma(t, C2, M2); p1[r] = t.x; p1[r + 1] = t.y; }
#pragma unroll
    for (int r = 0; r < 16; ++r) p0[r] = __builtin_amdgcn_exp2f(p0[r]);
}
__device__ __forceinline__ void finishSM2(f32x16& p0, f32x16& p1, float alpha, float& l_reg, bf16x8& pa0, bf16x8& pa1, bf16x8& pa2, bf16x8& pa3) {
#pragma unroll
    for (int r = 0; r < 16; ++r) p1[r] = __builtin_amdgcn_exp2f(p1[r]);
    typedef float f32x2 __attribute__((ext_vector_type(2)));
    f32x2 s2 = {0.f, 0.f};
#pragma unroll
    for (int r = 0; r < 16; r += 2) { const f32x2 t = {p0[r], p0[r + 1]}; s2 += t; }
#pragma unroll
    for (int r = 0; r < 16; r += 2) { const f32x2 t = {p1[r], p1[r + 1]}; s2 += t; }
    float ps = s2.x + s2.y;
    { auto rr = __builtin_amdgcn_permlane32_swap(__float_as_uint(ps), __float_as_uint(ps), false, false);
      ps = __uint_as_float(rr[0]) + __uint_as_float(rr[1]); }
    l_reg = l_reg * alpha + ps;
#define PK4(P, BASE, OUT) do { unsigned a0 = cvt_pk(P[BASE + 0], P[BASE + 1]), a1 = cvt_pk(P[BASE + 2], P[BASE + 3]);   \
    unsigned b0 = cvt_pk(P[BASE + 4], P[BASE + 5]), b1 = cvt_pk(P[BASE + 6], P[BASE + 7]);                              \
    auto r0 = __builtin_amdgcn_permlane32_swap(a0, b0, false, false); auto r1 = __builtin_amdgcn_permlane32_swap(a1, b1, false, false); \
    u32x4 w = {r0[0], r1[0], r0[1], r1[1]}; OUT = *reinterpret_cast<bf16x8*>(&w); } while (0)
    PK4(p0, 0, pa0); PK4(p0, 8, pa1); PK4(p1, 0, pa2); PK4(p1, 8, pa3);
#undef PK4
}
template <int DQK>
__device__ __forceinline__ void attn_unit(const bf16_t* __restrict__ Qp, int ldq, const bf16_t* __restrict__ Kp, int ldk, const bf16_t* __restrict__ Kr,
                                          const bf16_t* __restrict__ Vp, int ldv, const int NT, const int nkw, LAS unsigned char* lds, f32x16 (&o)[4], float scale) {
    constexpr int ND = DQK / 16, KCH = DQK / 64, KRB = DQK * 2, KTB = 64 * KRB, CPR = DQK / 8;
    int tid = threadIdx.x; asm volatile("" : "+v"(tid));
    const int wid = tid >> 6, lane = tid & 63, r32 = lane & 31, hi = lane >> 5;
    LAS unsigned char* Vl = lds; LAS unsigned char* Kl = lds + 32768; LAS float* wsc = (LAS float*)(lds + 32768 + 49152) + wid * 64;
    const float C = scale * 1.4426950408889634f, thr_raw = 8.0f / scale;
    bf16x8 qr[ND];
    {
        const bf16_t* qw = Qp + (size_t)(wid * 32 + r32) * ldq + hi * 8;
#pragma unroll
        for (int d0 = 0; d0 < ND; ++d0) qr[d0] = *(const GAS bf16x8*)(qw + d0 * 16);
    }
    const bf16_t* kp[KCH]; unsigned kl[KCH]; int kst[KCH];
#pragma unroll
    for (int i = 0; i < KCH; ++i) {
        const int q = tid + i * 512, row = q / CPR, cc = q % CPR;
        if (DQK == 192 && cc >= 16) { kp[i] = Kr + (size_t)row * 64 + (cc - 16) * 8; kst[i] = 64 * 64; }
        else { kp[i] = Kp + (size_t)row * ldk + cc * 8; kst[i] = 64 * ldk; }
        kl[i] = (unsigned)(row * KRB + ((cc ^ ((row >> 1) & 7)) << 4));
    }
    const int sr = tid >> 4, sc = (tid & 15) * 8;
    const bf16_t* vp0 = Vp + (size_t)sr * ldv + sc; const bf16_t* vp1 = vp0 + (size_t)32 * ldv; const int vstp = 64 * ldv;
    const int vs0 = v_st(sr, sc), vs1 = v_st(32 + sr, sc);
    const unsigned vbase = (unsigned)(uintptr_t)Vl + (unsigned)v_rd_base(lane);
    const unsigned sw = (unsigned)((r32 >> 1) & 7);
    u32x4 kreg[KCH], vreg0, vreg1;
#define A_SLOAD() do { _Pragma("unroll") for (int i = 0; i < KCH; ++i) { kreg[i] = *(const GAS u32x4*)kp[i]; kp[i] += kst[i]; } \
        vreg0 = *(const GAS u32x4*)vp0; vreg1 = *(const GAS u32x4*)vp1; vp0 += vstp; vp1 += vstp; } while (0)
#define A_SWRITE(b) do { LAS unsigned char* Kn_ = Kl + (b) * KTB; LAS unsigned char* Vn_ = Vl + (b) * 16384; \
        _Pragma("unroll") for (int i = 0; i < KCH; ++i) *(LAS u32x4*)(Kn_ + kl[i]) = kreg[i]; \
        *(LAS u32x4*)(Vn_ + vs0) = vreg0; *(LAS u32x4*)(Vn_ + vs1) = vreg1; } while (0)
#define A_QKT(P0, P1, b) do { LAS unsigned char* Kc_ = Kl + (b) * KTB; \
        _Pragma("unroll") for (int r = 0; r < 16; ++r) { P0[r] = 0.f; P1[r] = 0.f; } \
        _Pragma("unroll") for (int d0 = 0; d0 < ND; ++d0) { const unsigned off_ = (unsigned)(r32 * KRB) + ((((unsigned)(d0 * 2 + hi)) ^ sw) << 4); \
            const bf16x8 b0_ = *(const LAS bf16x8*)(Kc_ + off_); const bf16x8 b1_ = *(const LAS bf16x8*)(Kc_ + off_ + 32 * KRB); \
            P0 = __builtin_amdgcn_mfma_f32_32x32x16_bf16(b0_, qr[d0], P0, 0, 0, 0); P1 = __builtin_amdgcn_mfma_f32_32x32x16_bf16(b1_, qr[d0], P1, 0, 0, 0); } } while (0)
#define A_MASK(P0, P1, j) do { if (((j) + 1) * 64 > nkw) { asm volatile("" ::: "memory"); _Pragma("unroll") for (int r = 0; r < 16; ++r) { const int kb_ = (j) * 64 + crow(r, hi); \
        if (kb_ >= nkw) P0[r] = -1e30f; if (kb_ + 32 >= nkw) P1[r] = -1e30f; } } } while (0)
#define A_RESC(al) do { if (__any((al) < 1.f)) { if (hi == 0) wsc[r32] = (al); asm volatile("s_waitcnt lgkmcnt(0)" ::: "memory"); \
        _Pragma("unroll") for (int r = 0; r < 16; ++r) { const float al_ = wsc[crow(r, hi)]; _Pragma("unroll") for (int d = 0; d < 4; ++d) o[d][r] *= al_; } } } while (0)
#define A_PV(b) do { const unsigned vb_ = vbase + (unsigned)((b) * 16384); \
        pv_one<0>(o[0], vb_, pa0, pa1, pa2, pa3); pv_one<1>(o[1], vb_, pa0, pa1, pa2, pa3); pv_one<2>(o[2], vb_, pa0, pa1, pa2, pa3); pv_one<3>(o[3], vb_, pa0, pa1, pa2, pa3); } while (0)
    float m_reg = -1e30f, l_reg = 0.f;
#pragma unroll
    for (int d = 0; d < 4; ++d)
#pragma unroll
        for (int r = 0; r < 16; ++r) o[d][r] = 0.f;
    f32x16 pA0, pA1, pB0, pB1; float alA, alB; bf16x8 pa0, pa1, pa2, pa3;
    A_SLOAD(); A_SWRITE(0); __syncthreads();
    A_QKT(pA0, pA1, 0); A_MASK(pA0, pA1, 0); partialSM2(pA0, pA1, m_reg, alA, C, thr_raw);
    A_SLOAD(); A_SWRITE(1); __syncthreads();
#pragma unroll 1
    for (int j = 1; j + 1 < NT; j += 2) {
        SBAR(); A_QKT(pB0, pB1, 1);
        finishSM2(pA0, pA1, alA, l_reg, pa0, pa1, pa2, pa3); SBAR();
        A_SLOAD(); SBAR();
        A_PV(0); A_MASK(pB0, pB1, j); partialSM2(pB0, pB1, m_reg, alB, C, thr_raw);
        __syncthreads(); A_SWRITE(0);
        A_RESC(alB); __syncthreads();
        SBAR(); A_QKT(pA0, pA1, 0);
        finishSM2(pB0, pB1, alB, l_reg, pa0, pa1, pa2, pa3); SBAR();
        A_SLOAD(); SBAR();
        A_PV(1); A_MASK(pA0, pA1, j + 1); partialSM2(pA0, pA1, m_reg, alA, C, thr_raw);
        __syncthreads(); A_SWRITE(1);
        A_RESC(alA); __syncthreads();
    }
    SBAR(); A_QKT(pB0, pB1, 1);
    finishSM2(pA0, pA1, alA, l_reg, pa0, pa1, pa2, pa3); SBAR();
    A_PV(0); A_MASK(pB0, pB1, NT - 1); partialSM2(pB0, pB1, m_reg, alB, C, thr_raw);
    A_RESC(alB);
    finishSM2(pB0, pB1, alB, l_reg, pa0, pa1, pa2, pa3); SBAR();
    A_PV(1);
    __syncthreads();
    {
        if (hi == 0) wsc[32 + r32] = l_reg;
        asm volatile("s_waitcnt lgkmcnt(0)" ::: "memory");
#pragma unroll
        for (int r = 0; r < 16; ++r) { const float rl = __builtin_amdgcn_rcpf(wsc[32 + crow(r, hi)]);
#pragma unroll
            for (int d = 0; d < 4; ++d) o[d][r] *= rl; }
    }
#undef A_SLOAD
#undef A_SWRITE
#undef A_QKT
#undef A_MASK
#undef A_RESC
#undef A_PV
}

template <int DQK>
__device__ __forceinline__ void attn_unit_np(const bf16_t* __restrict__ Qp, int ldq, const bf16_t* __restrict__ Kp, int ldk, const bf16_t* __restrict__ Kr,
                                          const bf16_t* __restrict__ Vp, int ldv, int NT, int lim, int nkeys, LAS unsigned char* lds, f32x16 (&o)[4], float scale) {
    constexpr int ND = DQK / 16, KCH = DQK / 64, KRB = DQK * 2, KTB = 64 * KRB, CPR = DQK / 8;
    int tid = threadIdx.x; asm volatile("" : "+v"(tid));
    const int wid = tid >> 6, lane = tid & 63, r32 = lane & 31, hi = lane >> 5;
    LAS unsigned char* Vl = lds; LAS unsigned char* Kl = lds + 32768; LAS float* wsc = (LAS float*)(lds + 32768 + 49152) + wid * 64;
    const float C = scale * 1.4426950408889634f, thr_raw = 8.0f / scale;
    bf16x8 qr[ND];
    if (lim >= 0) {
        const bf16_t* qw = Qp + (size_t)(wid * 32 + r32) * ldq + hi * 8;
#pragma unroll
        for (int d0 = 0; d0 < ND; ++d0) qr[d0] = *(const GAS bf16x8*)(qw + d0 * 16);
    } else {
#pragma unroll
        for (int d0 = 0; d0 < ND; ++d0) qr[d0] = (bf16x8){0, 0, 0, 0, 0, 0, 0, 0};
    }
    const bf16_t* kp[KCH]; unsigned kl[KCH]; int kst[KCH];
#pragma unroll
    for (int i = 0; i < KCH; ++i) {
        const int q = tid + i * 512, row = q / CPR, cc = q % CPR;
        if (DQK == 192 && cc >= 16) { kp[i] = Kr + (size_t)row * 64 + (cc - 16) * 8; kst[i] = 64 * 64; }
        else { kp[i] = Kp + (size_t)row * ldk + cc * 8; kst[i] = 64 * ldk; }
        kl[i] = (unsigned)(row * KRB + ((cc ^ ((row >> 1) & 7)) << 4));
    }
    const int sr = tid >> 4, sc = (tid & 15) * 8;
    const bf16_t* vp0 = Vp + (size_t)sr * ldv + sc; const bf16_t* vp1 = vp0 + (size_t)32 * ldv; const int vstp = 64 * ldv;
    const int vs0 = v_st(sr, sc), vs1 = v_st(32 + sr, sc);
    const unsigned vbase = (unsigned)(uintptr_t)Vl + (unsigned)v_rd_base(lane);
    u32x4 kreg[KCH], vreg0, vreg1;
#pragma unroll
    for (int i = 0; i < KCH; ++i) { kreg[i] = *(const GAS u32x4*)kp[i]; kp[i] += kst[i]; }
    vreg0 = *(const GAS u32x4*)vp0; vreg1 = *(const GAS u32x4*)vp1; vp0 += vstp; vp1 += vstp;
#pragma unroll
    for (int i = 0; i < KCH; ++i) *(LAS u32x4*)(Kl + kl[i]) = kreg[i];
    *(LAS u32x4*)(Vl + vs0) = vreg0; *(LAS u32x4*)(Vl + vs1) = vreg1;
    __syncthreads();
    float m_reg = -1e30f, l_reg = 0.f;
#pragma unroll
    for (int d = 0; d < 4; ++d)
#pragma unroll
        for (int r = 0; r < 16; ++r) o[d][r] = 0.f;
    const unsigned sw = (unsigned)((r32 >> 1) & 7);
    for (int j = 0; j < NT; ++j) {
        const int cur = j & 1;
        const bool more = (j + 1 < NT);
        if (more) {
#pragma unroll
            for (int i = 0; i < KCH; ++i) { kreg[i] = *(const GAS u32x4*)kp[i]; kp[i] += kst[i]; }
            vreg0 = *(const GAS u32x4*)vp0; vreg1 = *(const GAS u32x4*)vp1; vp0 += vstp; vp1 += vstp;
        }
        if (j <= lim) {
            f32x16 p0, p1;
#pragma unroll
            for (int r = 0; r < 16; ++r) { p0[r] = 0.f; p1[r] = 0.f; }
            LAS unsigned char* Kc = Kl + cur * KTB;
#define NP_KOFF(d0) ((unsigned)(r32 * KRB) + ((((unsigned)((d0) * 2 + hi)) ^ sw) << 4))
            bf16x8 kb0[3], kb1[3];
            kb0[0] = *(const LAS bf16x8*)(Kc + NP_KOFF(0)); kb1[0] = *(const LAS bf16x8*)(Kc + NP_KOFF(0) + 32 * KRB);
            if (ND > 1) { kb0[1] = *(const LAS bf16x8*)(Kc + NP_KOFF(1)); kb1[1] = *(const LAS bf16x8*)(Kc + NP_KOFF(1) + 32 * KRB); }
#pragma unroll
            for (int d0 = 0; d0 < ND; ++d0) {
                if (d0 + 2 < ND) { kb0[(d0 + 2) % 3] = *(const LAS bf16x8*)(Kc + NP_KOFF(d0 + 2)); kb1[(d0 + 2) % 3] = *(const LAS bf16x8*)(Kc + NP_KOFF(d0 + 2) + 32 * KRB); }
                SBAR();
                p0 = __builtin_amdgcn_mfma_f32_32x32x16_bf16(kb0[d0 % 3], qr[d0], p0, 0, 0, 0);
                p1 = __builtin_amdgcn_mfma_f32_32x32x16_bf16(kb1[d0 % 3], qr[d0], p1, 0, 0, 0);
                SBAR();
            }
#undef NP_KOFF
            if (j == NT - 1 && nkeys < NT * 64) {
#pragma unroll
                for (int r = 0; r < 16; ++r) { const int kb = j * 64 + crow(r, hi); if (kb >= nkeys) p0[r] = -1e30f; if (kb + 32 >= nkeys) p1[r] = -1e30f; }
            }
            float mn, alpha; bf16x8 pa0, pa1, pa2, pa3;
            partialSM(p0, p1, m_reg, mn, alpha, C, thr_raw);
            finishSM(p0, p1, alpha, l_reg, pa0, pa1, pa2, pa3);
            if (__any(alpha < 1.f)) {
                if (hi == 0) wsc[r32] = alpha;
                asm volatile("s_waitcnt lgkmcnt(0)" ::: "memory");
#pragma unroll
                for (int r = 0; r < 16; ++r) { const float al = wsc[crow(r, hi)];
#pragma unroll
                    for (int d = 0; d < 4; ++d) o[d][r] *= al; }
            }
            const unsigned vb = vbase + (unsigned)(cur * 16384);
            pv_one<0>(o[0], vb, pa0, pa1, pa2, pa3); pv_one<1>(o[1], vb, pa0, pa1, pa2, pa3); pv_one<2>(o[2], vb, pa0, pa1, pa2, pa3); pv_one<3>(o[3], vb, pa0, pa1, pa2, pa3);
        }
        if (more) {
            LAS unsigned char* Kn = Kl + (cur ^ 1) * KTB; LAS unsigned char* Vn = Vl + (cur ^ 1) * 16384;
#pragma unroll
            for (int i = 0; i < KCH; ++i) *(LAS u32x4*)(Kn + kl[i]) = kreg[i];
            *(LAS u32x4*)(Vn + vs0) = vreg0; *(LAS u32x4*)(Vn + vs1) = vreg1;
        }
        __syncthreads();
    }
    if (lim >= 0) {
        if (hi == 0) wsc[32 + r32] = l_reg;
        asm volatile("s_waitcnt lgkmcnt(0)" ::: "memory");
#pragma unroll
        for (int r = 0; r < 16; ++r) { const float rl = __builtin_amdgcn_rcpf(wsc[32 + crow(r, hi)]);
#pragma unroll
            for (int d = 0; d < 4; ++d) o[d][r] *= rl; }
    }
}


template <int D0, int SUB> __device__ __forceinline__ void pv_one128(f32x16& od, unsigned vb, bf16x8 pa0, bf16x8 pa1, bf16x8 pa2, bf16x8 pa3) {
    constexpr int B = SUB * 16384;
    const s16x4 l0 = tr_read<B + v_rd_off(D0, 0, 0)>(vb), h0 = tr_read<B + v_rd_off(D0, 0, 1)>(vb), l1 = tr_read<B + v_rd_off(D0, 1, 0)>(vb), h1 = tr_read<B + v_rd_off(D0, 1, 1)>(vb);
    const s16x4 l2 = tr_read<B + v_rd_off(D0, 2, 0)>(vb), h2 = tr_read<B + v_rd_off(D0, 2, 1)>(vb), l3 = tr_read<B + v_rd_off(D0, 3, 0)>(vb), h3 = tr_read<B + v_rd_off(D0, 3, 1)>(vb);
    asm volatile("s_waitcnt lgkmcnt(0)" ::: "memory"); SBAR();
#define PKV(L, H) (bf16x8){L[0], L[1], L[2], L[3], H[0], H[1], H[2], H[3]}
    od = __builtin_amdgcn_mfma_f32_32x32x16_bf16(pa0, PKV(l0, h0), od, 0, 0, 0);
    od = __builtin_amdgcn_mfma_f32_32x32x16_bf16(pa1, PKV(l1, h1), od, 0, 0, 0);
    od = __builtin_amdgcn_mfma_f32_32x32x16_bf16(pa2, PKV(l2, h2), od, 0, 0, 0);
    od = __builtin_amdgcn_mfma_f32_32x32x16_bf16(pa3, PKV(l3, h3), od, 0, 0, 0);
#undef PKV
}
__device__ __forceinline__ void attn_unit_k128(const bf16_t* __restrict__ Qp, int ldq, const bf16_t* __restrict__ Kp, int ldk, const bf16_t* __restrict__ Vp, int ldv,
                                               const int NT, const int nkw, LAS unsigned char* lds, f32x16 (&o)[4], float scale) {
    constexpr int ND = 4, KRB = 128, KTB = 128 * KRB, VTB = 32768;
    int tid = threadIdx.x; asm volatile("" : "+v"(tid));
    const int wid = tid >> 6, lane = tid & 63, r32 = lane & 31, hi = lane >> 5;
    LAS unsigned char* Vl = lds; LAS unsigned char* Kl = lds + 2 * VTB; LAS float* wsc = (LAS float*)(lds + 2 * VTB + 2 * KTB) + wid * 64;
    const float C = scale * 1.4426950408889634f, thr_raw = 8.0f / scale;
    bf16x8 qr[ND];
    if (nkw > 0) {
        const bf16_t* qw = Qp + (size_t)(wid * 32 + r32) * ldq + hi * 8;
#pragma unroll
        for (int d0 = 0; d0 < ND; ++d0) qr[d0] = *(const GAS bf16x8*)(qw + d0 * 16);
    } else {
#pragma unroll
        for (int d0 = 0; d0 < ND; ++d0) qr[d0] = (bf16x8){0, 0, 0, 0, 0, 0, 0, 0};
    }
    const bf16_t* kp0; unsigned kl0;
    { const int row = tid >> 3, cc = tid & 7; kp0 = Kp + (size_t)row * ldk + cc * 8; kl0 = (unsigned)(row * KRB + ((cc ^ ((row >> 1) & 7)) << 4)); }
    const int sr = tid >> 4, sc = (tid & 15) * 8;
    const bf16_t* vp0 = Vp + (size_t)sr * ldv + sc; const unsigned vs0 = (unsigned)v_st(sr, sc);
    const long k64 = 64L * ldk, v32 = 32L * ldv;
    const int kstp = 128 * ldk, vstp = 128 * ldv;
#define K128_LOAD() do { kreg[0] = *(const GAS u32x4*)kp0; kreg[1] = *(const GAS u32x4*)(kp0 + k64); kp0 += kstp; \
        vreg[0] = *(const GAS u32x4*)vp0; vreg[1] = *(const GAS u32x4*)(vp0 + v32); vreg[2] = *(const GAS u32x4*)(vp0 + 2 * v32); vreg[3] = *(const GAS u32x4*)(vp0 + 3 * v32); vp0 += vstp; } while (0)
#define K128_WRITE(Kb_, Vb_) do { *(LAS u32x4*)((Kb_) + kl0) = kreg[0]; *(LAS u32x4*)((Kb_) + kl0 + 8192) = kreg[1]; \
        *(LAS u32x4*)((Vb_) + vs0) = vreg[0]; *(LAS u32x4*)((Vb_) + vs0 + 8192) = vreg[1]; *(LAS u32x4*)((Vb_) + vs0 + 16384) = vreg[2]; *(LAS u32x4*)((Vb_) + vs0 + 24576) = vreg[3]; } while (0)
    const unsigned vbase = (unsigned)(uintptr_t)Vl + (unsigned)v_rd_base(lane);
    const unsigned sw = (unsigned)((r32 >> 1) & 7);
    u32x4 kreg[2], vreg[4];
    K128_LOAD(); K128_WRITE(Kl, Vl);
    __syncthreads();
    float m_reg = -1e30f, l_reg = 0.f;
#pragma unroll
    for (int d = 0; d < 4; ++d)
#pragma unroll
        for (int r = 0; r < 16; ++r) o[d][r] = 0.f;
#pragma unroll 1
    for (int j = 0; j < NT; ++j) {
        const int cur = j & 1;
        const bool more = (j + 1 < NT);
        if (more) K128_LOAD();
        if (j * 128 < nkw) {
            f32x16 p[4];
#pragma unroll
            for (int k = 0; k < 4; ++k)
#pragma unroll
                for (int r = 0; r < 16; ++r) p[k][r] = 0.f;
            LAS unsigned char* Kc = Kl + cur * KTB;
#define K128_OFF(d0, k) ((unsigned)((32 * (k) + r32) * KRB) + ((((unsigned)((d0) * 2 + hi)) ^ sw) << 4))
            bf16x8 fa[4], fb[4];
#pragma unroll
            for (int k = 0; k < 4; ++k) fa[k] = *(const LAS bf16x8*)(Kc + K128_OFF(0, k));
#pragma unroll
            for (int k = 0; k < 4; ++k) fb[k] = *(const LAS bf16x8*)(Kc + K128_OFF(1, k));
            SBAR();
#pragma unroll
            for (int k = 0; k < 4; ++k) p[k] = __builtin_amdgcn_mfma_f32_32x32x16_bf16(fa[k], qr[0], p[k], 0, 0, 0);
            SBAR();
#pragma unroll
            for (int k = 0; k < 4; ++k) fa[k] = *(const LAS bf16x8*)(Kc + K128_OFF(2, k));
            SBAR();
#pragma unroll
            for (int k = 0; k < 4; ++k) p[k] = __builtin_amdgcn_mfma_f32_32x32x16_bf16(fb[k], qr[1], p[k], 0, 0, 0);
            SBAR();
#pragma unroll
            for (int k = 0; k < 4; ++k) fb[k] = *(const LAS bf16x8*)(Kc + K128_OFF(3, k));
            SBAR();
#pragma unroll
            for (int k = 0; k < 4; ++k) p[k] = __builtin_amdgcn_mfma_f32_32x32x16_bf16(fa[k], qr[2], p[k], 0, 0, 0);
            SBAR();
#pragma unroll
            for (int k = 0; k < 4; ++k) p[k] = __builtin_amdgcn_mfma_f32_32x32x16_bf16(fb[k], qr[3], p[k], 0, 0, 0);
#undef K128_OFF
            if ((j + 1) * 128 > nkw) {
                asm volatile("" ::: "memory");
#pragma unroll
                for (int k = 0; k < 4; ++k)
#pragma unroll
                    for (int r = 0; r < 16; ++r) { const int kb = j * 128 + 32 * k + crow(r, hi); if (kb >= nkw) p[k][r] = -1e30f; }
            }
            float pmax = p[0][0];
#pragma unroll
            for (int k = 0; k < 4; ++k)
#pragma unroll
                for (int r = 0; r < 16; ++r) pmax = fmaxf(pmax, p[k][r]);
            { auto rr = __builtin_amdgcn_permlane32_swap(__float_as_uint(pmax), __float_as_uint(pmax), false, false);
              pmax = fmaxf(__uint_as_float(rr[0]), __uint_as_float(rr[1])); }
            float mn, alpha;
            if (__builtin_expect(__all(pmax - m_reg <= thr_raw), 1)) { mn = m_reg; alpha = 1.f; }
            else { mn = fmaxf(m_reg, pmax); alpha = __builtin_amdgcn_exp2f((m_reg - mn) * C); m_reg = mn; }
            const float mnC = -mn * C;
            typedef float f32x2 __attribute__((ext_vector_type(2)));
            const f32x2 C2 = {C, C}, M2 = {mnC, mnC};
            f32x2 s2 = {0.f, 0.f};
#pragma unroll
            for (int k = 0; k < 4; ++k)
#pragma unroll
                for (int r = 0; r < 16; r += 2) { f32x2 t = {p[k][r], p[k][r + 1]}; t = __builtin_elementwise_fma(t, C2, M2);
                    t.x = __builtin_amdgcn_exp2f(t.x); t.y = __builtin_amdgcn_exp2f(t.y); p[k][r] = t.x; p[k][r + 1] = t.y; s2 += t; }
            float ps = s2.x + s2.y;
            { auto rr = __builtin_amdgcn_permlane32_swap(__float_as_uint(ps), __float_as_uint(ps), false, false);
              ps = __uint_as_float(rr[0]) + __uint_as_float(rr[1]); }
            l_reg = l_reg * alpha + ps;
            bf16x8 pa[8];
#define PK4(P, BASE, OUT) do { unsigned a0 = cvt_pk(P[BASE + 0], P[BASE + 1]), a1 = cvt_pk(P[BASE + 2], P[BASE + 3]);   \
    unsigned b0 = cvt_pk(P[BASE + 4], P[BASE + 5]), b1 = cvt_pk(P[BASE + 6], P[BASE + 7]);                              \
    auto r0 = __builtin_amdgcn_permlane32_swap(a0, b0, false, false); auto r1 = __builtin_amdgcn_permlane32_swap(a1, b1, false, false); \
    u32x4 w = {r0[0], r1[0], r0[1], r1[1]}; OUT = *reinterpret_cast<bf16x8*>(&w); } while (0)
#pragma unroll
            for (int k = 0; k < 4; ++k) { PK4(p[k], 0, pa[2 * k]); PK4(p[k], 8, pa[2 * k + 1]); }
#undef PK4
            if (__any(alpha < 1.f)) {
                if (hi == 0) wsc[r32] = alpha;
                asm volatile("s_waitcnt lgkmcnt(0)" ::: "memory");
#pragma unroll
                for (int r = 0; r < 16; ++r) { const float al = wsc[crow(r, hi)];
#pragma unroll
                    for (int d = 0; d < 4; ++d) o[d][r] *= al; }
            }
            const unsigned vb = vbase + (unsigned)(cur * VTB);
            pv_one128<0, 0>(o[0], vb, pa[0], pa[1], pa[2], pa[3]); pv_one128<0, 1>(o[0], vb, pa[4], pa[5], pa[6], pa[7]);
            pv_one128<1, 0>(o[1], vb, pa[0], pa[1], pa[2], pa[3]); pv_one128<1, 1>(o[1], vb, pa[4], pa[5], pa[6], pa[7]);
            pv_one128<2, 0>(o[2], vb, pa[0], pa[1], pa[2], pa[3]); pv_one128<2, 1>(o[2], vb, pa[4], pa[5], pa[6], pa[7]);
            pv_one128<3, 0>(o[3], vb, pa[0], pa[1], pa[2], pa[3]); pv_one128<3, 1>(o[3], vb, pa[4], pa[5], pa[6], pa[7]);
        }
        if (more) {
            LAS unsigned char* Kn = Kl + (cur ^ 1) * KTB; LAS unsigned char* Vn = Vl + (cur ^ 1) * VTB;
            K128_WRITE(Kn, Vn);
        }
        __syncthreads();
    }
    if (nkw > 0) {
        if (hi == 0) wsc[32 + r32] = l_reg;
        asm volatile("s_waitcnt lgkmcnt(0)" ::: "memory");
#pragma unroll
        for (int r = 0; r < 16; ++r) { const float rl = __builtin_amdgcn_rcpf(wsc[32 + crow(r, hi)]);
#pragma unroll
            for (int d = 0; d < 4; ++d) o[d][r] *= rl; }
    }
#undef K128_LOAD
#undef K128_WRITE
}

__device__ __forceinline__ void ffn_conv_phase(bf16_t* U, const float* __restrict__ st, const float* __restrict__ cw, const float* __restrict__ cb, long gt_, long NTH_, int dummy) {
        const long ntask = (long)(M / 4) * (FF / 8);
        for (long t = gt_; t < ntask; t += NTH_) {
            const int cch = (int)(t % (FF / 8)), rb = (int)(t / (FF / 8)), r0 = rb * 4, c0 = cch * 8;
            const bool samp = r0 >= MP;
            const int spos = samp ? ((r0 - MP) & 31) : (r0 & (SEQ - 1));
            const int sbb = (r0 - MP) >> 5;
            float gv[6][8];
#pragma unroll
            for (int k = 0; k < 6; ++k) {
                if (k >= 2 || spos != 0) unpack8(*(const GAS u32x4*)(U + (size_t)(r0 - 2 + k) * 5632 + c0), gv[k]);
                else if (samp) { const f32x4 h0 = *(const GAS f32x4*)(st + (size_t)(sbb * 2 + k) * FF + c0), h1 = *(const GAS f32x4*)(st + (size_t)(sbb * 2 + k) * FF + c0 + 4);
                    gv[k][0] = h0[0]; gv[k][1] = h0[1]; gv[k][2] = h0[2]; gv[k][3] = h0[3]; gv[k][4] = h1[0]; gv[k][5] = h1[1]; gv[k][6] = h1[2]; gv[k][7] = h1[3]; }
                else {
#pragma unroll
                    for (int e = 0; e < 8; ++e) gv[k][e] = 0.f; }
            }
            float w0[8], w1[8], w2[8], bb[8];
#pragma unroll
            for (int e = 0; e < 8; ++e) { w0[e] = cw[c0 + e]; w1[e] = cw[FF + c0 + e]; w2[e] = cw[2 * FF + c0 + e]; bb[e] = cb[c0 + e]; }
#pragma unroll
            for (int j = 0; j < 4; ++j) {
                bf16_t* up = U + (size_t)(r0 + j) * 5632 + FF + c0;
                float uv[8]; unpack8(*(const GAS u32x4*)up, uv);
                float ov[8];
#pragma unroll
                for (int e = 0; e < 8; ++e) { const float gs = w0[e] * gv[j][e] + w1[e] * gv[j + 1][e] + w2[e] * gv[j + 2][e] + bb[e];
                    ov[e] = gs / (1.f + __expf(-gs)) * uv[e]; }
                u32x4 w; w.x = cvt_pk(ov[0], ov[1]); w.y = cvt_pk(ov[2], ov[3]); w.z = cvt_pk(ov[4], ov[5]); w.w = cvt_pk(ov[6], ov[7]);
                if (!dummy || ov[0] == 1.2345e-37f) *(GAS u32x4*)up = w;
            }
        }
}

#define XB_TMO      128
#define XB_XCNT(j)  (256  + 64 * (j))
#define XB_XSUB(j)  (1280 + 64 * (j))
#define XB_XGEN(j)  (2304 + 64 * (j))
#define XB_TOP      3328
#define XB_TOPGEN   3392
#define XCD_BAR_WORDS 3456
#define XB_SPIN_CAP (1u << 18)

__device__ __forceinline__ unsigned xb_ld(unsigned* p)              { return __hip_atomic_load(p, __ATOMIC_RELAXED, __HIP_MEMORY_SCOPE_AGENT); }
__device__ __forceinline__ unsigned xb_add(unsigned* p, unsigned v) { return __hip_atomic_fetch_add(p, v, __ATOMIC_RELAXED, __HIP_MEMORY_SCOPE_AGENT); }
__device__ __forceinline__ unsigned xb_xcc_id() { return (unsigned)__builtin_amdgcn_s_getreg((3 << 11) | 20) & 0xFu; }
#define XB_SPIN(cond, bar) do { unsigned _sp = 0; while (cond) { __builtin_amdgcn_s_sleep(1); \
    if ((++_sp & 255u) == 0u) { if (xb_ld(&(bar)[XB_TMO])) break; if (_sp > XB_SPIN_CAP) { atomicAdd(&(bar)[XB_TMO], 1u); break; } } } } while (0)

struct XcdBarrier {
    unsigned* bar; unsigned x;
    volatile LAS unsigned* st;
};

__device__ __forceinline__ XcdBarrier xcd_barrier_post(unsigned* bar, volatile LAS unsigned* st) {
    XcdBarrier b; b.bar = bar; b.x = (unsigned)__builtin_amdgcn_readfirstlane((int)xb_xcc_id()); b.st = st;
    if (threadIdx.x == 0) (void)xb_add(&bar[XB_XCNT(b.x)], 1u);
    return b;
}
__device__ __forceinline__ void xcd_barrier_complete(unsigned* bar, unsigned x, unsigned& nloc, unsigned& nx) {
    const unsigned G = gridDim.x * gridDim.y * gridDim.z;
    unsigned sum, cnt, mine, sp = 0u;
    for (;;) {
        sum = 0u; cnt = 0u; mine = 0u;
#pragma unroll
        for (unsigned j = 0; j < 16; ++j) { const unsigned c = xb_ld(&bar[XB_XCNT(j)]); sum += c; cnt += (c > 0u) ? 1u : 0u; mine = (j == x) ? c : mine; }
        if (sum == G) break;
        __builtin_amdgcn_s_sleep(1);
        if ((++sp & 255u) == 0u) { if (xb_ld(&bar[XB_TMO])) break; if (sp > XB_SPIN_CAP) { atomicAdd(&bar[XB_TMO], 1u); break; } }
    }
    nloc = mine > 0u ? mine : 1u; nx = cnt > 0u ? cnt : 1u;
}

__device__ __forceinline__ void xcd_barrier(const XcdBarrier& b) {
    asm volatile("s_waitcnt vmcnt(0)" ::: "memory");
    __syncthreads();
    if (threadIdx.x == 0) {
        unsigned* bar = b.bar;
        __builtin_amdgcn_s_waitcnt(0);
        unsigned nloc = b.st[0], nx = b.st[1];
        if (nloc == 0u) { xcd_barrier_complete(bar, b.x, nloc, nx); b.st[0] = nloc; b.st[1] = nx; }
        const unsigned old = xb_add(&bar[XB_XSUB(b.x)], 1u);
        const unsigned gen = old / nloc;
        if (old + 1u == (gen + 1u) * nloc) {
            __builtin_amdgcn_fence(__ATOMIC_RELEASE, "agent");
            asm volatile("s_waitcnt vmcnt(0)" ::: "memory");
            const unsigned og = xb_add(&bar[XB_TOP], 1u);
            const unsigned tg = og / nx;
            if (og + 1u == (tg + 1u) * nx) xb_add(&bar[XB_TOPGEN], 1u);
            else XB_SPIN(xb_ld(&bar[XB_TOPGEN]) == tg, bar);
            __builtin_amdgcn_fence(__ATOMIC_ACQUIRE, "agent");
            xb_add(&bar[XB_XGEN(b.x)], 1u);
            asm volatile("s_waitcnt vmcnt(0)" ::: "memory");
        } else {
            XB_SPIN(xb_ld(&bar[XB_XGEN(b.x)]) == gen, bar);
            __builtin_amdgcn_fence(__ATOMIC_ACQUIRE, "agent");
            asm volatile("s_waitcnt vmcnt(0)" ::: "memory");
        }
    }
    __syncthreads();
}


struct Args { const float* in[33]; float* out; unsigned char* ws; };
__device__ __forceinline__ const float* ld_in(const Args& a, int k) { asm volatile("" : "+s"(k)); return a.in[k]; }
#define INP(k) ld_in(a, (k))
struct Ctx {
    unsigned char* ws; float* out; int tid, wid, lane, r32, hi, G, bid; long gt, NTH; int gw, NWV;
    float* ssq; float* rope; bf16_t* wmix; bf16_t* wffn; bf16_t* Xb; unsigned char* big; unsigned char* tail; float* X;
};
__device__ __forceinline__ Ctx mkctx(const Args& a) {
    Ctx c;
    { unsigned long long w = (unsigned long long)(uintptr_t)a.ws, o = (unsigned long long)(uintptr_t)a.out;
      unsigned wl = __builtin_amdgcn_readfirstlane((unsigned)w), wh = __builtin_amdgcn_readfirstlane((unsigned)(w >> 32));
      unsigned ol = __builtin_amdgcn_readfirstlane((unsigned)o), oh = __builtin_amdgcn_readfirstlane((unsigned)(o >> 32));
      asm volatile("" : "+s"(wl), "+s"(wh), "+s"(ol), "+s"(oh));
      c.ws = (unsigned char*)(uintptr_t)(((unsigned long long)wh << 32) | wl); c.out = (float*)(uintptr_t)(((unsigned long long)oh << 32) | ol); }
    int t = threadIdx.x; asm volatile("" : "+v"(t)); c.tid = t; c.wid = t >> 6; c.lane = t & 63; c.r32 = t & 31; c.hi = (t >> 5) & 1;
    int g = gridDim.x, b = blockIdx.x; asm volatile("" : "+s"(g), "+s"(b)); c.G = g; c.bid = b;
    c.gt = (long)b * NTHREADS + t; c.NTH = (long)g * NTHREADS; c.gw = b * 8 + c.wid; c.NWV = g * 8;
    c.ssq = (float*)(c.ws + WS_SSQP); c.rope = (float*)(c.ws + WS_ROPE); c.wmix = (bf16_t*)(c.ws + WS_WMIX); c.wffn = (bf16_t*)(c.ws + WS_WFFN);
    c.Xb = (bf16_t*)(c.ws + WS_XB); c.big = c.ws + WS_BIG; c.tail = c.ws + WS_TAIL; c.X = c.out + O_Y;
    return c;
}

__device__ __forceinline__ float* ssqb(const Ctx& c, int s) { return (float*)((unsigned char*)c.ssq + (size_t)(s & 1) * 3 * MiB); }
constexpr size_t B_WDN1 = 346 * MiB;
static_assert(B_WDN1 + 1024u * 2816 * 2 <= 356 * MiB, "wdn1");
__device__ __forceinline__ bf16_t* wdn_buf(const Ctx& c, int i) { return (i & 1) ? (bf16_t*)(c.big + B_WDN1) : c.wffn + W_DN; }
__device__ __forceinline__ void prep_ffn(const Args& a, const Ctx& c, LAS float* ltile, int i, int rank = -1, int nwork = 0) {
    prep_gu(ltile, INP(28) + (size_t)i * D * FF, INP(29) + (size_t)i * D * FF, c.wffn + W_GU, INP(10) + i * D, rank, nwork);
    prep_w(ltile, INP(32) + (size_t)i * FF * D, D, FF, D, wdn_buf(c, i), D, 0, 0, nullptr, 1, 1.f, nullptr, rank, nwork);
}

__device__ __forceinline__ void prep_mixer_rest(const Args& a, const Ctx& c, LAS float* ltile) {
    prep_w(ltile, INP(15), 1024, 1024, 1024, c.wmix + W_OA, 1024, 0, 0, INP(14), 128, 0.8f, nullptr);
    prep_w(ltile, INP(16), 704, 1024, 704, c.wmix + W_DB, 768, 0, 0, INP(9) + D, D, 1.f, nullptr);
    prep_w(ltile, INP(18), 1536, 384, 1536, c.wmix + W_UQ, 1536, 3, 0, nullptr, 1, 1.f, nullptr);
    prep_w(ltile, INP(20), 1024, 256, 1024, c.wmix + W_UKV, 1024, 0, 0, nullptr, 1, 1.f, nullptr);
    prep_w(ltile, INP(21), 1024, 256, 1024, c.wmix + W_UKV + 1024u * 256, 1024, 0, 0, nullptr, 1, 1.f, nullptr);
    prep_w(ltile, INP(22), 1024, 1024, 1024, c.wmix + W_OB, 1024, 0, 0, nullptr, 1, 1.f, nullptr);
    prep_w(ltile, INP(23), 3072, 1024, 3072, c.wmix + W_CIN, 3072, 0, 0, INP(9) + 2 * D, D, 1.f, nullptr);
    prep_w(ltile, INP(25), 1024, 1024, 1024, c.wmix + W_COUT, 1024, 0, 0, nullptr, 1, 1.f, nullptr);
#pragma unroll 1
    for (int g4 = 0; g4 < 4; ++g4)
        prep_w(ltile, INP(26) + (size_t)g4 * 65536, 256, 256, 256, c.wmix + W_DG + (size_t)g4 * 65536, 256, 0, 0, nullptr, 1, 1.f, INP(27) + g4 * 256);
}
__device__ __forceinline__ void ph_prologue(const Args& a, LAS unsigned char* lds) {
    const Ctx c = mkctx(a); LAS float* ltile = (LAS float*)lds;
    prep_w(ltile, INP(12), 3072, 1024, 3072, c.wmix + W_QKV, 3072, 1, 32, INP(9), D, 1.f, nullptr);
    for (long i = c.gt; i < 16384L * 32; i += c.NTH) {
        const int pos = (int)(i >> 5), k = (int)(i & 31);
        double inv = 1.0; for (int q = 0; q < k; ++q) inv *= 0.7498942093324559;
        const float invf = (float)inv;
        const double rev = (double)pos * (double)invf * 0.15915494309189535;
        const float fr = (float)(rev - floor(rev));
        c.rope[(size_t)pos * 64 + k] = __builtin_amdgcn_cosf(fr); c.rope[(size_t)pos * 64 + 32 + k] = __builtin_amdgcn_sinf(fr);
    }
    {
        const float* xp = INP(0); const float* xs = INP(1);
        for (int r = c.gw; r < M; r += c.NWV) {
            const float* src = r < MP ? xp + (size_t)r * D : xs + (size_t)(r - MP) * D;
            float ss = 0.f;
#pragma unroll
            for (int j = 0; j < 4; ++j) { const f32x4 v = *(const GAS f32x4*)(src + j * 256 + c.lane * 4); ss += v[0] * v[0] + v[1] * v[1] + v[2] * v[2] + v[3] * v[3];
                *(GAS u32x2*)(c.Xb + (size_t)r * D + j * 256 + c.lane * 4) = pack4(v); }
            ss = wave_sum(ss);
            if (c.lane < 16) ssqb(c, 0)[(size_t)r * 16 + c.lane] = c.lane == 0 ? ss : 0.f;
        }
    }
    {
        const float* ck = INP(2); const float* cv = INP(3);
        bf16_t* Ks = (bf16_t*)(c.tail + T_K); bf16_t* Vs = (bf16_t*)(c.tail + T_V);
        for (long i = c.gt; i < (long)SBN * PAST * D / 8; i += c.NTH) {
            const long e = i * 8; const int sbb = (int)(e / ((long)PAST * D)); const long rem = e % ((long)PAST * D);
            const size_t dst = (size_t)sbb * NKSP * D + rem;
            *(GAS u32x4*)(Ks + dst) = pack8(*(const GAS f32x4*)(ck + e), *(const GAS f32x4*)(ck + e + 4));
            *(GAS u32x4*)(Vs + dst) = pack8(*(const GAS f32x4*)(cv + e), *(const GAS f32x4*)(cv + e + 4));
        }
        for (long i = c.gt; i < (long)SBN * (NKSP - NKS) * D / 8; i += c.NTH) {
            const long e = i * 8; const int sbb = (int)(e / ((long)(NKSP - NKS) * D)); const long rem = e % ((long)(NKSP - NKS) * D);
            const size_t dst = ((size_t)sbb * NKSP + NKS) * D + rem;
            *(GAS u32x4*)(Ks + dst) = (u32x4){0, 0, 0, 0}; *(GAS u32x4*)(Vs + dst) = (u32x4){0, 0, 0, 0};
        }
    }
}

__device__ __forceinline__ void ph_l0_qkv(const Args& a, LAS unsigned char* lds) {
    const Ctx c = mkctx(a);
    bf16_t* Q = (bf16_t*)(c.big + B0_Q); bf16_t* Kb = (bf16_t*)(c.big + B0_K); bf16_t* Vb = (bf16_t*)(c.big + B0_V);
    bf16_t* Ks = (bf16_t*)(c.tail + T_K); bf16_t* Vs = (bf16_t*)(c.tail + T_V);
    pg8::Gemm g{c.Xb, c.wmix + W_QKV, M, 3072, 1024, 1024, 0}; pg8::StaticOrder S; S.init(M, 3072, c.G, c.bid);
    EpiQKV E{ssqb(c, 0), c.rope, Q, Kb, Vb, Ks, Vs, c.out + O_AKP, c.out + O_AVP, c.out + O_AKS, c.out + O_AVS};
    pg8::gemm_phase(lds, g, S, E);
    prep_mixer_rest(a, c, (LAS float*)lds);
}
struct AUnit { int b, h, qb, sbb; bool samp; };
__device__ __forceinline__ AUnit attn_unit_of(int G, int bid, int ui) {
    AUnit u; u.samp = false; u.sbb = 0; u.b = 0; u.qb = 0; u.h = 0;
    if (G == 256) {
        if (ui < 4) { const int combo = (bid & 7) * 2 + (ui >> 1); u.b = combo >> 3; u.h = combo & 7; u.qb = (ui & 1) ? (bid >> 3) : 63 - (bid >> 3); }
        else { u.samp = true; u.sbb = bid >> 3; u.h = bid & 7; }
    } else {
        const int id = bid + ui * G;
        if (id < 1024) { u.b = id >> 9; u.h = (id >> 6) & 7; u.qb = id & 63; } else { u.samp = true; u.sbb = (id - 1024) >> 3; u.h = (id - 1024) & 7; }
    }
    return u;
}
__device__ __forceinline__ int attn_ucount(int G, int bid) { return (G == 256) ? 4 + (bid < 64 ? 1 : 0) : (1024 + 64 - bid + G - 1) / G; }

__device__ __forceinline__ void ph_l0_attn(const Args& a, LAS unsigned char* lds, int dummy) {
    const Ctx c = mkctx(a);
    bf16_t* Q = (bf16_t*)(c.big + B0_Q); bf16_t* Kb = (bf16_t*)(c.big + B0_K); bf16_t* Vb = (bf16_t*)(c.big + B0_V); GAS float* OS = (GAS float*)(c.big + B0_OS);
    GAS bf16_t* Qg = (GAS bf16_t*)Q;
    bf16_t* Ks = (bf16_t*)(c.tail + T_K); bf16_t* Vs = (bf16_t*)(c.tail + T_V);
    float lam;
    { const float* al = INP(13); const float pa = al[c.lane] * al[64 + c.lane], pb = al[128 + c.lane] * al[192 + c.lane];
      lam = __expf(wave_sum(pa)) - __expf(wave_sum(pb)) + 0.2f; }
    const int ucount = attn_ucount(c.G, c.bid);
    if (__builtin_amdgcn_readfirstlane(c.tid) >= 256) __builtin_amdgcn_s_setprio(1);
#pragma unroll 1
    for (int ui = 0; ui < ucount; ++ui) {
        const AUnit u = attn_unit_of(c.G, c.bid, ui);
        const int row0 = u.samp ? MP + u.sbb * 32 : u.b * SEQ + u.qb * 256;
        const int NT = u.samp ? 9 : 2 * u.qb + 2;
        const int nkw = __builtin_amdgcn_readfirstlane(u.samp ? (c.wid == 0 ? NKS : 0) : (4 * u.qb + (c.wid >> 1) + 1) * 64);
        const bool act = nkw > 0;
#pragma unroll 1
        for (int cc = 0; cc < 2; ++cc) {
            const bf16_t* Kp = u.samp ? Ks + (size_t)u.sbb * NKSP * D + u.h * 128 + cc * 64 : Kb + (size_t)u.b * SEQ * D + u.h * 128 + cc * 64;
            const bf16_t* Vp = u.samp ? Vs + (size_t)u.sbb * NKSP * D + u.h * 128 : Vb + (size_t)u.b * SEQ * D + u.h * 128;
            f32x16 o[4];
            attn_unit_k128(Q + (size_t)row0 * D + u.h * 128 + cc * 64, D, Kp, D, Vp, D, NT, nkw, lds, o, 0.125f);
            if (act && (!dummy || o[0][0] == 1.2345e-37f)) {
                unsigned ebase = (unsigned)((row0 + c.wid * 32 + 4 * c.hi) * D + u.h * 128 + c.r32);
                asm volatile("" : "+v"(ebase));
                if (cc == 0) {
#pragma unroll
                    for (int r = 0; r < 16; ++r)
#pragma unroll
                        for (int d = 0; d < 4; ++d) OS[ebase + (unsigned)(((r & 3) + 8 * (r >> 2)) * D + d * 32)] = o[d][r];
                } else {
#pragma unroll
                    for (int r = 0; r < 16; ++r) {
                        asm volatile("" ::: "memory");
                        const unsigned base = ebase + (unsigned)(((r & 3) + 8 * (r >> 2)) * D);
                        float x[4]; float ss = 0.f;
#pragma unroll
                        for (int d = 0; d < 4; ++d) { x[d] = OS[base + d * 32] - lam * o[d][r]; ss += x[d] * x[d]; }
                        ss += __shfl_xor(ss, 1); ss += __shfl_xor(ss, 2); ss += __shfl_xor(ss, 4); ss += __shfl_xor(ss, 8); ss += __shfl_xor(ss, 16);
                        const float rs = rsqrtf(ss * (1.0f / 128.0f) + 1e-5f);
#pragma unroll
                        for (int d = 0; d < 4; ++d) Qg[base + d * 32] = f2bf(x[d] * rs);
                    }
                }
            }
        }
    }
    __builtin_amdgcn_s_setprio(0);
}
__device__ __forceinline__ void ph_l0_out(const Args& a, LAS unsigned char* lds) {
    const Ctx c = mkctx(a);
    bf16_t* Q = (bf16_t*)(c.big + B0_Q);
    pg8::Gemm g{Q, c.wmix + W_OA, M, 1024, 1024, 1024, 0}; pg8::StaticOrder S; S.init(M, 1024, c.G, c.bid);
    EpiResidT<true> E{INP(0), INP(1), c.Xb, ssqb(c, 1)};
    pg8::gemm_phase(lds, g, S, E);
    prep_ffn(a, c, (LAS float*)lds, 0);
}

__device__ __forceinline__ void ph_ffn_up(const Args& a, LAS unsigned char* lds, int i) {
    const Ctx c = mkctx(a);
    pg8::Gemm g{c.Xb, c.wffn + W_GU, M, 5632, 1024, 1024, 0}; g.mrows = 254; g.moff = -2;
    pg8::StaticOrder S; S.init2(131, 22, c.G, c.bid);
    EpiFfn E{(bf16_t*)c.big, ssqb(c, 2 * i + 1), INP(30) + (size_t)i * 3 * FF, INP(31) + (size_t)i * FF, INP(8) + (size_t)i * SBN * 2 * FF,
             c.out + O_FCP + (size_t)i * NBP * 2 * FF, c.out + O_FCS + (size_t)i * SBN * 2 * FF, lds + 131072 + 4096};
    pg8::gemm_phase(lds, g, S, E);
}
constexpr size_t B_SLAB = 180 * MiB;
__device__ __forceinline__ void ph_ffn_down(const Args& a, LAS unsigned char* lds, int i) {
    const Ctx c = mkctx(a);
    constexpr int NS = FF / 256;
    const bool split = c.G >= 8 * NS;
    {
        pg8::Gemm g{(bf16_t*)c.big, wdn_buf(c, i), M, 1024, FF, FF, 0}; pg8::StaticOrder S; S.init(split ? MP : M, 1024, c.G, c.bid);
        EpiResidT<false> E{nullptr, nullptr, c.Xb, ssqb(c, 2 * i + 2)};
        pg8::gemm_phase(lds, g, S, E);
    }
    if (!split) { if (i < 3) prep_ffn(a, c, (LAS float*)lds, i + 1); return; }
    if (c.bid >= 4 * NS) {
        if (i < 3) prep_ffn(a, c, (LAS float*)lds, i + 1, c.bid - 4 * NS, c.G - 4 * NS);
        return;
    }
    unsigned* cnt = (unsigned*)c.ws + 3600 + i;
    float* slab = (float*)(c.big + B_SLAB);
    {
        const int pn = c.bid & 3, ks = c.bid >> 2;
        pg8::Gemm g{(bf16_t*)c.big + ks * 256, wdn_buf(c, i) + ks * 256, M, 1024, 256, FF, 0}; g.ldb = FF;
        pg8::SingleUnit S{128, pn};
        EpiSlab E{slab + (size_t)(pn * NS + ks) * 65536};
        pg8::gemm_phase(lds, g, S, E);
        __builtin_amdgcn_fence(__ATOMIC_RELEASE, "agent"); asm volatile("s_waitcnt vmcnt(0)" ::: "memory");
        __syncthreads();
        if (c.tid == 0) __hip_atomic_fetch_add(cnt, 1u, __ATOMIC_RELAXED, __HIP_MEMORY_SCOPE_AGENT);
    }
    if (c.bid < 16) {
        if (c.tid == 0) { unsigned sp = 0; while (__hip_atomic_load(cnt, __ATOMIC_RELAXED, __HIP_MEMORY_SCOPE_AGENT) < 4u * NS) { __builtin_amdgcn_s_sleep(2); if (++sp > (1u << 22)) break; } }
        __syncthreads();
        __builtin_amdgcn_fence(__ATOMIC_ACQUIRE, "agent"); asm volatile("s_waitcnt vmcnt(0)" ::: "memory");
        const int sl = c.bid, pn = sl >> 2, row = c.tid >> 1, cq = (sl & 3) * 64 + (c.tid & 1) * 32;
        const size_t xoff = (size_t)(MP + row) * D + pn * 256 + cq;
        float ss = 0.f;
#pragma unroll
        for (int k8 = 0; k8 < 4; ++k8) {
            const u32x4 w = *(const GAS u32x4*)(c.Xb + xoff + k8 * 8);
            f32x4 v0 = {bflo(w.x), bfhi(w.x), bflo(w.y), bfhi(w.y)}, v1 = {bflo(w.z), bfhi(w.z), bflo(w.w), bfhi(w.w)};
#pragma unroll
            for (int ks = 0; ks < NS; ++ks) { const float* p = slab + (size_t)(pn * NS + ks) * 65536 + row * 256 + cq + k8 * 8;
                v0 += *(const GAS f32x4*)p; v1 += *(const GAS f32x4*)(p + 4); }
            *(GAS u32x4*)(c.Xb + xoff + k8 * 8) = pack8(v0, v1);
            ss += (v0[0] * v0[0] + v0[1] * v0[1]) + (v0[2] * v0[2] + v0[3] * v0[3]) + (v1[0] * v1[0] + v1[1] * v1[1]) + (v1[2] * v1[2] + v1[3] * v1[3]);
        }
        ss += __shfl_xor(ss, 1);
        if ((c.tid & 1) == 0) ssqb(c, 2 * i + 2)[(size_t)(MP + row) * 16 + sl] = ss;
    }
}

__device__ __forceinline__ void ph_l1_down(const Args& a, LAS unsigned char* lds) {
    const Ctx c = mkctx(a);
    pg8::Gemm g{c.Xb, c.wmix + W_DB, M, 768, 1024, 1024, 0}; pg8::StaticOrder S; S.init(M, 768, c.G, c.bid);
    EpiF32 E{(float*)(c.big + B1_DOWN), 768, ssqb(c, 2)};
    pg8::gemm_phase(lds, g, S, E);
}
__device__ __forceinline__ void ph_l1_rows(const Args& a) {
    const Ctx c = mkctx(a);
    const float* DOWN = (const float*)(c.big + B1_DOWN); bf16_t* CQ = (bf16_t*)(c.big + B1_CQ); bf16_t* CKV = (bf16_t*)(c.big + B1_CKV); bf16_t* KR = (bf16_t*)(c.big + B1_KR);
    bf16_t* KsN = (bf16_t*)(c.tail + T_K); bf16_t* VsB = (bf16_t*)(c.tail + T_V); bf16_t* KRs = (bf16_t*)(c.tail + T_KR);
    const float* gq = INP(17); const float* gkv = INP(19); const int lane = c.lane;
    for (int r = c.gw; r < M; r += c.NWV) {
        const float* dr = DOWN + (size_t)r * 768;
        const bool samp = r >= MP; const int sr_ = r - MP, sbb = sr_ >> 5, tt = sr_ & 31;
        const int pos = samp ? PAST + tt : (r & (SEQ - 1));
        float cq[6]; float s1 = 0.f;
#pragma unroll
        for (int j = 0; j < 6; ++j) { cq[j] = dr[j * 64 + lane]; s1 += cq[j] * cq[j]; }
        s1 = wave_sum(s1); const float r1 = rsqrtf(s1 * (1.0f / 384.0f) + NORM_EPS);
#pragma unroll
        for (int j = 0; j < 6; ++j) CQ[(size_t)r * 384 + j * 64 + lane] = f2bf(cq[j] * r1 * gq[j * 64 + lane]);
        float kv[4]; float s2 = 0.f;
#pragma unroll
        for (int j = 0; j < 4; ++j) { kv[j] = dr[384 + j * 64 + lane]; s2 += kv[j] * kv[j]; }
        s2 = wave_sum(s2); const float r2 = rsqrtf(s2 * (1.0f / 256.0f) + NORM_EPS);
        float* lo = samp ? c.out + O_BLS + (size_t)sr_ * 256 : c.out + O_BLP + (size_t)r * 256;
#pragma unroll
        for (int j = 0; j < 4; ++j) { const float v = kv[j] * r2 * gkv[j * 64 + lane]; lo[j * 64 + lane] = v; CKV[(size_t)r * 256 + j * 64 + lane] = f2bf(v); }
        const float xk = dr[640 + lane], xo = __shfl_xor(xk, 32);
        const float cs = c.rope[(size_t)pos * 64 + (lane & 31)], sn = c.rope[(size_t)pos * 64 + 32 + (lane & 31)];
        const float y = lane < 32 ? xk * cs - xo * sn : xk * cs + xo * sn;
        if (samp) { c.out[O_BRS + (size_t)sr_ * 64 + lane] = y; KRs[((size_t)sbb * NKSP + PAST + tt) * 64 + lane] = f2bf(y); }
        else { c.out[O_BRP + (size_t)r * 64 + lane] = y; KR[(size_t)r * 64 + lane] = f2bf(y); }
    }
    const float* cl = INP(4); const float* ckr = INP(5);
    for (long i = c.gt; i < (long)MCACHE * 256 / 8; i += c.NTH) {
        const long e = i * 8;
        *(GAS u32x4*)(CKV + (size_t)M * 256 + e) = pack8(*(const GAS f32x4*)(cl + e), *(const GAS f32x4*)(cl + e + 4));
    }
    for (long i = c.gt; i < (long)MCACHE * 64 / 8; i += c.NTH) {
        const long e = i * 8; const int sbb = (int)(e / (PAST * 64)); const long rem = e % (PAST * 64);
        *(GAS u32x4*)(KRs + (size_t)sbb * NKSP * 64 + rem) = pack8(*(const GAS f32x4*)(ckr + e), *(const GAS f32x4*)(ckr + e + 4));
    }
    for (long i = c.gt; i < (long)SBN * (NKSP - NKS) * D / 8; i += c.NTH) {
        const long e = i * 8; const int sbb = (int)(e / ((long)(NKSP - NKS) * D)); const long rem = e % ((long)(NKSP - NKS) * D);
        const size_t dst = ((size_t)sbb * NKSP + NKS) * D + rem;
        *(GAS u32x4*)(KsN + dst) = (u32x4){0, 0, 0, 0}; *(GAS u32x4*)(VsB + dst) = (u32x4){0, 0, 0, 0};
    }
    for (long i = c.gt; i < (long)SBN * (NKSP - NKS) * 64 / 8; i += c.NTH) {
        const long e = i * 8; const int sbb = (int)(e / ((long)(NKSP - NKS) * 64)); const long rem = e % ((long)(NKSP - NKS) * 64);
        *(GAS u32x4*)(KRs + ((size_t)sbb * NKSP + NKS) * 64 + rem) = (u32x4){0, 0, 0, 0};
    }
}
__device__ __forceinline__ void ph_l1_uq(const Args& a, LAS unsigned char* lds) {
    const Ctx c = mkctx(a);
    pg8::Gemm g{(bf16_t*)(c.big + B1_CQ), c.wmix + W_UQ, M, 1536, 384, 384, 0}; pg8::StaticOrder S; S.init(M, 1536, c.G, c.bid);
    EpiUQ E{c.rope, (bf16_t*)(c.big + B1_DOWN)};
    pg8::gemm_phase(lds, g, S, E);
}
__device__ __forceinline__ void ph_l1_expand(const Args& a, LAS unsigned char* lds) {
    const Ctx c = mkctx(a);
    pg8::Gemm g{(bf16_t*)(c.big + B1_CKV), c.wmix + W_UKV, MX, 2048, 256, 256, 0}; pg8::StaticOrder S; S.init(MX, 2048, c.G, (c.bid + c.G / 2) % c.G);
    EpiExpand E{(bf16_t*)(c.big + B1_KN), (bf16_t*)(c.big + B1_V), (bf16_t*)(c.tail + T_K), (bf16_t*)(c.tail + T_V)};
    pg8::gemm_phase(lds, g, S, E);
}
__device__ __forceinline__ void ph_l1_attn(const Args& a, LAS unsigned char* lds, int dummy) {
    const Ctx c = mkctx(a);
    bf16_t* QB = (bf16_t*)(c.big + B1_DOWN); bf16_t* KN = (bf16_t*)(c.big + B1_KN); bf16_t* KR = (bf16_t*)(c.big + B1_KR); bf16_t* VB = (bf16_t*)(c.big + B1_V); GAS bf16_t* AO = (GAS bf16_t*)(c.big + B1_AO);
    bf16_t* KsN = (bf16_t*)(c.tail + T_K); bf16_t* VsB = (bf16_t*)(c.tail + T_V); bf16_t* KRs = (bf16_t*)(c.tail + T_KR);
    const int ucount = attn_ucount(c.G, c.bid);
    if (__builtin_amdgcn_readfirstlane(c.tid) >= 256) __builtin_amdgcn_s_setprio(1);
#pragma unroll 1
    for (int ui = 0; ui < ucount; ++ui) {
        const AUnit u = attn_unit_of(c.G, c.bid, ui);
        const int row0 = u.samp ? MP + u.sbb * 32 : u.b * SEQ + u.qb * 256;
        const int NT = u.samp ? 17 : 4 * u.qb + 4;
        const int lim = u.samp ? (c.wid == 0 ? 16 : -1) : 4 * u.qb + (c.wid >> 1);
        const int nkeys = u.samp ? NKS : NT * 64;
        const bool act = lim >= 0;
        const bf16_t* Kp = u.samp ? KsN + (size_t)u.sbb * NKSP * D + u.h * 128 : KN + (size_t)u.b * SEQ * D + u.h * 128;
        const bf16_t* Krp = u.samp ? KRs + (size_t)u.sbb * NKSP * 64 : KR + (size_t)u.b * SEQ * 64;
        const bf16_t* Vp = u.samp ? VsB + (size_t)u.sbb * NKSP * D + u.h * 128 : VB + (size_t)u.b * SEQ * D + u.h * 128;
        f32x16 o[4];
        attn_unit_np<192>(QB + (size_t)row0 * 1536 + u.h * 192, 1536, Kp, D, Krp, Vp, D, NT, lim, nkeys, lds, o, 0.07216878364870322f);
        if (act && (!dummy || o[0][0] == 1.2345e-37f)) {
            unsigned ebase = (unsigned)((row0 + c.wid * 32 + 4 * c.hi) * D + u.h * 128 + c.r32);
            asm volatile("" : "+v"(ebase));
#pragma unroll
            for (int r = 0; r < 16; ++r)
#pragma unroll
                for (int d = 0; d < 4; ++d) AO[ebase + (unsigned)(((r & 3) + 8 * (r >> 2)) * D + d * 32)] = f2bf(o[d][r]);
        }
    }
    __builtin_amdgcn_s_setprio(0);
}
__device__ __forceinline__ void ph_mix_out(const Args& a, LAS unsigned char* lds, size_t a_off, size_t w_off, int K, int lda, int apn, int so) {
    const Ctx c = mkctx(a);
    pg8::Gemm g{(bf16_t*)(c.big + a_off), c.wmix + w_off, M, 1024, K, lda, apn}; pg8::StaticOrder S; S.init(M, 1024, c.G, c.bid);
    EpiResidT<false> E{nullptr, nullptr, c.Xb, ssqb(c, so)};
    pg8::gemm_phase(lds, g, S, E);
}

__device__ __forceinline__ void ph_l2_in(const Args& a, LAS unsigned char* lds) {
    const Ctx c = mkctx(a);
    pg8::Gemm g{c.Xb, c.wmix + W_CIN, M, 3072, 1024, 1024, 0}; pg8::StaticOrder S; S.init(M, 3072, c.G, c.bid);
    EpiBf16 E{(bf16_t*)(c.big + B2_CIN), 3072, ssqb(c, 4), nullptr, nullptr, 0};
    pg8::gemm_phase(lds, g, S, E);
}
__device__ __forceinline__ void ph_l2_conv(const Args& a) {
    const Ctx c = mkctx(a);
    const bf16_t* CIN = (const bf16_t*)(c.big + B2_CIN); bf16_t* CP = (bf16_t*)(c.big + B2_CP);
    const float* state_c = INP(6); const float* cw = INP(24);
    const long ntask = (long)(M / 4) * (D / 8);
    for (long t = c.gt; t < ntask; t += c.NTH) {
        const int cch = (int)(t % (D / 8)), rb = (int)(t / (D / 8)), r0 = rb * 4, c0 = cch * 8;
        const bool samp = r0 >= MP;
        const int spos = samp ? ((r0 - MP) & 31) : (r0 & (SEQ - 1));
        const int sbb = (r0 - MP) >> 5, bb_ = r0 >> 14;
        float z[6][8];
#pragma unroll
        for (int k = 0; k < 6; ++k) {
            if (k >= 2 || spos != 0) { float gc[8], vv[8]; const bf16_t* rp_ = CIN + (size_t)(r0 - 2 + k) * 3072 + c0;
                unpack8(*(const GAS u32x4*)(rp_ + 1024), gc); unpack8(*(const GAS u32x4*)(rp_ + 2048), vv);
#pragma unroll
                for (int e = 0; e < 8; ++e) z[k][e] = gc[e] * vv[e]; }
            else if (samp) {
#pragma unroll
                for (int e = 0; e < 8; ++e) z[k][e] = state_c[(size_t)(sbb * 2 + k) * D + c0 + e]; }
            else {
#pragma unroll
                for (int e = 0; e < 8; ++e) z[k][e] = 0.f; }
        }
        float w0[8], w1[8], w2[8];
#pragma unroll
        for (int e = 0; e < 8; ++e) { w0[e] = cw[c0 + e]; w1[e] = cw[D + c0 + e]; w2[e] = cw[2 * D + c0 + e]; }
#pragma unroll
        for (int j = 0; j < 4; ++j) {
            const int r = r0 + j;
            float gb[8]; unpack8(*(const GAS u32x4*)(CIN + (size_t)r * 3072 + c0), gb);
            float ov[8];
#pragma unroll
            for (int e = 0; e < 8; ++e) ov[e] = gb[e] * (w0[e] * z[j][e] + w1[e] * z[j + 1][e] + w2[e] * z[j + 2][e]);
            u32x4 w; w.x = cvt_pk(ov[0], ov[1]); w.y = cvt_pk(ov[2], ov[3]); w.z = cvt_pk(ov[4], ov[5]); w.w = cvt_pk(ov[6], ov[7]);
            *(GAS u32x4*)(CP + (size_t)r * D + c0) = w;
            float* so = nullptr;
            if (!samp) { const int s = spos + j; if (s >= SEQ - 2) so = c.out + O_CCP + (size_t)(bb_ * 2 + (s - (SEQ - 2))) * D + c0; }
            else { const int tq = spos + j; if (tq >= 30) so = c.out + O_CCS + (size_t)(sbb * 2 + (tq - 30)) * D + c0; }
            if (so) {
#pragma unroll
                for (int e = 0; e < 8; ++e) so[e] = z[j + 2][e]; }
        }
    }
}

__device__ __forceinline__ void ph_l3_rstd(const Args& a) {
    const Ctx c = mkctx(a);
    float* rst = (float*)(c.ws + 65536); const float* sq = ssqb(c, 6);
    for (long r = c.gt; r < M; r += c.NTH) rst[r] = rstd_row(sq, (int)r);
}
__device__ __forceinline__ void ph_l3_pool(const Args& a, LAS unsigned char* lds) {
    const Ctx c = mkctx(a);
    bf16_t* DP = (bf16_t*)c.big;
    const float* rst = (const float*)(c.ws + 65536); const float* gm = INP(9) + 3 * D; const float* state_d = INP(7);
    const long ntask = (long)M * (D / 4);
    for (long t = c.gt; t < ntask; t += c.NTH) {
        const int c0 = (int)(t % (D / 4)) * 4, r = (int)(t / (D / 4));
        const bool samp = r >= MP; const int sr_ = r - MP, sbb = sr_ >> 5;
        const int spos = samp ? (sr_ & 31) : (r & (SEQ - 1));
        const int w = 2 << (c0 >> 8);
        const f32x4 gv = *(const GAS f32x4*)(gm + c0);
        const u32x2 wt = *(const GAS u32x2*)(c.Xb + (size_t)r * D + c0);
        const f32x4 ht = (f32x4){bflo(wt.x), bfhi(wt.x), bflo(wt.y), bfhi(wt.y)} * rst[r] * gv;
        f32x4 sum = ht;
#define POOL_WIN(W) do { _Pragma("unroll") for (int i = 1; i < (W); ++i) { const int sp = spos - i; \
            if (sp >= 0) { const u32x2 wi = *(const GAS u32x2*)(c.Xb + (size_t)(r - i) * D + c0); sum += (f32x4){bflo(wi.x), bfhi(wi.x), bflo(wi.y), bfhi(wi.y)} * rst[r - i] * gv; } \
            else if (samp) sum += *(const GAS f32x4*)(state_d + (size_t)(sbb * 15 + 15 + sp) * D + c0); } } while (0)
        if (w == 2) POOL_WIN(2); else if (w == 4) POOL_WIN(4); else if (w == 8) POOL_WIN(8); else POOL_WIN(16);
#undef POOL_WIN
        const float cnt = samp ? (float)w : (float)((spos + 1) < w ? (spos + 1) : w);
        const f32x4 dp = sum / cnt - ht;
        *(GAS u32x2*)(DP + (size_t)r * D + c0) = pack4(dp);
        if (!samp) { if (spos >= SEQ - 15) *(GAS f32x4*)(c.out + O_DPP + (size_t)((r >> 14) * 15 + (spos - (SEQ - 15))) * D + c0) = ht; }
        else { if (spos >= 17) *(GAS f32x4*)(c.out + O_DPS + (size_t)(sbb * 15 + (spos - 17)) * D + c0) = ht; }
    }
}
__device__ __forceinline__ void ph_final(const Args& a) {
    const Ctx c = mkctx(a);
    const float* sq = ssqb(c, 8); const float* gf = INP(11);
    for (int r = c.gw; r < M; r += c.NWV) {
        const float rs = rstd_row(sq, r);
#pragma unroll
        for (int j = 0; j < 4; ++j) { const int cc_ = j * 256 + c.lane * 4; const u32x2 w = *(const GAS u32x2*)(c.Xb + (size_t)r * D + cc_);
            const f32x4 xv = {bflo(w.x), bfhi(w.x), bflo(w.y), bfhi(w.y)};
            *(GAS f32x4*)(c.X + (size_t)r * D + cc_) = xv * rs * *(const GAS f32x4*)(gf + cc_); }
    }
}

#ifdef SKIP_PH_PROLOGUE
#define ON_PH_PROLOGUE(x)
#else
#define ON_PH_PROLOGUE(x) x
#endif
#ifdef SKIP_PH_L0_QKV
#define ON_PH_L0_QKV(x)
#else
#define ON_PH_L0_QKV(x) x
#endif
#ifdef SKIP_PH_L0_ATTN
#define ON_PH_L0_ATTN(x)
#else
#define ON_PH_L0_ATTN(x) x
#endif
#ifdef SKIP_PH_L0_OUT
#define ON_PH_L0_OUT(x)
#else
#define ON_PH_L0_OUT(x) x
#endif
#ifdef SKIP_PH_L1_DOWN
#define ON_PH_L1_DOWN(x)
#else
#define ON_PH_L1_DOWN(x) x
#endif
#ifdef SKIP_PH_L1_ROWS
#define ON_PH_L1_ROWS(x)
#else
#define ON_PH_L1_ROWS(x) x
#endif
#ifdef SKIP_PH_L1_UQ
#define ON_PH_L1_UQ(x)
#else
#define ON_PH_L1_UQ(x) x
#endif
#ifdef SKIP_PH_L1_EXPAND
#define ON_PH_L1_EXPAND(x)
#else
#define ON_PH_L1_EXPAND(x) x
#endif
#ifdef SKIP_PH_L1_ATTN
#define ON_PH_L1_ATTN(x)
#else
#define ON_PH_L1_ATTN(x) x
#endif
#ifdef SKIP_PH_MIX_OUT
#define ON_PH_MIX_OUT(x)
#else
#define ON_PH_MIX_OUT(x) x
#endif
#ifdef SKIP_PH_L2_IN
#define ON_PH_L2_IN(x)
#else
#define ON_PH_L2_IN(x) x
#endif
#ifdef SKIP_PH_L2_CONV
#define ON_PH_L2_CONV(x)
#else
#define ON_PH_L2_CONV(x) x
#endif
#ifdef SKIP_PH_L3_POOL
#define ON_PH_L3_POOL(x)
#else
#define ON_PH_L3_POOL(x) x
#endif
#ifdef SKIP_PH_FFN_UP
#define ON_PH_FFN_UP(x)
#else
#define ON_PH_FFN_UP(x) x
#endif
#ifdef SKIP_PH_FFN_CONV
#define ON_PH_FFN_CONV(x)
#else
#define ON_PH_FFN_CONV(x) x
#endif
#ifdef SKIP_PH_FFN_DOWN
#define ON_PH_FFN_DOWN(x)
#else
#define ON_PH_FFN_DOWN(x) x
#endif
#ifdef SKIP_PH_FINAL
#define ON_PH_FINAL(x)
#else
#define ON_PH_FINAL(x) x
#endif
__global__ void __launch_bounds__(NTHREADS, 2) mega_fwd(Args a) {
    extern __shared__ __attribute__((aligned(16))) unsigned char lds_raw[];
    LAS unsigned char* lds = (LAS unsigned char*)lds_raw;
    cg::grid_group grid = cg::this_grid();
    if (gridDim.x == 0xffffffffu) grid.sync();
    int nrep_attn = PROBE_ATTN_REPS; asm volatile("" : "+s"(nrep_attn));
    int nrep_conv = PROBE_CONV_REPS; asm volatile("" : "+s"(nrep_conv));
    int nrep_sync = PROBE_SYNC_REPS; asm volatile("" : "+s"(nrep_sync));
    LAS unsigned* bst = (LAS unsigned*)(lds + 131072 + 2048);
    if (threadIdx.x < 2) bst[threadIdx.x] = 0u;
    __syncthreads();
    unsigned char* wsb = a.ws; asm volatile("" : "+s"(wsb));
    const XcdBarrier xbar = xcd_barrier_post((unsigned*)wsb, (volatile LAS unsigned*)bst);
#define GSYNC() do { for (int q_ = 0; q_ < nrep_sync; ++q_) { xcd_barrier(xbar); } } while (0)
    ON_PH_PROLOGUE(ph_prologue(a, lds);) GSYNC();
#pragma unroll 1
    for (int layer = 0; layer < 4; ++layer) {
        if (layer == 0) {
            ON_PH_L0_QKV(ph_l0_qkv(a, lds);) GSYNC();
            ON_PH_L0_ATTN(for (int rep = nrep_attn - 1; rep >= 0; --rep) ph_l0_attn(a, lds, rep);) GSYNC();
            ON_PH_L0_OUT(ph_l0_out(a, lds);) GSYNC();
        } else if (layer == 1) {
            ON_PH_L1_DOWN(ph_l1_down(a, lds);) GSYNC();
            ON_PH_L1_ROWS(ph_l1_rows(a);) GSYNC();
            ON_PH_L1_UQ(ph_l1_uq(a, lds);) ON_PH_L1_EXPAND(ph_l1_expand(a, lds);) GSYNC();
            ON_PH_L1_ATTN(for (int rep = nrep_attn - 1; rep >= 0; --rep) ph_l1_attn(a, lds, rep);) GSYNC();
            ON_PH_MIX_OUT(ph_mix_out(a, lds, B1_AO, W_OB, 1024, 1024, 0, 3);) GSYNC();
        } else if (layer == 2) {
            ON_PH_L2_IN(ph_l2_in(a, lds);) GSYNC();
            ON_PH_L2_CONV(ph_l2_conv(a);) GSYNC();
            ON_PH_MIX_OUT(ph_mix_out(a, lds, B2_CP, W_COUT, 1024, 1024, 0, 5);) GSYNC();
        } else {
            ON_PH_L3_POOL(ph_l3_rstd(a);) GSYNC();
            ON_PH_L3_POOL(ph_l3_pool(a, lds);) GSYNC();
            ON_PH_MIX_OUT(ph_mix_out(a, lds, 0, W_DG, 256, 1024, 256, 7);) GSYNC();
        }
        ON_PH_FFN_UP(ph_ffn_up(a, lds, layer);) GSYNC();
        ON_PH_FFN_DOWN(ph_ffn_down(a, lds, layer);) GSYNC();
    }
    ON_PH_FINAL(ph_final(a);)
}
extern "C" void kernel_launch(void* const* d_in, const int* in_sizes, int n_in, void* d_out, int out_size, void* d_ws, size_t ws_size, hipStream_t stream) {
    static int grid = 0;
    if (grid == 0) {
        if (n_in != 33 || (size_t)out_size != O_END || ws_size < WS_END) {
            fprintf(stderr, "kernel_launch: shape mismatch n_in %d out %d (want %zu) ws %zu (want %zu)\n", n_in, out_size, (size_t)O_END, ws_size, (size_t)WS_END);
            grid = -1; return; }
        int dev = 0, cus = 0, per_cu = 0;
        hipGetDevice(&dev);
        hipDeviceGetAttribute(&cus, hipDeviceAttributeMultiprocessorCount, dev);
        if (hipFuncSetAttribute((const void*)mega_fwd, hipFuncAttributeMaxDynamicSharedMemorySize, LDS_BYTES) != hipSuccess) { fprintf(stderr, "kernel_launch: hipFuncSetAttribute failed\n"); grid = -1; return; }
        if (hipOccupancyMaxActiveBlocksPerMultiprocessor(&per_cu, (const void*)mega_fwd, NTHREADS, LDS_BYTES) != hipSuccess || per_cu < 1) { fprintf(stderr, "kernel_launch: occupancy query failed (%d)\n", per_cu); per_cu = 1; }
        (void)hipGetLastError();
        grid = cus * 1;
        fprintf(stderr, "kernel_launch: cus %d per_cu %d grid %d\n", cus, per_cu, grid);
    }
    if (grid < 0) return;
    Args a{};
    for (int i = 0; i < 33; ++i) a.in[i] = (const float*)d_in[i];
    a.out = (float*)d_out; a.ws = (unsigned char*)d_ws;
    if (hipMemsetAsync(d_ws, 0, 16384, stream) != hipSuccess) { fprintf(stderr, "kernel_launch: memset failed\n"); return; }
    void* args[] = {&a};
    hipError_t e = hipLaunchCooperativeKernel((const void*)mega_fwd, dim3(grid), dim3(NTHREADS), args, LDS_BYTES, stream);
    if (e != hipSuccess) fprintf(stderr, "kernel_launch: cooperative launch failed: %s (grid %d)\n", hipGetErrorString(e), grid);
}
```

```cpp
#include <hip/hip_runtime.h>
#include <hip/hip_cooperative_groups.h>
#include <cstdio>
#include <cstdint>
namespace cg = cooperative_groups;

#define LAS __attribute__((address_space(3)))
#define GAS __attribute__((address_space(1)))
typedef unsigned short bf16_t;
typedef short bf16x8 __attribute__((ext_vector_type(8)));
typedef short s16x4 __attribute__((ext_vector_type(4)));
typedef float f32x4 __attribute__((ext_vector_type(4)));
typedef float f32x16 __attribute__((ext_vector_type(16)));
typedef unsigned u32x4 __attribute__((ext_vector_type(4)));
typedef unsigned u32x2 __attribute__((ext_vector_type(2)));

constexpr int D = 1024, SEQ = 16384, NBP = 2, MP = NBP * SEQ, SBN = 8, STN = 32, MS = SBN * STN, M = MP + MS;
constexpr int PAST = 1024, NKS = PAST + STN, NKSP = 1152, FF = 2816, MCACHE = SBN * PAST, MX = M + MCACHE;
constexpr float NORM_EPS = 1e-6f;
constexpr int NTHREADS = 512;
constexpr int LDS_BYTES = 131072 + 4096 + 8192;
#ifndef PROBE_CONV_REPS
#define PROBE_CONV_REPS 1
#endif
#ifndef PROBE_SYNC_REPS
#define PROBE_SYNC_REPS 3
#endif
#ifndef PROBE_ATTN_REPS
#define PROBE_ATTN_REPS 1
#endif

constexpr size_t O_Y = 0;
constexpr size_t O_AKP = (size_t)M * D;
constexpr size_t O_AVP = O_AKP + (size_t)MP * D;
constexpr size_t O_BLP = O_AVP + (size_t)MP * D;
constexpr size_t O_BRP = O_BLP + (size_t)MP * 256;
constexpr size_t O_CCP = O_BRP + (size_t)MP * 64;
constexpr size_t O_DPP = O_CCP + (size_t)NBP * 2 * D;
constexpr size_t O_FCP = O_DPP + (size_t)NBP * 15 * D;
constexpr size_t O_AKS = O_FCP + (size_t)4 * NBP * 2 * FF;
constexpr size_t O_AVS = O_AKS + (size_t)MS * D;
constexpr size_t O_BLS = O_AVS + (size_t)MS * D;
constexpr size_t O_BRS = O_BLS + (size_t)MS * 256;
constexpr size_t O_CCS = O_BRS + (size_t)MS * 64;
constexpr size_t O_DPS = O_CCS + (size_t)SBN * 2 * D;
constexpr size_t O_FCS = O_DPS + (size_t)SBN * 15 * D;
constexpr size_t O_END = O_FCS + (size_t)4 * SBN * 2 * FF;

constexpr size_t MiB = 1u << 20;
constexpr size_t WS_SSQ = 0;
constexpr size_t WS_ROPE = 2 * MiB;
constexpr size_t WS_WMIX = 6 * MiB;
constexpr size_t WS_WFFN = 29 * MiB;
constexpr size_t WS_XB = 46 * MiB;
constexpr size_t WS_BIG = 111 * MiB;
constexpr size_t WS_TAIL = 467 * MiB;
constexpr size_t WS_END = 512 * MiB;
constexpr size_t WS_SSQP = WS_TAIL + 38 * MiB;
static_assert((size_t)M * 16 * 4 <= 3 * MiB && WS_SSQP + 6 * MiB <= WS_END, "ssqp");
constexpr size_t W_QKV = 0, W_OA = W_QKV + 3072u * 1024, W_DB = W_OA + 1024u * 1024, W_UQ = W_DB + 768u * 1024, W_UKV = W_UQ + 1536u * 384,
                 W_OB = W_UKV + 2048u * 256, W_CIN = W_OB + 1024u * 1024, W_COUT = W_CIN + 3072u * 1024, W_DG = W_COUT + 1024u * 1024, W_MIX_END = W_DG + 1024u * 256;
static_assert(WS_WMIX + W_MIX_END * 2 <= WS_WFFN, "mixer weights");
constexpr size_t W_GU = 0, W_DN = 5632u * 1024, W_FFN_END = W_DN + 1024u * 2816;
static_assert(WS_WFFN + W_FFN_END * 2 <= WS_XB, "ffn weights");
static_assert(WS_XB + (size_t)M * D * 2 <= WS_BIG, "xb");
static_assert(WS_BIG + (size_t)M * 5632 * 2 <= WS_TAIL, "U");
constexpr size_t B0_Q = 0, B0_K = 65 * MiB, B0_V = 130 * MiB, B0_OS = 195 * MiB;
constexpr size_t B1_DOWN = 0, B1_CQ = 97 * MiB, B1_CKV = 122 * MiB, B1_KN = 143 * MiB, B1_KR = 208 * MiB, B1_V = 213 * MiB, B1_AO = 278 * MiB;
constexpr size_t B2_CIN = 0, B2_CP = 194 * MiB;
static_assert(B0_OS + (size_t)M * D * 4 <= 356 * MiB && B1_AO + 65 * MiB <= 356 * MiB, "big");
static_assert((size_t)MX * 256 * 2 <= 21 * MiB && (size_t)M * 1536 * 2 <= 97 * MiB && (size_t)M * 768 * 4 <= 97 * MiB, "big2");
constexpr size_t T_K = 0, T_V = 18 * MiB, T_KR = 36 * MiB;
static_assert((size_t)SBN * NKSP * D * 2 <= 18 * MiB && WS_TAIL + T_KR + (size_t)SBN * NKSP * 64 * 2 <= WS_END, "tail");

__device__ __forceinline__ unsigned cvt_pk(float lo, float hi) { unsigned r; asm volatile("v_cvt_pk_bf16_f32 %0, %1, %2" : "=v"(r) : "v"(lo), "v"(hi)); return r; }
__device__ __forceinline__ bf16_t f2bf(float f) { return (bf16_t)(cvt_pk(f, 0.f) & 0xffffu); }
__device__ __forceinline__ u32x2 pack4(f32x4 v) { u32x2 w; w.x = cvt_pk(v[0], v[1]); w.y = cvt_pk(v[2], v[3]); return w; }
__device__ __forceinline__ u32x4 pack8(f32x4 a, f32x4 b) { u32x4 w; w.x = cvt_pk(a[0], a[1]); w.y = cvt_pk(a[2], a[3]); w.z = cvt_pk(b[0], b[1]); w.w = cvt_pk(b[2], b[3]); return w; }
__device__ __forceinline__ float bflo(unsigned w) { return __uint_as_float(w << 16); }
__device__ __forceinline__ float bfhi(unsigned w) { return __uint_as_float(w & 0xffff0000u); }
__device__ __forceinline__ void unpack8(u32x4 w, float* f) { f[0] = bflo(w.x); f[1] = bfhi(w.x); f[2] = bflo(w.y); f[3] = bfhi(w.y); f[4] = bflo(w.z); f[5] = bfhi(w.z); f[6] = bflo(w.w); f[7] = bfhi(w.w); }
__device__ __forceinline__ float rstd_of(float ssq) { return rsqrtf(ssq * (1.0f / 1024.0f) + NORM_EPS); }
__device__ __forceinline__ float rstd_row(const float* __restrict__ p, int row) {
    const f32x4* q = (const f32x4*)(p + (size_t)row * 16);
    const f32x4 a = q[0], b = q[1], c = q[2], d = q[3];
    const float s = (((a[0] + a[1]) + (a[2] + a[3])) + ((b[0] + b[1]) + (b[2] + b[3]))) + (((c[0] + c[1]) + (c[2] + c[3])) + ((d[0] + d[1]) + (d[2] + d[3])));
    return rstd_of(s);
}
__device__ __forceinline__ float wave_sum(float v) {
#pragma unroll
    for (int o = 32; o >= 1; o >>= 1) v += __shfl_xor(v, o);
    return v;
}

namespace pg8 {
constexpr int BM = 256, BK = 64, HALF = 128, HTB = HALF * BK * 2, STAGE_BYTES = 8 * HTB, NXCD = 8, WGM = 8;
__host__ __device__ __forceinline__ int lds_byte(int r, int c) { const int st = (r >> 4) * 2 + (c >> 5), rr = r & 15, cc = c & 31, ob = rr * 64 + cc * 2; return st * 1024 + (ob ^ (((ob >> 9) & 1) << 5)); }
__host__ __device__ __forceinline__ void stage_rc(int b, int& R, int& C) { const int st = b / 1024, sb = b % 1024, swz = sb ^ (((sb >> 9) & 1) << 5); R = (st >> 1) * 16 + swz / 64; C = (st & 1) * 32 + (swz % 64) / 2; }
struct Unit { int pm, pn; };
struct Gemm { const bf16_t* A; const bf16_t* Bt; int M, N, K, lda, a_pn_step; int mrows = 256, moff = 0, ldb = 0; };
struct StaticOrder {
    int nM, nN, nwg, G, c;
    __device__ void init(int M_, int N_, int G_, int c_) { nM = M_ / BM; nN = N_ / BM; nwg = nM * nN; G = G_; c = c_; }
    __device__ void init2(int nM_, int nN_, int G_, int c_) { nM = nM_; nN = nN_; nwg = nM * nN; G = G_; c = c_; }
    __device__ bool next(int i, Unit& u) const {
        const long L = (long)i * G + c; if (L >= nwg) return false;
        int wgid = (int)L; { const int q = nwg / NXCD, r = nwg % NXCD, xcd = wgid % NXCD, off = wgid / NXCD; wgid = (xcd < r ? xcd * (q + 1) : r * (q + 1) + (xcd - r) * q) + off; }
        const int nig = WGM * nN, gid = wgid / nig, fm = gid * WGM, gsz = (nM - fm) < WGM ? (nM - fm) : WGM;
        u.pm = fm + ((wgid % nig) % gsz); u.pn = (wgid % nig) / gsz; return true;
    }
};
struct SingleUnit { int pm, pn; __device__ bool next(int i, Unit& u) const { if (i != 0) return false; u.pm = pm; u.pn = pn; return true; } };
template <class Epi, class Sched>
__device__ __forceinline__ void gemm_phase(LAS unsigned char* lds, const Gemm g, const Sched& S, const Epi& E) {
    int tid = threadIdx.x; asm volatile("" : "+v"(tid));
    const int wid = __builtin_amdgcn_readfirstlane(tid >> 6), lane = tid & 63, wr = wid >> 2, wc = wid & 3, fr = lane & 15, fq = lane >> 4;
    const int K = g.K, nt = K / BK;
    unsigned voffA[2], voffB[2];
#pragma unroll
    for (int i = 0; i < 2; ++i) { int R, C; stage_rc(tid * 16 + i * 8192, R, C); voffA[i] = (unsigned)(R * g.lda + C) * 2u; voffB[i] = (unsigned)(R * (g.ldb ? g.ldb : K) + C) * 2u; }
    const size_t kstep = (size_t)(BK * 2);
    const size_t hstepA = (size_t)HALF * g.lda * 2, hstepB = (size_t)HALF * (g.ldb ? g.ldb : K) * 2;
    const size_t tstepA = (size_t)g.mrows * g.lda * 2, tstepB = 2 * hstepB, apn = (size_t)g.a_pn_step * 2;
    const char* const Abase = (const char*)g.A + (long)g.moff * g.lda * 2;
    const unsigned ldsw = (unsigned)wid * 1024u;
    const int aoff = lds_byte(wr * 64 + fr, fq * 8), boff = lds_byte(wc * 32 + fr, fq * 8);
#define PG8_SA(b, h) (((b) * 2 + (h)) * HTB)
#define PG8_SB(b, h) ((4 + (b) * 2 + (h)) * HTB)
#define PG8_STAGE(bufoff, gbase, voff) do { _Pragma("unroll") for (int _i = 0; _i < 2; ++_i) \
        __builtin_amdgcn_global_load_lds((const unsigned*)((const char*)(gbase) + (voff)[_i]), (LAS unsigned*)(lds + (bufoff) + ldsw + _i * 8192), 16, 0, 0); } while (0)
#define PG8_LDA(dst, b, h) do { _Pragma("unroll") for (int m = 0; m < 4; ++m) _Pragma("unroll") for (int k = 0; k < 2; ++k) dst[m][k] = *(const LAS bf16x8*)(lds + PG8_SA(b, h) + aoff + m * 2048 + k * 1024); } while (0)
#define PG8_LDB(dst, b, h) do { _Pragma("unroll") for (int n = 0; n < 2; ++n) _Pragma("unroll") for (int k = 0; k < 2; ++k) dst[n][k] = *(const LAS bf16x8*)(lds + PG8_SB(b, h) + boff + n * 2048 + k * 1024); } while (0)
#define PG8_MMA(ai, bj, At, Bt) do { __builtin_amdgcn_s_setprio(1); _Pragma("unroll") for (int m = 0; m < 4; ++m) _Pragma("unroll") for (int n = 0; n < 2; ++n) _Pragma("unroll") for (int k = 0; k < 2; ++k) \
        acc[ai][bj][m][n] = __builtin_amdgcn_mfma_f32_16x16x32_bf16(Bt[n][k], At[m][k], acc[ai][bj][m][n], 0, 0, 0); __builtin_amdgcn_s_setprio(0); } while (0)
#define PG8_WAIT_V(n) asm volatile("s_waitcnt vmcnt(" #n ")" ::: "memory")
#define PG8_WAIT_L(n) asm volatile("s_waitcnt lgkmcnt(" #n ")" ::: "memory")
#define PG8_BAR __builtin_amdgcn_s_barrier()
#define PG8_SCHED __builtin_amdgcn_sched_barrier(0)
    Unit cur, nxt; int ui = 0;
    if (!S.next(0, cur)) return;
    f32x4 acc[2][2][4][2];
#pragma unroll
    for (int a = 0; a < 2; ++a)
#pragma unroll
        for (int b = 0; b < 2; ++b)
#pragma unroll
            for (int m = 0; m < 4; ++m)
#pragma unroll
                for (int n = 0; n < 2; ++n) acc[a][b][m][n] = (f32x4){0.f, 0.f, 0.f, 0.f};
    bf16x8 At[4][2], B0[2][2], B1[2][2];
    const char* cA = Abase + (size_t)cur.pm * tstepA + (size_t)cur.pn * apn; const char* cB = (const char*)g.Bt + (size_t)cur.pn * tstepB;
    PG8_STAGE(PG8_SB(0, 0), cB, voffB); PG8_STAGE(PG8_SB(0, 1), cB + hstepB, voffB); PG8_STAGE(PG8_SA(0, 0), cA, voffA); PG8_STAGE(PG8_SA(0, 1), cA + hstepA, voffA);
    if (wr == 1) PG8_BAR;
    PG8_WAIT_V(2); PG8_BAR;
    PG8_STAGE(PG8_SB(1, 0), cB + kstep, voffB); PG8_STAGE(PG8_SA(1, 0), cA + kstep, voffA); PG8_STAGE(PG8_SB(1, 1), cB + hstepB + kstep, voffB);
    PG8_WAIT_V(6); PG8_BAR;
    for (;;) {
        const bool has_next = S.next(ui + 1, nxt);
        const char* nA = has_next ? Abase + (size_t)nxt.pm * tstepA + (size_t)nxt.pn * apn : cA; const char* nB = has_next ? (const char*)g.Bt + (size_t)nxt.pn * tstepB : cB;
#pragma unroll 1
        for (int t = 0; t < nt; t += 2) {
            const bool last = (t == nt - 2);
            const char* a1 = cA + (size_t)(t + 1) * kstep;
            const char* a2 = last ? nA : cA + (size_t)(t + 2) * kstep; const char* b2 = last ? nB : cB + (size_t)(t + 2) * kstep;
            const char* a3 = a2 + kstep; const char* b3 = b2 + kstep;
            PG8_LDB(B0, 0, 0); PG8_LDB(B1, 0, 1); PG8_SCHED; PG8_LDA(At, 0, 0); PG8_STAGE(PG8_SA(1, 1), a1 + hstepA, voffA);
            PG8_WAIT_V(8); PG8_WAIT_L(0); PG8_BAR; PG8_MMA(0, 0, At, B0); PG8_MMA(0, 1, At, B1); PG8_BAR; PG8_SCHED;
            PG8_LDA(At, 0, 1); PG8_STAGE(PG8_SB(0, 0), b2, voffB); PG8_STAGE(PG8_SB(0, 1), b2 + hstepB, voffB); PG8_STAGE(PG8_SA(0, 0), a2, voffA);
            PG8_WAIT_V(8); PG8_WAIT_L(0); PG8_BAR; PG8_MMA(1, 0, At, B0); PG8_MMA(1, 1, At, B1); PG8_BAR; PG8_SCHED;
            PG8_LDB(B0, 1, 0); PG8_LDB(B1, 1, 1); PG8_SCHED; PG8_LDA(At, 1, 0); PG8_STAGE(PG8_SA(0, 1), a2 + hstepA, voffA);
            PG8_WAIT_V(8); PG8_WAIT_L(0); PG8_BAR; PG8_MMA(0, 0, At, B0); PG8_MMA(0, 1, At, B1); PG8_BAR; PG8_SCHED;
            PG8_LDA(At, 1, 1); PG8_STAGE(PG8_SB(1, 0), b3, voffB); PG8_STAGE(PG8_SB(1, 1), b3 + hstepB, voffB); PG8_STAGE(PG8_SA(1, 0), a3, voffA);
            PG8_WAIT_V(8); PG8_WAIT_L(0); PG8_BAR; PG8_MMA(1, 0, At, B0); PG8_MMA(1, 1, At, B1); PG8_BAR; PG8_SCHED;
        }
        if (wr == 0) PG8_BAR;
        E(acc, cur, wr, wc, fr, fq);
        if (!has_next) break;
#pragma unroll
        for (int a = 0; a < 2; ++a)
#pragma unroll
            for (int b = 0; b < 2; ++b)
#pragma unroll
                for (int m = 0; m < 4; ++m)
#pragma unroll
                    for (int n = 0; n < 2; ++n) acc[a][b][m][n] = (f32x4){0.f, 0.f, 0.f, 0.f};
        cur = nxt; cA = nA; cB = nB; ++ui;
        if (wr == 1) PG8_BAR;
    }
    PG8_WAIT_V(0);
    PG8_BAR;
#undef PG8_SA
#undef PG8_SB
#undef PG8_STAGE
#undef PG8_LDA
#undef PG8_LDB
#undef PG8_MMA
#undef PG8_WAIT_V
#undef PG8_WAIT_L
#undef PG8_BAR
#undef PG8_SCHED
}
}
using pg8::Unit;
typedef f32x4 Acc[2][2][4][2];

struct EpiBf16 {
    bf16_t* O; int ldc; const float* ssq; float* tap_p; float* tap_s; int tap_cols;
    __device__ __forceinline__ void operator()(const Acc& acc, const Unit& u, int wr, int wc, int fr, int fq) const {
#pragma unroll
        for (int ai = 0; ai < 2; ++ai)
#pragma unroll
            for (int m = 0; m < 4; ++m) {
                asm volatile("" ::: "memory");
                const int row = u.pm * 256 + ai * 128 + wr * 64 + m * 16 + fr;
                const float rs = ssq ? rstd_row(ssq, row) : 1.f;
                float* trow = nullptr;
                if (tap_cols) {
                    if (row < MP) { const int s = row & (SEQ - 1); if (s >= SEQ - 2) trow = tap_p + (size_t)((row >> 14) * 2 + (s - (SEQ - 2))) * FF; }
                    else { const int t = (row - MP) & 31; if (t >= 30) trow = tap_s + (size_t)(((row - MP) >> 5) * 2 + (t - 30)) * FF; }
                }
#pragma unroll
                for (int bj = 0; bj < 2; ++bj) {
                    const int col0 = u.pn * 256 + bj * 128 + wc * 32 + fq * 8;
                    const f32x4 v0 = acc[ai][bj][m][0] * rs, v1 = acc[ai][bj][m][1] * rs;
                    *(GAS u32x4*)(O + (size_t)row * ldc + col0) = pack8(v0, v1);
                    if (trow && col0 < tap_cols) { *(GAS f32x4*)(trow + col0) = v0; *(GAS f32x4*)(trow + col0 + 4) = v1; }
                }
            }
    }
};
struct EpiF32 {
    float* O; int ldc; const float* ssq;
    __device__ __forceinline__ void operator()(const Acc& acc, const Unit& u, int wr, int wc, int fr, int fq) const {
#pragma unroll
        for (int ai = 0; ai < 2; ++ai)
#pragma unroll
            for (int m = 0; m < 4; ++m) {
                asm volatile("" ::: "memory");
                const int row = u.pm * 256 + ai * 128 + wr * 64 + m * 16 + fr;
                const float rs = rstd_row(ssq, row);
#pragma unroll
                for (int bj = 0; bj < 2; ++bj) {
                    const int col0 = u.pn * 256 + bj * 128 + wc * 32 + fq * 8;
                    *(GAS f32x4*)(O + (size_t)row * ldc + col0) = acc[ai][bj][m][0] * rs;
                    *(GAS f32x4*)(O + (size_t)row * ldc + col0 + 4) = acc[ai][bj][m][1] * rs;
                }
            }
    }
};
struct EpiSlab {
    float* P;
    __device__ __forceinline__ void operator()(const Acc& acc, const Unit& u, int wr, int wc, int fr, int fq) const {
#pragma unroll
        for (int ai = 0; ai < 2; ++ai)
#pragma unroll
            for (int m = 0; m < 4; ++m) {
                const int row_l = ai * 128 + wr * 64 + m * 16 + fr;
#pragma unroll
                for (int bj = 0; bj < 2; ++bj) {
                    const int col_l = bj * 128 + wc * 32 + fq * 8;
                    *(GAS f32x4*)(P + row_l * 256 + col_l) = acc[ai][bj][m][0]; *(GAS f32x4*)(P + row_l * 256 + col_l + 4) = acc[ai][bj][m][1];
                }
            }
    }
};
template <bool F32IN> struct EpiResidT {
    const float* rp; const float* rsm; bf16_t* Xb; float* ssq_out;
    __device__ __forceinline__ void operator()(const Acc& acc, const Unit& u, int wr, int wc, int fr, int fq) const {
#pragma unroll
        for (int ai = 0; ai < 2; ++ai)
#pragma unroll
            for (int m = 0; m < 4; ++m) {
                asm volatile("" ::: "memory");
                const int row = u.pm * 256 + ai * 128 + wr * 64 + m * 16 + fr;
                float ss = 0.f;
#pragma unroll
                for (int bj = 0; bj < 2; ++bj) {
                    const int col0 = u.pn * 256 + bj * 128 + wc * 32 + fq * 8;
                    f32x4 r0, r1;
                    if (F32IN) { const float* rrow = (row < MP) ? rp + (size_t)row * D : rsm + (size_t)(row - MP) * D; r0 = *(const GAS f32x4*)(rrow + col0); r1 = *(const GAS f32x4*)(rrow + col0 + 4); }
                    else { const u32x4 w = *(const GAS u32x4*)(Xb + (size_t)row * D + col0); r0 = (f32x4){bflo(w.x), bfhi(w.x), bflo(w.y), bfhi(w.y)}; r1 = (f32x4){bflo(w.z), bfhi(w.z), bflo(w.w), bfhi(w.w)}; }
                    const f32x4 v0 = r0 + acc[ai][bj][m][0], v1 = r1 + acc[ai][bj][m][1];
                    *(GAS u32x4*)(Xb + (size_t)row * D + col0) = pack8(v0, v1);
                    ss += (v0[0] * v0[0] + v0[1] * v0[1]) + (v0[2] * v0[2] + v0[3] * v0[3]) + (v1[0] * v1[0] + v1[1] * v1[1]) + (v1[2] * v1[2] + v1[3] * v1[3]);
                }
                ss += __shfl_xor(ss, 16); ss += __shfl_xor(ss, 32);
                if (fq == 0) ssq_out[(size_t)row * 16 + u.pn * 4 + wc] = ss;
            }
    }
};

__device__ __forceinline__ float dpp_shr1(float oldv, float x) { return __int_as_float(__builtin_amdgcn_update_dpp(__float_as_int(oldv), __float_as_int(x), 0x111, 0xf, 0xf, false)); }
__device__ __forceinline__ float dpp_shr2(float oldv, float x) { return __int_as_float(__builtin_amdgcn_update_dpp(__float_as_int(oldv), __float_as_int(x), 0x112, 0xf, 0xf, false)); }
__device__ __forceinline__ float dpp_ror1(float x) { return __int_as_float(__builtin_amdgcn_update_dpp(0, __float_as_int(x), 0x121, 0xf, 0xf, false)); }
__device__ __forceinline__ float dpp_ror2(float x) { return __int_as_float(__builtin_amdgcn_update_dpp(0, __float_as_int(x), 0x122, 0xf, 0xf, false)); }
struct EpiFfn {
    bf16_t* ACT; const float* ssq; const float* cw; const float* cb; const float* st; float* tap_p; float* tap_s; LAS unsigned char* slab;
    __device__ __forceinline__ void operator()(Acc& acc, const Unit& u, int wr, int wc, int fr, int fq) const {
        asm volatile("" : "+v"(fr), "+v"(fq), "+s"(wr), "+s"(wc));
        const int r_lo = u.pm * 254 - 2;
        const bool has_start = (r_lo <= 0) || (r_lo <= SEQ && r_lo + 255 >= SEQ) || (r_lo + 255 >= MP);
        LAS float* rl = (LAS float*)(slab + 6144);
        { const int t_ = (wr * 4 + wc) * 64 + fq * 16 + fr, rw = t_ >> 1;
          const float* pp = ssq + (size_t)(r_lo + rw) * 16 + (t_ & 1) * 8;
          const f32x4 a_ = *(const GAS f32x4*)pp, b_ = *(const GAS f32x4*)(pp + 4);
          float sm = ((a_[0] + a_[1]) + (a_[2] + a_[3])) + ((b_[0] + b_[1]) + (b_[2] + b_[3]));
          sm += __shfl_xor(sm, 1);
          if ((t_ & 1) == 0) rl[rw] = rstd_of(sm); }
        asm volatile("s_waitcnt lgkmcnt(0)" ::: "memory"); __builtin_amdgcn_s_barrier(); asm volatile("" ::: "memory");
#pragma unroll
        for (int ai = 0; ai < 2; ++ai)
#pragma unroll
            for (int m = 0; m < 4; ++m) { const float rs = rl[ai * 128 + wr * 64 + m * 16 + fr];
#pragma unroll
                for (int bj = 0; bj < 2; ++bj) { acc[ai][bj][m][0] = acc[ai][bj][m][0] * rs; acc[ai][bj][m][1] = acc[ai][bj][m][1] * rs; } }
        LAS f32x4* sl = (LAS f32x4*)slab;
        if (fr >= 14) {
#pragma unroll
            for (int ai = 0; ai < 2; ++ai)
#pragma unroll
                for (int bj = 0; bj < 2; ++bj) sl[((((ai * 2 + wr) * 4 + wc) * 2 + bj) * 2 + (fr - 14)) * 4 + fq] = acc[ai][bj][3][0];
        }
        asm volatile("s_waitcnt lgkmcnt(0)" ::: "memory"); __builtin_amdgcn_s_barrier(); asm volatile("" ::: "memory");
#pragma unroll
        for (int bj = 0; bj < 2; ++bj) {
            const int cbase = u.pn * 128 + bj * 64 + wc * 16 + fq * 4;
            u32x2 wq0, wq1, wq2, wqb;
            { const f32x4 t0 = *(const GAS f32x4*)(cw + cbase), t1 = *(const GAS f32x4*)(cw + FF + cbase), t2 = *(const GAS f32x4*)(cw + 2 * FF + cbase), tb = *(const GAS f32x4*)(cb + cbase);
              wq0 = pack4(t0); wq1 = pack4(t1); wq2 = pack4(t2); wqb = pack4(tb); }
#pragma unroll
            for (int ai = 0; ai < 2; ++ai) {
                asm volatile("" ::: "memory");
                f32x4 H = {0.f, 0.f, 0.f, 0.f};
                if ((ai | wr) != 0 && fr >= 14) { const int sai = wr ? ai : ai - 1, swr = wr ? 0 : 1; H = sl[((((sai * 2 + swr) * 4 + wc) * 2 + bj) * 2 + (fr - 14)) * 4 + fq]; }
                f32x4 uprev = H;
#pragma unroll
                for (int m = 0; m < 4; ++m) {
                    asm volatile("" ::: "memory");
                    const int row_l = ai * 128 + wr * 64 + m * 16 + fr, grow = r_lo + row_l;
                    const f32x4 uu = acc[ai][bj][m][0], up = acc[ai][bj][m][1];
                    f32x4 p1, p2;
#pragma unroll
                    for (int i = 0; i < 4; ++i) { p1[i] = dpp_shr1(dpp_ror1(uprev[i]), uu[i]); p2[i] = dpp_shr2(dpp_ror2(uprev[i]), uu[i]); }
                    if (has_start) {
                        const bool samp = grow >= MP;
                        const int sp = samp ? ((grow - MP) & 31) : (grow & (SEQ - 1));
                        if (grow >= 0 && grow < M && sp < 2) {
                            f32x4 h0 = {0.f, 0.f, 0.f, 0.f}, h1 = {0.f, 0.f, 0.f, 0.f};
                            if (samp) { const int sbb = (grow - MP) >> 5; h0 = *(const GAS f32x4*)(st + (size_t)(sbb * 2 + 0) * FF + cbase); h1 = *(const GAS f32x4*)(st + (size_t)(sbb * 2 + 1) * FF + cbase); }
                            if (sp == 0) { p1 = h1; p2 = h0; } else { p2 = h1; }
                        }
                    }
                    f32x4 gs = (f32x4){bflo(wqb.x), bfhi(wqb.x), bflo(wqb.y), bfhi(wqb.y)} + (f32x4){bflo(wq2.x), bfhi(wq2.x), bflo(wq2.y), bfhi(wq2.y)} * uu;
                    gs += (f32x4){bflo(wq1.x), bfhi(wq1.x), bflo(wq1.y), bfhi(wq1.y)} * p1;
                    gs += (f32x4){bflo(wq0.x), bfhi(wq0.x), bflo(wq0.y), bfhi(wq0.y)} * p2;
                    f32x4 act;
#pragma unroll
                    for (int i = 0; i < 4; ++i) act[i] = gs[i] * __builtin_amdgcn_rcpf(1.f + __expf(-gs[i])) * up[i];
                    if (row_l >= 2 && grow < M) {
                        *(GAS u32x2*)(ACT + (size_t)grow * FF + cbase) = pack4(act);
                        float* trow = nullptr;
                        if (grow < MP) { const int s_ = grow & (SEQ - 1); if (s_ >= SEQ - 2) trow = tap_p + (size_t)((grow >> 14) * 2 + (s_ - (SEQ - 2))) * FF; }
                        else { const int t_ = (grow - MP) & 31; if (t_ >= 30) trow = tap_s + (size_t)(((grow - MP) >> 5) * 2 + (t_ - 30)) * FF; }
                        if (trow) *(GAS f32x4*)(trow + cbase) = uu;
                    }
                    uprev = uu;
                }
            }
        }
    }
};
struct EpiQKV {
    const float* ssq; const float* rope; bf16_t* Q; bf16_t* Kb; bf16_t* Vb; bf16_t* Ks; bf16_t* Vs; float* okp; float* ovp; float* oks; float* ovs;
    __device__ __forceinline__ void operator()(const Acc& acc, const Unit& u, int wr, int wc, int fr, int fq) const {
        const int part = u.pn >> 2;
#pragma unroll
        for (int ai = 0; ai < 2; ++ai)
#pragma unroll
            for (int m = 0; m < 4; ++m) {
                asm volatile("" ::: "memory");
                const int row = u.pm * 256 + ai * 128 + wr * 64 + m * 16 + fr;
                const float rs = rstd_row(ssq, row);
                const bool samp = row >= MP;
                const int sr_ = row - MP, sbb = sr_ >> 5, tt = sr_ & 31;
                const int pos = samp ? PAST + tt : (row & (SEQ - 1));
                const size_t crow = (size_t)(sbb * NKSP + PAST + tt);
                if (part < 2) {
                    const int w = wc & 1, d0 = 16 * w + 4 * fq;
                    const f32x4 cs = *(const GAS f32x4*)(rope + (size_t)pos * 64 + d0), sn = *(const GAS f32x4*)(rope + (size_t)pos * 64 + 32 + d0);
#pragma unroll
                    for (int bj = 0; bj < 2; ++bj) {
                        const int lc = ((u.pn & 3) * 256 + bj * 128 + (wc >> 1) * 64) + d0;
                        const f32x4 x1 = acc[ai][bj][m][0] * rs, x2 = acc[ai][bj][m][1] * rs;
                        const f32x4 y1 = x1 * cs - x2 * sn, y2 = x2 * cs + x1 * sn;
                        if (part == 0) {
                            *(GAS u32x2*)(Q + (size_t)row * D + lc) = pack4(y1); *(GAS u32x2*)(Q + (size_t)row * D + lc + 32) = pack4(y2);
                        } else if (!samp) {
                            *(GAS u32x2*)(Kb + (size_t)row * D + lc) = pack4(y1); *(GAS u32x2*)(Kb + (size_t)row * D + lc + 32) = pack4(y2);
                            *(GAS f32x4*)(okp + (size_t)row * D + lc) = y1; *(GAS f32x4*)(okp + (size_t)row * D + lc + 32) = y2;
                        } else {
                            *(GAS u32x2*)(Ks + crow * D + lc) = pack4(y1); *(GAS u32x2*)(Ks + crow * D + lc + 32) = pack4(y2);
                            *(GAS f32x4*)(oks + (size_t)sr_ * D + lc) = y1; *(GAS f32x4*)(oks + (size_t)sr_ * D + lc + 32) = y2;
                        }
                    }
                } else {
#pragma unroll
                    for (int bj = 0; bj < 2; ++bj) {
                        const int lc = (u.pn & 3) * 256 + bj * 128 + wc * 32 + fq * 8;
                        const f32x4 v0 = acc[ai][bj][m][0] * rs, v1 = acc[ai][bj][m][1] * rs;
                        if (!samp) {
                            *(GAS u32x4*)(Vb + (size_t)row * D + lc) = pack8(v0, v1);
                            *(GAS f32x4*)(ovp + (size_t)row * D + lc) = v0; *(GAS f32x4*)(ovp + (size_t)row * D + lc + 4) = v1;
                        } else {
                            *(GAS u32x4*)(Vs + crow * D + lc) = pack8(v0, v1);
                            *(GAS f32x4*)(ovs + (size_t)sr_ * D + lc) = v0; *(GAS f32x4*)(ovs + (size_t)sr_ * D + lc + 4) = v1;
                        }
                    }
                }
            }
    }
};
struct EpiUQ {
    const float* rope; bf16_t* QB;
    __device__ __forceinline__ void operator()(const Acc& acc, const Unit& u, int wr, int wc, int fr, int fq) const {
#pragma unroll
        for (int ai = 0; ai < 2; ++ai)
#pragma unroll
            for (int m = 0; m < 4; ++m) {
                asm volatile("" ::: "memory");
                const int row = u.pm * 256 + ai * 128 + wr * 64 + m * 16 + fr;
                const int pos = row >= MP ? PAST + ((row - MP) & 31) : (row & (SEQ - 1));
#pragma unroll
                for (int bj = 0; bj < 2; ++bj) {
                    const int G = u.pn * 4 + bj * 2 + (wc >> 1);
                    if (G % 3 == 2) {
                        const int d0 = 16 * (wc & 1) + 4 * fq, lc = G * 64 + d0;
                        const f32x4 cs = *(const GAS f32x4*)(rope + (size_t)pos * 64 + d0), sn = *(const GAS f32x4*)(rope + (size_t)pos * 64 + 32 + d0);
                        const f32x4 x1 = acc[ai][bj][m][0], x2 = acc[ai][bj][m][1];
                        *(GAS u32x2*)(QB + (size_t)row * 1536 + lc) = pack4(x1 * cs - x2 * sn); *(GAS u32x2*)(QB + (size_t)row * 1536 + lc + 32) = pack4(x2 * cs + x1 * sn);
                    } else {
                        const int lc = u.pn * 256 + bj * 128 + wc * 32 + fq * 8;
                        *(GAS u32x4*)(QB + (size_t)row * 1536 + lc) = pack8(acc[ai][bj][m][0], acc[ai][bj][m][1]);
                    }
                }
            }
    }
};
struct EpiExpand {
    bf16_t* KN; bf16_t* VB; bf16_t* KsN; bf16_t* VsB;
    __device__ __forceinline__ void operator()(const Acc& acc, const Unit& u, int wr, int wc, int fr, int fq) const {
        const bool isk = u.pn < 4;
        bf16_t* const pbase = isk ? KN : VB; bf16_t* const sbase = isk ? KsN : VsB;
#pragma unroll
        for (int ai = 0; ai < 2; ++ai)
#pragma unroll
            for (int m = 0; m < 4; ++m) {
                asm volatile("" ::: "memory");
                const int row = u.pm * 256 + ai * 128 + wr * 64 + m * 16 + fr;
                int cr = row;
                if (row >= M) { const int s = row - M; cr = (s >> 10) * NKSP + (s & 1023); }
                else if (row >= MP) { const int s = row - MP; cr = (s >> 5) * NKSP + PAST + (s & 31); }
                bf16_t* dst = (row < MP ? pbase : sbase) + (size_t)cr * D;
#pragma unroll
                for (int bj = 0; bj < 2; ++bj) {
                    const int lc = (u.pn & 3) * 256 + bj * 128 + wc * 32 + fq * 8;
                    *(GAS u32x4*)(dst + lc) = pack8(acc[ai][bj][m][0], acc[ai][bj][m][1]);
                }
            }
    }
};

__device__ __forceinline__ void prep_w(LAS float* tile, const float* __restrict__ W, int ldw, int K, int nsrc, bf16_t* __restrict__ Bt, int nrows,
                                       int ropemode, int ropeG, const float* __restrict__ ks, int kper, float kmul, const float* __restrict__ ns, int rank = -1, int nwork = 0) {
    if (rank < 0) { rank = blockIdx.x; nwork = gridDim.x; }
    int tid = threadIdx.x; asm volatile("" : "+v"(tid));
    const int nkt = K / 64, nnt = nrows / 64;
    for (int t = rank; t < nkt * nnt; t += nwork) {
        const int kt = t % nkt, ntl = t / nkt, k0 = kt * 64, n0 = ntl * 64;
        {
            const int kk = tid >> 3, c8 = (tid & 7) * 8;
            f32x4 a = {0.f, 0.f, 0.f, 0.f}, b = {0.f, 0.f, 0.f, 0.f};
            if (n0 < nsrc) {
                a = *(const GAS f32x4*)(W + (size_t)(k0 + kk) * ldw + n0 + c8); b = *(const GAS f32x4*)(W + (size_t)(k0 + kk) * ldw + n0 + c8 + 4);
                float sc = kmul; if (ks) sc *= ks[(k0 + kk) % kper];
                a = a * sc; b = b * sc;
                if (ns) { a = a * *(const GAS f32x4*)(ns + n0 + c8); b = b * *(const GAS f32x4*)(ns + n0 + c8 + 4); }
            }
            LAS float* tp = tile + kk * 65 + c8;
            tp[0] = a[0]; tp[1] = a[1]; tp[2] = a[2]; tp[3] = a[3]; tp[4] = b[0]; tp[5] = b[1]; tp[6] = b[2]; tp[7] = b[3];
        }
        __syncthreads();
        {
            const int nl = tid >> 3, kc = (tid & 7) * 8, G = n0 >> 6;
            const bool rp = (ropemode == 1) ? (G < ropeG) : (ropemode == 3 ? (G % 3 == 2) : false);
            const int hi32 = nl >> 5, n = (nl >> 4) & 1, fq = (nl >> 2) & 3, i = nl & 3;
            const int sl = rp ? (32 * n + 16 * hi32 + 4 * fq + i) : (32 * hi32 + 8 * fq + 4 * n + i);
            float v[8];
#pragma unroll
            for (int j = 0; j < 8; ++j) v[j] = tile[(kc + j) * 65 + sl];
            u32x4 w; w.x = cvt_pk(v[0], v[1]); w.y = cvt_pk(v[2], v[3]); w.z = cvt_pk(v[4], v[5]); w.w = cvt_pk(v[6], v[7]);
            *(GAS u32x4*)(Bt + (size_t)(n0 + nl) * K + k0 + kc) = w;
        }
        __syncthreads();
    }
}


__device__ __forceinline__ void prep_gu(LAS float* tile, const float* __restrict__ Wg, const float* __restrict__ Wu, bf16_t* __restrict__ Bt, const float* __restrict__ ks, int rank = -1, int nwork = 0) {
    if (rank < 0) { rank = blockIdx.x; nwork = gridDim.x; }
    int tid = threadIdx.x; asm volatile("" : "+v"(tid));
    constexpr int K = D, nkt = K / 64, nnt = 2 * FF / 64;
    for (int t = rank; t < nkt * nnt; t += nwork) {
        const int kt = t % nkt, ntl = t / nkt, k0 = kt * 64, n0 = ntl * 64, cb0 = (n0 >> 5) * 16;
        {
            const int kk = tid >> 3, c8 = (tid & 7) * 8;
            const float* src = (c8 < 32 ? Wg + cb0 + c8 : Wu + cb0 + (c8 - 32)) + (size_t)(k0 + kk) * FF;
            f32x4 a = *(const GAS f32x4*)src, b = *(const GAS f32x4*)(src + 4);
            const float sc = ks[k0 + kk]; a = a * sc; b = b * sc;
            LAS float* tp = tile + kk * 65 + c8;
            tp[0] = a[0]; tp[1] = a[1]; tp[2] = a[2]; tp[3] = a[3]; tp[4] = b[0]; tp[5] = b[1]; tp[6] = b[2]; tp[7] = b[3];
        }
        __syncthreads();
        {
            const int nl = tid >> 3, kc = (tid & 7) * 8;
            const int sl = ((nl >> 4) & 1) * 32 + (nl >> 5) * 16 + (nl & 15);
            float v[8];
#pragma unroll
            for (int j = 0; j < 8; ++j) v[j] = tile[(kc + j) * 65 + sl];
            u32x4 w; w.x = cvt_pk(v[0], v[1]); w.y = cvt_pk(v[2], v[3]); w.z = cvt_pk(v[4], v[5]); w.w = cvt_pk(v[6], v[7]);
            *(GAS u32x4*)(Bt + (size_t)(n0 + nl) * K + k0 + kc) = w;
        }
        __syncthreads();
    }
}
__device__ __forceinline__ int crow(int r, int hi) { return (r & 3) + 8 * (r >> 2) + 4 * hi; }
#define SBAR() __builtin_amdgcn_sched_barrier(0)
__device__ __forceinline__ void partialSM(f32x16& p0, f32x16& p1, float& m_reg, float& mn, float& alpha, const float C, const float thr_raw) {
    float pmax = p0[0];
#pragma unroll
    for (int r = 1; r < 16; ++r) pmax = fmaxf(pmax, p0[r]);
#pragma unroll
    for (int r = 0; r < 16; ++r) pmax = fmaxf(pmax, p1[r]);
    { auto rr = __builtin_amdgcn_permlane32_swap(__float_as_uint(pmax), __float_as_uint(pmax), false, false);
      pmax = fmaxf(__uint_as_float(rr[0]), __uint_as_float(rr[1])); }
    if (__builtin_expect(__all(pmax - m_reg <= thr_raw), 1)) { mn = m_reg; alpha = 1.f; }
    else { mn = fmaxf(m_reg, pmax); alpha = __builtin_amdgcn_exp2f((m_reg - mn) * C); m_reg = mn; }
    const float mnC = -mn * C;
#pragma unroll
    for (int r = 0; r < 16; ++r) p0[r] = __builtin_amdgcn_exp2f(fmaf(p0[r], C, mnC));
#pragma unroll
    for (int r = 0; r < 16; ++r) p1[r] = __builtin_amdgcn_exp2f(fmaf(p1[r], C, mnC));
}
__device__ __forceinline__ void finishSM(f32x16& p0, f32x16& p1, float alpha, float& l_reg, bf16x8& pa0, bf16x8& pa1, bf16x8& pa2, bf16x8& pa3) {
    float ps = 0;
#pragma unroll
    for (int r = 0; r < 16; ++r) ps += p0[r];
#pragma unroll
    for (int r = 0; r < 16; ++r) ps += p1[r];
    { auto rr = __builtin_amdgcn_permlane32_swap(__float_as_uint(ps), __float_as_uint(ps), false, false);
      ps = __uint_as_float(rr[0]) + __uint_as_float(rr[1]); }
    l_reg = l_reg * alpha + ps;
#define PK4(P, BASE, OUT) do { unsigned a0 = cvt_pk(P[BASE + 0], P[BASE + 1]), a1 = cvt_pk(P[BASE + 2], P[BASE + 3]);   \
    unsigned b0 = cvt_pk(P[BASE + 4], P[BASE + 5]), b1 = cvt_pk(P[BASE + 6], P[BASE + 7]);                              \
    auto r0 = __builtin_amdgcn_permlane32_swap(a0, b0, false, false); auto r1 = __builtin_amdgcn_permlane32_swap(a1, b1, false, false); \
    u32x4 w = {r0[0], r1[0], r0[1], r1[1]}; OUT = *reinterpret_cast<bf16x8*>(&w); } while (0)
    PK4(p0, 0, pa0); PK4(p0, 8, pa1); PK4(p1, 0, pa2); PK4(p1, 8, pa3);
#undef PK4
}
__device__ __forceinline__ int v_st(int k, int c) { const int kk = (k & ~0xC) | ((k & 4) << 1) | ((k & 8) >> 1); return ((kk >> 3) * 4 + (c >> 5)) * 512 + ((kk & 7) * 32 + (c & 31)) * 2; }
__device__ __forceinline__ int v_rd_base(int lane) { return ((lane & 3) << 3) | (((lane >> 2) & 3) << 6) | (((lane >> 4) & 1) << 5) | (((lane >> 5) & 1) << 8); }
constexpr int v_rd_off(int d0, int ks, int half) { return d0 * 512 + ks * 4096 + half * 2048; }
template <int OFF> __device__ __forceinline__ s16x4 tr_read(unsigned vb) {
    s16x4 r; asm volatile("ds_read_b64_tr_b16 %0, %1 offset:%2" : "=&v"(r) : "v"(vb), "i"(OFF) : "memory"); return r;
}
template <int D0> __device__ __forceinline__ void pv_one(f32x16& od, unsigned vb, bf16x8 pa0, bf16x8 pa1, bf16x8 pa2, bf16x8 pa3) {
    const s16x4 l0 = tr_read<v_rd_off(D0, 0, 0)>(vb), h0 = tr_read<v_rd_off(D0, 0, 1)>(vb), l1 = tr_read<v_rd_off(D0, 1, 0)>(vb), h1 = tr_read<v_rd_off(D0, 1, 1)>(vb);
    const s16x4 l2 = tr_read<v_rd_off(D0, 2, 0)>(vb), h2 = tr_read<v_rd_off(D0, 2, 1)>(vb), l3 = tr_read<v_rd_off(D0, 3, 0)>(vb), h3 = tr_read<v_rd_off(D0, 3, 1)>(vb);
    asm volatile("s_waitcnt lgkmcnt(0)" ::: "memory"); SBAR();
#define PKV(L, H) (bf16x8){L[0], L[1], L[2], L[3], H[0], H[1], H[2], H[3]}
    od = __builtin_amdgcn_mfma_f32_32x32x16_bf16(pa0, PKV(l0, h0), od, 0, 0, 0);
    od = __builtin_amdgcn_mfma_f32_32x32x16_bf16(pa1, PKV(l1, h1), od, 0, 0, 0);
    od = __builtin_amdgcn_mfma_f32_32x32x16_bf16(pa2, PKV(l2, h2), od, 0, 0, 0);
    od = __builtin_amdgcn_mfma_f32_32x32x16_bf16(pa3, PKV(l3, h3), od, 0, 0, 0);
#undef PKV
}

__device__ __forceinline__ void partialSM2(f32x16& p0, f32x16& p1, float& m_reg, float& alpha, const float C, const float thr_raw) {
    float pmax = p0[0];
#pragma unroll
    for (int r = 1; r < 16; ++r) pmax = fmaxf(pmax, p0[r]);
#pragma unroll
    for (int r = 0; r < 16; ++r) pmax = fmaxf(pmax, p1[r]);
    { auto rr = __builtin_amdgcn_permlane32_swap(__float_as_uint(pmax), __float_as_uint(pmax), false, false);
      pmax = fmaxf(__uint_as_float(rr[0]), __uint_as_float(rr[1])); }
    float mn;
    if (__builtin_expect(__all(pmax - m_reg <= thr_raw), 1)) { mn = m_reg; alpha = 1.f; }
    else { mn = fmaxf(m_reg, pmax); alpha = __builtin_amdgcn_exp2f((m_reg - mn) * C); m_reg = mn; }
    const float mnC = -mn * C;
    typedef float f32x2 __attribute__((ext_vector_type(2)));
    const f32x2 C2 = {C, C}, M2 = {mnC, mnC};
#pragma unroll
    for (int r = 0; r < 16; r += 2) { f32x2 t = {p0[r], p0[r + 1]}; t = __builtin_elementwise_fma(t, C2, M2); p0[r] = t.x; p0[r + 1] = t.y; }
#pragma unroll
    for (int r = 0; r < 16; r += 2) { f32x2 t = {p1[r], p1[r + 1]}; t = __builtin_elementwise_fma(t, C2, M2); p1[r] = t.x; p1[r + 1] = t.y; }
#pragma unroll
    for (int r = 0; r < 16; ++r) p0[r] = __builtin_amdgcn_exp2f(p0[r]);
}
__device__ __forceinline__ void finishSM2(f32x16& p0, f32x16& p1, float alpha, float& l_reg, bf16x8& pa0, bf16x8& pa1, bf16x8& pa2, bf16x8& pa3) {
#pragma unroll
    for (int r = 0; r < 16; ++r) p1[r] = __builtin_amdgcn_exp2f(p1[r]);
    typedef float f32x2 __attribute__((ext_vector_type(2)));
    f32x2 s2 = {0.f, 0.f};
#pragma unroll
    for (int r = 0; r < 16; r += 2) { const f32x2 t = {p0[r], p0[r + 1]}; s2 += t; }
#pragma unroll
    for (int r = 0; r < 16; r += 2) { const f32x2 t = {p1[r], p1[r + 1]}; s2 += t; }
    float ps = s2.x + s2.y;
    { auto rr = __builtin_amdgcn_permlane32_swap(__float_as_uint(ps), __float_as_uint(ps), false, false);
      ps = __uint_as_float(rr[0]) + __uint_as_float(rr[1]); }
    l_reg = l_reg * alpha + ps;
#define PK4(P, BASE, OUT) do { unsigned a0 = cvt_pk(P[BASE + 0], P[BASE + 1]), a1 = cvt_pk(P[BASE + 2], P[BASE + 3]);   \
    unsigned b0 = cvt_pk(P[BASE + 4], P[BASE + 5]), b1 = cvt_pk(P[BASE + 6], P[BASE + 7]);                              \
    auto r0 = __builtin_amdgcn_permlane32_swap(a0, b0, false, false); auto r1 = __builtin_amdgcn_permlane32_swap(a1, b1, false, false); \
    u32x4 w = {r0[0], r1[0], r0[1], r1[1]}; OUT = *reinterpret_cast<bf16x8*>(&w); } while (0)
    PK4(p0, 0, pa0); PK4(p0, 8, pa1); PK4(p1, 0, pa2); PK4(p1, 8, pa3);
#undef PK4
}
template <int DQK>
__device__ __forceinline__ void attn_unit(const bf16_t* __restrict__ Qp, int ldq, const bf16_t* __restrict__ Kp, int ldk, const bf16_t* __restrict__ Kr,
                                          const bf16_t* __restrict__ Vp, int ldv, const int NT, const int nkw, LAS unsigned char* lds, f32x16 (&o)[4], float scale) {
    constexpr int ND = DQK / 16, KCH = DQK / 64, KRB = DQK * 2, KTB = 64 * KRB, CPR = DQK / 8;
    int tid = threadIdx.x; asm volatile("" : "+v"(tid));
    const int wid = tid >> 6, lane = tid & 63, r32 = lane & 31, hi = lane >> 5;
    LAS unsigned char* Vl = lds; LAS unsigned char* Kl = lds + 32768; LAS float* wsc = (LAS float*)(lds + 32768 + 49152) + wid * 64;
    const float C = scale * 1.4426950408889634f, thr_raw = 8.0f / scale;
    bf16x8 qr[ND];
    {
        const bf16_t* qw = Qp + (size_t)(wid * 32 + r32) * ldq + hi * 8;
#pragma unroll
        for (int d0 = 0; d0 < ND; ++d0) qr[d0] = *(const GAS bf16x8*)(qw + d0 * 16);
    }
    const bf16_t* kp[KCH]; unsigned kl[KCH]; int kst[KCH];
#pragma unroll
    for (int i = 0; i < KCH; ++i) {
        const int q = tid + i * 512, row = q / CPR, cc = q % CPR;
        if (DQK == 192 && cc >= 16) { kp[i] = Kr + (size_t)row * 64 + (cc - 16) * 8; kst[i] = 64 * 64; }
        else { kp[i] = Kp + (size_t)row * ldk + cc * 8; kst[i] = 64 * ldk; }
        kl[i] = (unsigned)(row * KRB + ((cc ^ ((row >> 1) & 7)) << 4));
    }
    const int sr = tid >> 4, sc = (tid & 15) * 8;
    const bf16_t* vp0 = Vp + (size_t)sr * ldv + sc; const bf16_t* vp1 = vp0 + (size_t)32 * ldv; const int vstp = 64 * ldv;
    const int vs0 = v_st(sr, sc), vs1 = v_st(32 + sr, sc);
    const unsigned vbase = (unsigned)(uintptr_t)Vl + (unsigned)v_rd_base(lane);
    const unsigned sw = (unsigned)((r32 >> 1) & 7);
    u32x4 kreg[KCH], vreg0, vreg1;
#define A_SLOAD() do { _Pragma("unroll") for (int i = 0; i < KCH; ++i) { kreg[i] = *(const GAS u32x4*)kp[i]; kp[i] += kst[i]; } \
        vreg0 = *(const GAS u32x4*)vp0; vreg1 = *(const GAS u32x4*)vp1; vp0 += vstp; vp1 += vstp; } while (0)
#define A_SWRITE(b) do { LAS unsigned char* Kn_ = Kl + (b) * KTB; LAS unsigned char* Vn_ = Vl + (b) * 16384; \
        _Pragma("unroll") for (int i = 0; i < KCH; ++i) *(LAS u32x4*)(Kn_ + kl[i]) = kreg[i]; \
        *(LAS u32x4*)(Vn_ + vs0) = vreg0; *(LAS u32x4*)(Vn_ + vs1) = vreg1; } while (0)
#define A_QKT(P0, P1, b) do { LAS unsigned char* Kc_ = Kl + (b) * KTB; \
        _Pragma("unroll") for (int r = 0; r < 16; ++r) { P0[r] = 0.f; P1[r] = 0.f; } \
        _Pragma("unroll") for (int d0 = 0; d0 < ND; ++d0) { const unsigned off_ = (unsigned)(r32 * KRB) + ((((unsigned)(d0 * 2 + hi)) ^ sw) << 4); \
            const bf16x8 b0_ = *(const LAS bf16x8*)(Kc_ + off_); const bf16x8 b1_ = *(const LAS bf16x8*)(Kc_ + off_ + 32 * KRB); \
            P0 = __builtin_amdgcn_mfma_f32_32x32x16_bf16(b0_, qr[d0], P0, 0, 0, 0); P1 = __builtin_amdgcn_mfma_f32_32x32x16_bf16(b1_, qr[d0], P1, 0, 0, 0); } } while (0)
#define A_MASK(P0, P1, j) do { if (((j) + 1) * 64 > nkw) { asm volatile("" ::: "memory"); _Pragma("unroll") for (int r = 0; r < 16; ++r) { const int kb_ = (j) * 64 + crow(r, hi); \
        if (kb_ >= nkw) P0[r] = -1e30f; if (kb_ + 32 >= nkw) P1[r] = -1e30f; } } } while (0)
#define A_RESC(al) do { if (__any((al) < 1.f)) { if (hi == 0) wsc[r32] = (al); asm volatile("s_waitcnt lgkmcnt(0)" ::: "memory"); \
        _Pragma("unroll") for (int r = 0; r < 16; ++r) { const float al_ = wsc[crow(r, hi)]; _Pragma("unroll") for (int d = 0; d < 4; ++d) o[d][r] *= al_; } } } while (0)
#define A_PV(b) do { const unsigned vb_ = vbase + (unsigned)((b) * 16384); \
        pv_one<0>(o[0], vb_, pa0, pa1, pa2, pa3); pv_one<1>(o[1], vb_, pa0, pa1, pa2, pa3); pv_one<2>(o[2], vb_, pa0, pa1, pa2, pa3); pv_one<3>(o[3], vb_, pa0, pa1, pa2, pa3); } while (0)
    float m_reg = -1e30f, l_reg = 0.f;
#pragma unroll
    for (int d = 0; d < 4; ++d)
#pragma unroll
        for (int r = 0; r < 16; ++r) o[d][r] = 0.f;
    f32x16 pA0, pA1, pB0, pB1; float alA, alB; bf16x8 pa0, pa1, pa2, pa3;
    A_SLOAD(); A_SWRITE(0); __syncthreads();
    A_QKT(pA0, pA1, 0); A_MASK(pA0, pA1, 0); partialSM2(pA0, pA1, m_reg, alA, C, thr_raw);
    A_SLOAD(); A_SWRITE(1); __syncthreads();
#pragma unroll 1
    for (int j = 1; j + 1 < NT; j += 2) {
        SBAR(); A_QKT(pB0, pB1, 1);
        finishSM2(pA0, pA1, alA, l_reg, pa0, pa1, pa2, pa3); SBAR();
        A_SLOAD(); SBAR();
        A_PV(0); A_MASK(pB0, pB1, j); partialSM2(pB0, pB1, m_reg, alB, C, thr_raw);
        __syncthreads(); A_SWRITE(0);
        A_RESC(alB); __syncthreads();
        SBAR(); A_QKT(pA0, pA1, 0);
        finishSM2(pB0, pB1, alB, l_reg, pa0, pa1, pa2, pa3); SBAR();
        A_SLOAD(); SBAR();
        A_PV(1); A_MASK(pA0, pA1, j + 1); partialSM2(pA0, pA1, m_reg, alA, C, thr_raw);
        __syncthreads(); A_SWRITE(1);
        A_RESC(alA); __syncthreads();
    }
    SBAR(); A_QKT(pB0, pB1, 1);
    finishSM2(pA0, pA1, alA, l_reg, pa0, pa1, pa2, pa3); SBAR();
    A_PV(0); A_MASK(pB0, pB1, NT - 1); partialSM2(pB0, pB1, m_reg, alB, C, thr_raw);
    A_RESC(alB);
    finishSM2(pB0, pB1, alB, l_reg, pa0, pa1, pa2, pa3); SBAR();
    A_PV(1);
    __syncthreads();
    {
        if (hi == 0) wsc[32 + r32] = l_reg;
        asm volatile("s_waitcnt lgkmcnt(0)" ::: "memory");
#pragma unroll
        for (int r = 0; r < 16; ++r) { const float rl = __builtin_amdgcn_rcpf(wsc[32 + crow(r, hi)]);
#pragma unroll
            for (int d = 0; d < 4; ++d) o[d][r] *= rl; }
    }
#undef A_SLOAD
#undef A_SWRITE
#undef A_QKT
#undef A_MASK
#undef A_RESC
#undef A_PV
}

template <int DQK>
__device__ __forceinline__ void attn_unit_np(const bf16_t* __restrict__ Qp, int ldq, const bf16_t* __restrict__ Kp, int ldk, const bf16_t* __restrict__ Kr,
                                          const bf16_t* __restrict__ Vp, int ldv, int NT, int lim, int nkeys, LAS unsigned char* lds, f32x16 (&o)[4], float scale) {
    constexpr int ND = DQK / 16, KCH = DQK / 64, KRB = DQK * 2, KTB = 64 * KRB, CPR = DQK / 8;
    int tid = threadIdx.x; asm volatile("" : "+v"(tid));
    const int wid = tid >> 6, lane = tid & 63, r32 = lane & 31, hi = lane >> 5;
    LAS unsigned char* Vl = lds; LAS unsigned char* Kl = lds + 32768; LAS float* wsc = (LAS float*)(lds + 32768 + 49152) + wid * 64;
    const float C = scale * 1.4426950408889634f, thr_raw = 8.0f / scale;
    bf16x8 qr[ND];
    if (lim >= 0) {
        const bf16_t* qw = Qp + (size_t)(wid * 32 + r32) * ldq + hi * 8;
#pragma unroll
        for (int d0 = 0; d0 < ND; ++d0) qr[d0] = *(const GAS bf16x8*)(qw + d0 * 16);
    } else {
#pragma unroll
        for (int d0 = 0; d0 < ND; ++d0) qr[d0] = (bf16x8){0, 0, 0, 0, 0, 0, 0, 0};
    }
    const bf16_t* kp[KCH]; unsigned kl[KCH]; int kst[KCH];
#pragma unroll
    for (int i = 0; i < KCH; ++i) {
        const int q = tid + i * 512, row = q / CPR, cc = q % CPR;
        if (DQK == 192 && cc >= 16) { kp[i] = Kr + (size_t)row * 64 + (cc - 16) * 8; kst[i] = 64 * 64; }
        else { kp[i] = Kp + (size_t)row * ldk + cc * 8; kst[i] = 64 * ldk; }
        kl[i] = (unsigned)(row * KRB + ((cc ^ ((row >> 1) & 7)) << 4));
    }
    const int sr = tid >> 4, sc = (tid & 15) * 8;
    const bf16_t* vp0 = Vp + (size_t)sr * ldv + sc; const bf16_t* vp1 = vp0 + (size_t)32 * ldv; const int vstp = 64 * ldv;
    const int vs0 = v_st(sr, sc), vs1 = v_st(32 + sr, sc);
    const unsigned vbase = (unsigned)(uintptr_t)Vl + (unsigned)v_rd_base(lane);
    u32x4 kreg[KCH], vreg0, vreg1;
#pragma unroll
    for (int i = 0; i < KCH; ++i) { kreg[i] = *(const GAS u32x4*)kp[i]; kp[i] += kst[i]; }
    vreg0 = *(const GAS u32x4*)vp0; vreg1 = *(const GAS u32x4*)vp1; vp0 += vstp; vp1 += vstp;
#pragma unroll
    for (int i = 0; i < KCH; ++i) *(LAS u32x4*)(Kl + kl[i]) = kreg[i];
    *(LAS u32x4*)(Vl + vs0) = vreg0; *(LAS u32x4*)(Vl + vs1) = vreg1;
    __syncthreads();
    float m_reg = -1e30f, l_reg = 0.f;
#pragma unroll
    for (int d = 0; d < 4; ++d)
#pragma unroll
        for (int r = 0; r < 16; ++r) o[d][r] = 0.f;
    const unsigned sw = (unsigned)((r32 >> 1) & 7);
    for (int j = 0; j < NT; ++j) {
        const int cur = j & 1;
        const bool more = (j + 1 < NT);
        if (more) {
#pragma unroll
            for (int i = 0; i < KCH; ++i) { kreg[i] = *(const GAS u32x4*)kp[i]; kp[i] += kst[i]; }
            vreg0 = *(const GAS u32x4*)vp0; vreg1 = *(const GAS u32x4*)vp1; vp0 += vstp; vp1 += vstp;
        }
        if (j <= lim) {
            f32x16 p0, p1;
#pragma unroll
            for (int r = 0; r < 16; ++r) { p0[r] = 0.f; p1[r] = 0.f; }
            LAS unsigned char* Kc = Kl + cur * KTB;
#define NP_KOFF(d0) ((unsigned)(r32 * KRB) + ((((unsigned)((d0) * 2 + hi)) ^ sw) << 4))
            bf16x8 kb0[3], kb1[3];
            kb0[0] = *(const LAS bf16x8*)(Kc + NP_KOFF(0)); kb1[0] = *(const LAS bf16x8*)(Kc + NP_KOFF(0) + 32 * KRB);
            if (ND > 1) { kb0[1] = *(const LAS bf16x8*)(Kc + NP_KOFF(1)); kb1[1] = *(const LAS bf16x8*)(Kc + NP_KOFF(1) + 32 * KRB); }
#pragma unroll
            for (int d0 = 0; d0 < ND; ++d0) {
                if (d0 + 2 < ND) { kb0[(d0 + 2) % 3] = *(const LAS bf16x8*)(Kc + NP_KOFF(d0 + 2)); kb1[(d0 + 2) % 3] = *(const LAS bf16x8*)(Kc + NP_KOFF(d0 + 2) + 32 * KRB); }
                SBAR();
                p0 = __builtin_amdgcn_mfma_f32_32x32x16_bf16(kb0[d0 % 3], qr[d0], p0, 0, 0, 0);
                p1 = __builtin_amdgcn_mfma_f32_32x32x16_bf16(kb1[d0 % 3], qr[d0], p1, 0, 0, 0);
                SBAR();
            }
#undef NP_KOFF
            if (j == NT - 1 && nkeys < NT * 64) {
#pragma unroll
                for (int r = 0; r < 16; ++r) { const int kb = j * 64 + crow(r, hi); if (kb >= nkeys) p0[r] = -1e30f; if (kb + 32 >= nkeys) p1[r] = -1e30f; }
            }
            float mn, alpha; bf16x8 pa0, pa1, pa2, pa3;
            partialSM(p0, p1, m_reg, mn, alpha, C, thr_raw);
            finishSM(p0, p1, alpha, l_reg, pa0, pa1, pa2, pa3);
            if (__any(alpha < 1.f)) {
                if (hi == 0) wsc[r32] = alpha;
                asm volatile("s_waitcnt lgkmcnt(0)" ::: "memory");
#pragma unroll
                for (int r = 0; r < 16; ++r) { const float al = wsc[crow(r, hi)];
#pragma unroll
                    for (int d = 0; d < 4; ++d) o[d][r] *= al; }
            }
            const unsigned vb = vbase + (unsigned)(cur * 16384);
            pv_one<0>(o[0], vb, pa0, pa1, pa2, pa3); pv_one<1>(o[1], vb, pa0, pa1, pa2, pa3); pv_one<2>(o[2], vb, pa0, pa1, pa2, pa3); pv_one<3>(o[3], vb, pa0, pa1, pa2, pa3);
        }
        if (more) {
            LAS unsigned char* Kn = Kl + (cur ^ 1) * KTB; LAS unsigned char* Vn = Vl + (cur ^ 1) * 16384;
#pragma unroll
            for (int i = 0; i < KCH; ++i) *(LAS u32x4*)(Kn + kl[i]) = kreg[i];
            *(LAS u32x4*)(Vn + vs0) = vreg0; *(LAS u32x4*)(Vn + vs1) = vreg1;
        }
        __syncthreads();
    }
    if (lim >= 0) {
        if (hi == 0) wsc[32 + r32] = l_reg;
        asm volatile("s_waitcnt lgkmcnt(0)" ::: "memory");
#pragma unroll
        for (int r = 0; r < 16; ++r) { const float rl = __builtin_amdgcn_rcpf(wsc[32 + crow(r, hi)]);
#pragma unroll
            for (int d = 0; d < 4; ++d) o[d][r] *= rl; }
    }
}


template <int D0, int SUB> __device__ __forceinline__ void pv_one128(f32x16& od, unsigned vb, bf16x8 pa0, bf16x8 pa1, bf16x8 pa2, bf16x8 pa3) {
    constexpr int B = SUB * 16384;
    const s16x4 l0 = tr_read<B + v_rd_off(D0, 0, 0)>(vb), h0 = tr_read<B + v_rd_off(D0, 0, 1)>(vb), l1 = tr_read<B + v_rd_off(D0, 1, 0)>(vb), h1 = tr_read<B + v_rd_off(D0, 1, 1)>(vb);
    const s16x4 l2 = tr_read<B + v_rd_off(D0, 2, 0)>(vb), h2 = tr_read<B + v_rd_off(D0, 2, 1)>(vb), l3 = tr_read<B + v_rd_off(D0, 3, 0)>(vb), h3 = tr_read<B + v_rd_off(D0, 3, 1)>(vb);
    asm volatile("s_waitcnt lgkmcnt(0)" ::: "memory"); SBAR();
#define PKV(L, H) (bf16x8){L[0], L[1], L[2], L[3], H[0], H[1], H[2], H[3]}
    od = __builtin_amdgcn_mfma_f32_32x32x16_bf16(pa0, PKV(l0, h0), od, 0, 0, 0);
    od = __builtin_amdgcn_mfma_f32_32x32x16_bf16(pa1, PKV(l1, h1), od, 0, 0, 0);
    od = __builtin_amdgcn_mfma_f32_32x32x16_bf16(pa2, PKV(l2, h2), od, 0, 0, 0);
    od = __builtin_amdgcn_mfma_f32_32x32x16_bf16(pa3, PKV(l3, h3), od, 0, 0, 0);
#undef PKV
}
__device__ __forceinline__ void attn_unit_k128(const bf16_t* __restrict__ Qp, int ldq, const bf16_t* __restrict__ Kp, int ldk, const bf16_t* __restrict__ Vp, int ldv,
                                               const int NT, const int nkw, LAS unsigned char* lds, f32x16 (&o)[4], float scale) {
    constexpr int ND = 4, KRB = 128, KTB = 128 * KRB, VTB = 32768;
    int tid = threadIdx.x; asm volatile("" : "+v"(tid));
    const int wid = tid >> 6, lane = tid & 63, r32 = lane & 31, hi = lane >> 5;
    LAS unsigned char* Vl = lds; LAS unsigned char* Kl = lds + 2 * VTB; LAS float* wsc = (LAS float*)(lds + 2 * VTB + 2 * KTB) + wid * 64;
    const float C = scale * 1.4426950408889634f, thr_raw = 8.0f / scale;
    bf16x8 qr[ND];
    if (nkw > 0) {
        const bf16_t* qw = Qp + (size_t)(wid * 32 + r32) * ldq + hi * 8;
#pragma unroll
        for (int d0 = 0; d0 < ND; ++d0) qr[d0] = *(const GAS bf16x8*)(qw + d0 * 16);
    } else {
#pragma unroll
        for (int d0 = 0; d0 < ND; ++d0) qr[d0] = (bf16x8){0, 0, 0, 0, 0, 0, 0, 0};
    }
    const bf16_t* kp0; unsigned kl0;
    { const int row = tid >> 3, cc = tid & 7; kp0 = Kp + (size_t)row * ldk + cc * 8; kl0 = (unsigned)(row * KRB + ((cc ^ ((row >> 1) & 7)) << 4)); }
    const int sr = tid >> 4, sc = (tid & 15) * 8;
    const bf16_t* vp0 = Vp + (size_t)sr * ldv + sc; const unsigned vs0 = (unsigned)v_st(sr, sc);
    const long k64 = 64L * ldk, v32 = 32L * ldv;
    const int kstp = 128 * ldk, vstp = 128 * ldv;
#define K128_LOAD() do { kreg[0] = *(const GAS u32x4*)kp0; kreg[1] = *(const GAS u32x4*)(kp0 + k64); kp0 += kstp; \
        vreg[0] = *(const GAS u32x4*)vp0; vreg[1] = *(const GAS u32x4*)(vp0 + v32); vreg[2] = *(const GAS u32x4*)(vp0 + 2 * v32); vreg[3] = *(const GAS u32x4*)(vp0 + 3 * v32); vp0 += vstp; } while (0)
#define K128_WRITE(Kb_, Vb_) do { *(LAS u32x4*)((Kb_) + kl0) = kreg[0]; *(LAS u32x4*)((Kb_) + kl0 + 8192) = kreg[1]; \
        *(LAS u32x4*)((Vb_) + vs0) = vreg[0]; *(LAS u32x4*)((Vb_) + vs0 + 8192) = vreg[1]; *(LAS u32x4*)((Vb_) + vs0 + 16384) = vreg[2]; *(LAS u32x4*)((Vb_) + vs0 + 24576) = vreg[3]; } while (0)
    const unsigned vbase = (unsigned)(uintptr_t)Vl + (unsigned)v_rd_base(lane);
    const unsigned sw = (unsigned)((r32 >> 1) & 7);
    u32x4 kreg[2], vreg[4];
    K128_LOAD(); K128_WRITE(Kl, Vl);
    __syncthreads();
    float m_reg = -1e30f, l_reg = 0.f;
#pragma unroll
    for (int d = 0; d < 4; ++d)
#pragma unroll
        for (int r = 0; r < 16; ++r) o[d][r] = 0.f;
#pragma unroll 1
    for (int j = 0; j < NT; ++j) {
        const int cur = j & 1;
        const bool more = (j + 1 < NT);
        if (more) K128_LOAD();
        if (j * 128 < nkw) {
            f32x16 p[4];
#pragma unroll
            for (int k = 0; k < 4; ++k)
#pragma unroll
                for (int r = 0; r < 16; ++r) p[k][r] = 0.f;
            LAS unsigned char* Kc = Kl + cur * KTB;
#define K128_OFF(d0, k) ((unsigned)((32 * (k) + r32) * KRB) + ((((unsigned)((d0) * 2 + hi)) ^ sw) << 4))
            bf16x8 fa[4], fb[4];
#pragma unroll
            for (int k = 0; k < 4; ++k) fa[k] = *(const LAS bf16x8*)(Kc + K128_OFF(0, k));
#pragma unroll
            for (int k = 0; k < 4; ++k) fb[k] = *(const LAS bf16x8*)(Kc + K128_OFF(1, k));
            SBAR();
#pragma unroll
            for (int k = 0; k < 4; ++k) p[k] = __builtin_amdgcn_mfma_f32_32x32x16_bf16(fa[k], qr[0], p[k], 0, 0, 0);
            SBAR();
#pragma unroll
            for (int k = 0; k < 4; ++k) fa[k] = *(const LAS bf16x8*)(Kc + K128_OFF(2, k));
            SBAR();
#pragma unroll
            for (int k = 0; k < 4; ++k) p[k] = __builtin_amdgcn_mfma_f32_32x32x16_bf16(fb[k], qr[1], p[k], 0, 0, 0);
            SBAR();
#pragma unroll
            for (int k = 0; k < 4; ++k) fb[k] = *(const LAS bf16x8*)(Kc + K128_OFF(3, k));
            SBAR();
#pragma unroll
            for (int k = 0; k < 4; ++k) p[k] = __builtin_amdgcn_mfma_f32_32x32x16_bf16(fa[k], qr[2], p[k], 0, 0, 0);
            SBAR();
#pragma unroll
            for (int k = 0; k < 4; ++k) p[k] = __builtin_amdgcn_mfma_f32_32x32x16_bf16(fb[k], qr[3], p[k], 0, 0, 0);
#undef K128_OFF
            if ((j + 1) * 128 > nkw) {
                asm volatile("" ::: "memory");
#pragma unroll
                for (int k = 0; k < 4; ++k)
#pragma unroll
                    for (int r = 0; r < 16; ++r) { const int kb = j * 128 + 32 * k + crow(r, hi); if (kb >= nkw) p[k][r] = -1e30f; }
            }
            float pmax = p[0][0];
#pragma unroll
            for (int k = 0; k < 4; ++k)
#pragma unroll
                for (int r = 0; r < 16; ++r) pmax = fmaxf(pmax, p[k][r]);
            { auto rr = __builtin_amdgcn_permlane32_swap(__float_as_uint(pmax), __float_as_uint(pmax), false, false);
              pmax = fmaxf(__uint_as_float(rr[0]), __uint_as_float(rr[1])); }
            float mn, alpha;
            if (__builtin_expect(__all(pmax - m_reg <= thr_raw), 1)) { mn = m_reg; alpha = 1.f; }
            else { mn = fmaxf(m_reg, pmax); alpha = __builtin_amdgcn_exp2f((m_reg - mn) * C); m_reg = mn; }
            const float mnC = -mn * C;
            typedef float f32x2 __attribute__((ext_vector_type(2)));
            const f32x2 C2 = {C, C}, M2 = {mnC, mnC};
            f32x2 s2 = {0.f, 0.f};
#pragma unroll
            for (int k = 0; k < 4; ++k)
#pragma unroll
                for (int r = 0; r < 16; r += 2) { f32x2 t = {p[k][r], p[k][r + 1]}; t = __builtin_elementwise_fma(t, C2, M2);
                    t.x = __builtin_amdgcn_exp2f(t.x); t.y = __builtin_amdgcn_exp2f(t.y); p[k][r] = t.x; p[k][r + 1] = t.y; s2 += t; }
            float ps = s2.x + s2.y;
            { auto rr = __builtin_amdgcn_permlane32_swap(__float_as_uint(ps), __float_as_uint(ps), false, false);
              ps = __uint_as_float(rr[0]) + __uint_as_float(rr[1]); }
            l_reg = l_reg * alpha + ps;
            bf16x8 pa[8];
#define PK4(P, BASE, OUT) do { unsigned a0 = cvt_pk(P[BASE + 0], P[BASE + 1]), a1 = cvt_pk(P[BASE + 2], P[BASE + 3]);   \
    unsigned b0 = cvt_pk(P[BASE + 4], P[BASE + 5]), b1 = cvt_pk(P[BASE + 6], P[BASE + 7]);                              \
    auto r0 = __builtin_amdgcn_permlane32_swap(a0, b0, false, false); auto r1 = __builtin_amdgcn_permlane32_swap(a1, b1, false, false); \
    u32x4 w = {r0[0], r1[0], r0[1], r1[1]}; OUT = *reinterpret_cast<bf16x8*>(&w); } while (0)
#pragma unroll
            for (int k = 0; k < 4; ++k) { PK4(p[k], 0, pa[2 * k]); PK4(p[k], 8, pa[2 * k + 1]); }
#undef PK4
            if (__any(alpha < 1.f)) {
                if (hi == 0) wsc[r32] = alpha;
                asm volatile("s_waitcnt lgkmcnt(0)" ::: "memory");
#pragma unroll
                for (int r = 0; r < 16; ++r) { const float al = wsc[crow(r, hi)];
#pragma unroll
                    for (int d = 0; d < 4; ++d) o[d][r] *= al; }
            }
            const unsigned vb = vbase + (unsigned)(cur * VTB);
            pv_one128<0, 0>(o[0], vb, pa[0], pa[1], pa[2], pa[3]); pv_one128<0, 1>(o[0], vb, pa[4], pa[5], pa[6], pa[7]);
            pv_one128<1, 0>(o[1], vb, pa[0], pa[1], pa[2], pa[3]); pv_one128<1, 1>(o[1], vb, pa[4], pa[5], pa[6], pa[7]);
            pv_one128<2, 0>(o[2], vb, pa[0], pa[1], pa[2], pa[3]); pv_one128<2, 1>(o[2], vb, pa[4], pa[5], pa[6], pa[7]);
            pv_one128<3, 0>(o[3], vb, pa[0], pa[1], pa[2], pa[3]); pv_one128<3, 1>(o[3], vb, pa[4], pa[5], pa[6], pa[7]);
        }
        if (more) {
            LAS unsigned char* Kn = Kl + (cur ^ 1) * KTB; LAS unsigned char* Vn = Vl + (cur ^ 1) * VTB;
            K128_WRITE(Kn, Vn);
        }
        __syncthreads();
    }
    if (nkw > 0) {
        if (hi == 0) wsc[32 + r32] = l_reg;
        asm volatile("s_waitcnt lgkmcnt(0)" ::: "memory");
#pragma unroll
        for (int r = 0; r < 16; ++r) { const float rl = __builtin_amdgcn_rcpf(wsc[32 + crow(r, hi)]);
#pragma unroll
            for (int d = 0; d < 4; ++d) o[d][r] *= rl; }
    }
#undef K128_LOAD
#undef K128_WRITE
}

__device__ __forceinline__ void ffn_conv_phase(bf16_t* U, const float* __restrict__ st, const float* __restrict__ cw, const float* __restrict__ cb, long gt_, long NTH_, int dummy) {
        const long ntask = (long)(M / 4) * (FF / 8);
        for (long t = gt_; t < ntask; t += NTH_) {
            const int cch = (int)(t % (FF / 8)), rb = (int)(t / (FF / 8)), r0 = rb * 4, c0 = cch * 8;
            const bool samp = r0 >= MP;
            const int spos = samp ? ((r0 - MP) & 31) : (r0 & (SEQ - 1));
            const int sbb = (r0 - MP) >> 5;
            float gv[6][8];
#pragma unroll
            for (int k = 0; k < 6; ++k) {
                if (k >= 2 || spos != 0) unpack8(*(const GAS u32x4*)(U + (size_t)(r0 - 2 + k) * 5632 + c0), gv[k]);
                else if (samp) { const f32x4 h0 = *(const GAS f32x4*)(st + (size_t)(sbb * 2 + k) * FF + c0), h1 = *(const GAS f32x4*)(st + (size_t)(sbb * 2 + k) * FF + c0 + 4);
                    gv[k][0] = h0[0]; gv[k][1] = h0[1]; gv[k][2] = h0[2]; gv[k][3] = h0[3]; gv[k][4] = h1[0]; gv[k][5] = h1[1]; gv[k][6] = h1[2]; gv[k][7] = h1[3]; }
                else {
#pragma unroll
                    for (int e = 0; e < 8; ++e) gv[k][e] = 0.f; }
            }
            float w0[8], w1[8], w2[8], bb[8];
#pragma unroll
            for (int e = 0; e < 8; ++e) { w0[e] = cw[c0 + e]; w1[e] = cw[FF + c0 + e]; w2[e] = cw[2 * FF + c0 + e]; bb[e] = cb[c0 + e]; }
#pragma unroll
            for (int j = 0; j < 4; ++j) {
                bf16_t* up = U + (size_t)(r0 + j) * 5632 + FF + c0;
                float uv[8]; unpack8(*(const GAS u32x4*)up, uv);
                float ov[8];
#pragma unroll
                for (int e = 0; e < 8; ++e) { const float gs = w0[e] * gv[j][e] + w1[e] * gv[j + 1][e] + w2[e] * gv[j + 2][e] + bb[e];
                    ov[e] = gs / (1.f + __expf(-gs)) * uv[e]; }
                u32x4 w; w.x = cvt_pk(ov[0], ov[1]); w.y = cvt_pk(ov[2], ov[3]); w.z = cvt_pk(ov[4], ov[5]); w.w = cvt_pk(ov[6], ov[7]);
                if (!dummy || ov[0] == 1.2345e-37f) *(GAS u32x4*)up = w;
            }
        }
}

#define XB_TMO      128
#define XB_XCNT(j)  (256  + 64 * (j))
#define XB_XSUB(j)  (1280 + 64 * (j))
#define XB_XGEN(j)  (2304 + 64 * (j))
#define XB_TOP      3328
#define XB_TOPGEN   3392
#define XCD_BAR_WORDS 3456
#define XB_SPIN_CAP (1u << 18)

__device__ __forceinline__ unsigned xb_ld(unsigned* p)              { return __hip_atomic_load(p, __ATOMIC_RELAXED, __HIP_MEMORY_SCOPE_AGENT); }
__device__ __forceinline__ unsigned xb_add(unsigned* p, unsigned v) { return __hip_atomic_fetch_add(p, v, __ATOMIC_RELAXED, __HIP_MEMORY_SCOPE_AGENT); }
__device__ __forceinline__ unsigned xb_xcc_id() { return (unsigned)__builtin_amdgcn_s_getreg((3 << 11) | 20) & 0xFu; }
#define XB_SPIN(cond, bar) do { unsigned _sp = 0; while (cond) { __builtin_amdgcn_s_sleep(1); \
    if ((++_sp & 255u) == 0u) { if (xb_ld(&(bar)[XB_TMO])) break; if (_sp > XB_SPIN_CAP) { atomicAdd(&(bar)[XB_TMO], 1u); break; } } } } while (0)

struct XcdBarrier {
    unsigned* bar; unsigned x;
    volatile LAS unsigned* st;
};

__device__ __forceinline__ XcdBarrier xcd_barrier_post(unsigned* bar, volatile LAS unsigned* st) {
    XcdBarrier b; b.bar = bar; b.x = (unsigned)__builtin_amdgcn_readfirstlane((int)xb_xcc_id()); b.st = st;
    if (threadIdx.x == 0) (void)xb_add(&bar[XB_XCNT(b.x)], 1u);
    return b;
}
__device__ __forceinline__ void xcd_barrier_complete(unsigned* bar, unsigned x, unsigned& nloc, unsigned& nx) {
    const unsigned G = gridDim.x * gridDim.y * gridDim.z;
    unsigned sum, cnt, mine, sp = 0u;
    for (;;) {
        sum = 0u; cnt = 0u; mine = 0u;
#pragma unroll
        for (unsigned j = 0; j < 16; ++j) { const unsigned c = xb_ld(&bar[XB_XCNT(j)]); sum += c; cnt += (c > 0u) ? 1u : 0u; mine = (j == x) ? c : mine; }
        if (sum == G) break;
        __builtin_amdgcn_s_sleep(1);
        if ((++sp & 255u) == 0u) { if (xb_ld(&bar[XB_TMO])) break; if (sp > XB_SPIN_CAP) { atomicAdd(&bar[XB_TMO], 1u); break; } }
    }
    nloc = mine > 0u ? mine : 1u; nx = cnt > 0u ? cnt : 1u;
}

__device__ __forceinline__ void xcd_barrier(const XcdBarrier& b) {
    asm volatile("s_waitcnt vmcnt(0)" ::: "memory");
    __syncthreads();
    if (threadIdx.x == 0) {
        unsigned* bar = b.bar;
        __builtin_amdgcn_s_waitcnt(0);
        unsigned nloc = b.st[0], nx = b.st[1];
        if (nloc == 0u) { xcd_barrier_complete(bar, b.x, nloc, nx); b.st[0] = nloc; b.st[1] = nx; }
        const unsigned old = xb_add(&bar[XB_XSUB(b.x)], 1u);
        const unsigned gen = old / nloc;
        if (old + 1u == (gen + 1u) * nloc) {
            __builtin_amdgcn_fence(__ATOMIC_RELEASE, "agent");
            asm volatile("s_waitcnt vmcnt(0)" ::: "memory");
            const unsigned og = xb_add(&bar[XB_TOP], 1u);
            const unsigned tg = og / nx;
            if (og + 1u == (tg + 1u) * nx) xb_add(&bar[XB_TOPGEN], 1u);
            else XB_SPIN(xb_ld(&bar[XB_TOPGEN]) == tg, bar);
            __builtin_amdgcn_fence(__ATOMIC_ACQUIRE, "agent");
            xb_add(&bar[XB_XGEN(b.x)], 1u);
            asm volatile("s_waitcnt vmcnt(0)" ::: "memory");
        } else {
            XB_SPIN(xb_ld(&bar[XB_XGEN(b.x)]) == gen, bar);
            __builtin_amdgcn_fence(__ATOMIC_ACQUIRE, "agent");
            asm volatile("s_waitcnt vmcnt(0)" ::: "memory");
        }
    }
    __syncthreads();
}


struct Args { const float* in[33]; float* out; unsigned char* ws; };
__device__ __forceinline__ const float* ld_in(const Args& a, int k) { asm volatile("" : "+s"(k)); return a.in[k]; }
#define INP(k) ld_in(a, (k))
struct Ctx {
    unsigned char* ws; float* out; int tid, wid, lane, r32, hi, G, bid; long gt, NTH; int gw, NWV;
    float* ssq; float* rope; bf16_t* wmix; bf16_t* wffn; bf16_t* Xb; unsigned char* big; unsigned char* tail; float* X;
};
__device__ __forceinline__ Ctx mkctx(const Args& a) {
    Ctx c;
    { unsigned long long w = (unsigned long long)(uintptr_t)a.ws, o = (unsigned long long)(uintptr_t)a.out;
      unsigned wl = __builtin_amdgcn_readfirstlane((unsigned)w), wh = __builtin_amdgcn_readfirstlane((unsigned)(w >> 32));
      unsigned ol = __builtin_amdgcn_readfirstlane((unsigned)o), oh = __builtin_amdgcn_readfirstlane((unsigned)(o >> 32));
      asm volatile("" : "+s"(wl), "+s"(wh), "+s"(ol), "+s"(oh));
      c.ws = (unsigned char*)(uintptr_t)(((unsigned long long)wh << 32) | wl); c.out = (float*)(uintptr_t)(((unsigned long long)oh << 32) | ol); }
    int t = threadIdx.x; asm volatile("" : "+v"(t)); c.tid = t; c.wid = t >> 6; c.lane = t & 63; c.r32 = t & 31; c.hi = (t >> 5) & 1;
    int g = gridDim.x, b = blockIdx.x; asm volatile("" : "+s"(g), "+s"(b)); c.G = g; c.bid = b;
    c.gt = (long)b * NTHREADS + t; c.NTH = (long)g * NTHREADS; c.gw = b * 8 + c.wid; c.NWV = g * 8;
    c.ssq = (float*)(c.ws + WS_SSQP); c.rope = (float*)(c.ws + WS_ROPE); c.wmix = (bf16_t*)(c.ws + WS_WMIX); c.wffn = (bf16_t*)(c.ws + WS_WFFN);
    c.Xb = (bf16_t*)(c.ws + WS_XB); c.big = c.ws + WS_BIG; c.tail = c.ws + WS_TAIL; c.X = c.out + O_Y;
    return c;
}

__device__ __forceinline__ float* ssqb(const Ctx& c, int s) { return (float*)((unsigned char*)c.ssq + (size_t)(s & 1) * 3 * MiB); }
constexpr size_t B_WDN1 = 346 * MiB;
static_assert(B_WDN1 + 1024u * 2816 * 2 <= 356 * MiB, "wdn1");
__device__ __forceinline__ bf16_t* wdn_buf(const Ctx& c, int i) { return (i & 1) ? (bf16_t*)(c.big + B_WDN1) : c.wffn + W_DN; }
__device__ __forceinline__ void prep_ffn(const Args& a, const Ctx& c, LAS float* ltile, int i, int rank = -1, int nwork = 0) {
    prep_gu(ltile, INP(28) + (size_t)i * D * FF, INP(29) + (size_t)i * D * FF, c.wffn + W_GU, INP(10) + i * D, rank, nwork);
    prep_w(ltile, INP(32) + (size_t)i * FF * D, D, FF, D, wdn_buf(c, i), D, 0, 0, nullptr, 1, 1.f, nullptr, rank, nwork);
}

__device__ __forceinline__ void prep_mixer_rest(const Args& a, const Ctx& c, LAS float* ltile) {
    prep_w(ltile, INP(15), 1024, 1024, 1024, c.wmix + W_OA, 1024, 0, 0, INP(14), 128, 0.8f, nullptr);
    prep_w(ltile, INP(16), 704, 1024, 704, c.wmix + W_DB, 768, 0, 0, INP(9) + D, D, 1.f, nullptr);
    prep_w(ltile, INP(18), 1536, 384, 1536, c.wmix + W_UQ, 1536, 3, 0, nullptr, 1, 1.f, nullptr);
    prep_w(ltile, INP(20), 1024, 256, 1024, c.wmix + W_UKV, 1024, 0, 0, nullptr, 1, 1.f, nullptr);
    prep_w(ltile, INP(21), 1024, 256, 1024, c.wmix + W_UKV + 1024u * 256, 1024, 0, 0, nullptr, 1, 1.f, nullptr);
    prep_w(ltile, INP(22), 1024, 1024, 1024, c.wmix + W_OB, 1024, 0, 0, nullptr, 1, 1.f, nullptr);
    prep_w(ltile, INP(23), 3072, 1024, 3072, c.wmix + W_CIN, 3072, 0, 0, INP(9) + 2 * D, D, 1.f, nullptr);
    prep_w(ltile, INP(25), 1024, 1024, 1024, c.wmix + W_COUT, 1024, 0, 0, nullptr, 1, 1.f, nullptr);
#pragma unroll 1
    for (int g4 = 0; g4 < 4; ++g4)
        prep_w(ltile, INP(26) + (size_t)g4 * 65536, 256, 256, 256, c.wmix + W_DG + (size_t)g4 * 65536, 256, 0, 0, nullptr, 1, 1.f, INP(27) + g4 * 256);
}
__device__ __forceinline__ void ph_prologue(const Args& a, LAS unsigned char* lds) {
    const Ctx c = mkctx(a); LAS float* ltile = (LAS float*)lds;
    prep_w(ltile, INP(12), 3072, 1024, 3072, c.wmix + W_QKV, 3072, 1, 32, INP(9), D, 1.f, nullptr);
    for (long i = c.gt; i < 16384L * 32; i += c.NTH) {
        const int pos = (int)(i >> 5), k = (int)(i & 31);
        double inv = 1.0; for (int q = 0; q < k; ++q) inv *= 0.7498942093324559;
        const float invf = (float)inv;
        const double rev = (double)pos * (double)invf * 0.15915494309189535;
        const float fr = (float)(rev - floor(rev));
        c.rope[(size_t)pos * 64 + k] = __builtin_amdgcn_cosf(fr); c.rope[(size_t)pos * 64 + 32 + k] = __builtin_amdgcn_sinf(fr);
    }
    {
        const float* xp = INP(0); const float* xs = INP(1);
        for (int r = c.gw; r < M; r += c.NWV) {
            const float* src = r < MP ? xp + (size_t)r * D : xs + (size_t)(r - MP) * D;
            float ss = 0.f;
#pragma unroll
            for (int j = 0; j < 4; ++j) { const f32x4 v = *(const GAS f32x4*)(src + j * 256 + c.lane * 4); ss += v[0] * v[0] + v[1] * v[1] + v[2] * v[2] + v[3] * v[3];
                *(GAS u32x2*)(c.Xb + (size_t)r * D + j * 256 + c.lane * 4) = pack4(v); }
            ss = wave_sum(ss);
            if (c.lane < 16) ssqb(c, 0)[(size_t)r * 16 + c.lane] = c.lane == 0 ? ss : 0.f;
        }
    }
    {
        const float* ck = INP(2); const float* cv = INP(3);
        bf16_t* Ks = (bf16_t*)(c.tail + T_K); bf16_t* Vs = (bf16_t*)(c.tail + T_V);
        for (long i = c.gt; i < (long)SBN * PAST * D / 8; i += c.NTH) {
            const long e = i * 8; const int sbb = (int)(e / ((long)PAST * D)); const long rem = e % ((long)PAST * D);
            const size_t dst = (size_t)sbb * NKSP * D + rem;
            *(GAS u32x4*)(Ks + dst) = pack8(*(const GAS f32x4*)(ck + e), *(const GAS f32x4*)(ck + e + 4));
            *(GAS u32x4*)(Vs + dst) = pack8(*(const GAS f32x4*)(cv + e), *(const GAS f32x4*)(cv + e + 4));
        }
        for (long i = c.gt; i < (long)SBN * (NKSP - NKS) * D / 8; i += c.NTH) {
            const long e = i * 8; const int sbb = (int)(e / ((long)(NKSP - NKS) * D)); const long rem = e % ((long)(NKSP - NKS) * D);
            const size_t dst = ((size_t)sbb * NKSP + NKS) * D + rem;
            *(GAS u32x4*)(Ks + dst) = (u32x4){0, 0, 0, 0}; *(GAS u32x4*)(Vs + dst) = (u32x4){0, 0, 0, 0};
        }
    }
}

__device__ __forceinline__ void ph_l0_qkv(const Args& a, LAS unsigned char* lds) {
    const Ctx c = mkctx(a);
    bf16_t* Q = (bf16_t*)(c.big + B0_Q); bf16_t* Kb = (bf16_t*)(c.big + B0_K); bf16_t* Vb = (bf16_t*)(c.big + B0_V);
    bf16_t* Ks = (bf16_t*)(c.tail + T_K); bf16_t* Vs = (bf16_t*)(c.tail + T_V);
    pg8::Gemm g{c.Xb, c.wmix + W_QKV, M, 3072, 1024, 1024, 0}; pg8::StaticOrder S; S.init(M, 3072, c.G, c.bid);
    EpiQKV E{ssqb(c, 0), c.rope, Q, Kb, Vb, Ks, Vs, c.out + O_AKP, c.out + O_AVP, c.out + O_AKS, c.out + O_AVS};
    pg8::gemm_phase(lds, g, S, E);
    prep_mixer_rest(a, c, (LAS float*)lds);
}
struct AUnit { int b, h, qb, sbb; bool samp; };
__device__ __forceinline__ AUnit attn_unit_of(int G, int bid, int ui) {
    AUnit u; u.samp = false; u.sbb = 0; u.b = 0; u.qb = 0; u.h = 0;
    if (G == 256) {
        if (ui < 4) { const int combo = (bid & 7) * 2 + (ui >> 1); u.b = combo >> 3; u.h = combo & 7; u.qb = (ui & 1) ? (bid >> 3) : 63 - (bid >> 3); }
        else { u.samp = true; u.sbb = bid >> 3; u.h = bid & 7; }
    } else {
        const int id = bid + ui * G;
        if (id < 1024) { u.b = id >> 9; u.h = (id >> 6) & 7; u.qb = id & 63; } else { u.samp = true; u.sbb = (id - 1024) >> 3; u.h = (id - 1024) & 7; }
    }
    return u;
}
__device__ __forceinline__ int attn_ucount(int G, int bid) { return (G == 256) ? 4 + (bid < 64 ? 1 : 0) : (1024 + 64 - bid + G - 1) / G; }

__device__ __forceinline__ void ph_l0_attn(const Args& a, LAS unsigned char* lds, int dummy) {
    const Ctx c = mkctx(a);
    bf16_t* Q = (bf16_t*)(c.big + B0_Q); bf16_t* Kb = (bf16_t*)(c.big + B0_K); bf16_t* Vb = (bf16_t*)(c.big + B0_V); GAS float* OS = (GAS float*)(c.big + B0_OS);
    GAS bf16_t* Qg = (GAS bf16_t*)Q;
    bf16_t* Ks = (bf16_t*)(c.tail + T_K); bf16_t* Vs = (bf16_t*)(c.tail + T_V);
    float lam;
    { const float* al = INP(13); const float pa = al[c.lane] * al[64 + c.lane], pb = al[128 + c.lane] * al[192 + c.lane];
      lam = __expf(wave_sum(pa)) - __expf(wave_sum(pb)) + 0.2f; }
    const int ucount = attn_ucount(c.G, c.bid);
    if (__builtin_amdgcn_readfirstlane(c.tid) >= 256) __builtin_amdgcn_s_setprio(1);
#pragma unroll 1
    for (int ui = 0; ui < ucount; ++ui) {
        const AUnit u = attn_unit_of(c.G, c.bid, ui);
        const int row0 = u.samp ? MP + u.sbb * 32 : u.b * SEQ + u.qb * 256;
        const int NT = u.samp ? 9 : 2 * u.qb + 2;
        const int nkw = __builtin_amdgcn_readfirstlane(u.samp ? (c.wid == 0 ? NKS : 0) : (4 * u.qb + (c.wid >> 1) + 1) * 64);
        const bool act = nkw > 0;
#pragma unroll 1
        for (int cc = 0; cc < 2; ++cc) {
            const bf16_t* Kp = u.samp ? Ks + (size_t)u.sbb * NKSP * D + u.h * 128 + cc * 64 : Kb + (size_t)u.b * SEQ * D + u.h * 128 + cc * 64;
            const bf16_t* Vp = u.samp ? Vs + (size_t)u.sbb * NKSP * D + u.h * 128 : Vb + (size_t)u.b * SEQ * D + u.h * 128;
            f32x16 o[4];
            attn_unit_k128(Q + (size_t)row0 * D + u.h * 128 + cc * 64, D, Kp, D, Vp, D, NT, nkw, lds, o, 0.125f);
            if (act && (!dummy || o[0][0] == 1.2345e-37f)) {
                unsigned ebase = (unsigned)((row0 + c.wid * 32 + 4 * c.hi) * D + u.h * 128 + c.r32);
                asm volatile("" : "+v"(ebase));
                if (cc == 0) {
#pragma unroll
                    for (int r = 0; r < 16; ++r)
#pragma unroll
                        for (int d = 0; d < 4; ++d) OS[ebase + (unsigned)(((r & 3) + 8 * (r >> 2)) * D + d * 32)] = o[d][r];
                } else {
#pragma unroll
                    for (int r = 0; r < 16; ++r) {
                        if ((r & 3) == 0) asm volatile("" ::: "memory");
                        const unsigned base = ebase + (unsigned)(((r & 3) + 8 * (r >> 2)) * D);
                        float x[4]; float ss = 0.f;
#pragma unroll
                        for (int d = 0; d < 4; ++d) { x[d] = OS[base + d * 32] - lam * o[d][r]; ss += x[d] * x[d]; }
                        ss += __shfl_xor(ss, 1); ss += __shfl_xor(ss, 2); ss += __shfl_xor(ss, 4); ss += __shfl_xor(ss, 8); ss += __shfl_xor(ss, 16);
                        const float rs = rsqrtf(ss * (1.0f / 128.0f) + 1e-5f);
#pragma unroll
                        for (int d = 0; d < 4; ++d) Qg[base + d * 32] = f2bf(x[d] * rs);
                    }
                }
            }
        }
    }
    __builtin_amdgcn_s_setprio(0);
}
__device__ __forceinline__ void ph_l0_out(const Args& a, LAS unsigned char* lds) {
    const Ctx c = mkctx(a);
    bf16_t* Q = (bf16_t*)(c.big + B0_Q);
    pg8::Gemm g{Q, c.wmix + W_OA, M, 1024, 1024, 1024, 0}; pg8::StaticOrder S; S.init(M, 1024, c.G, c.bid);
    EpiResidT<true> E{INP(0), INP(1), c.Xb, ssqb(c, 1)};
    pg8::gemm_phase(lds, g, S, E);
    prep_ffn(a, c, (LAS float*)lds, 0);
}

__device__ __forceinline__ void ph_ffn_up(const Args& a, LAS unsigned char* lds, int i) {
    const Ctx c = mkctx(a);
    pg8::Gemm g{c.Xb, c.wffn + W_GU, M, 5632, 1024, 1024, 0}; g.mrows = 254; g.moff = -2;
    pg8::StaticOrder S; S.init2(131, 22, c.G, c.bid);
    EpiFfn E{(bf16_t*)c.big, ssqb(c, 2 * i + 1), INP(30) + (size_t)i * 3 * FF, INP(31) + (size_t)i * FF, INP(8) + (size_t)i * SBN * 2 * FF,
             c.out + O_FCP + (size_t)i * NBP * 2 * FF, c.out + O_FCS + (size_t)i * SBN * 2 * FF, lds + 131072 + 4096};
    pg8::gemm_phase(lds, g, S, E);
}
constexpr size_t B_SLAB = 180 * MiB;
__device__ __forceinline__ void ph_ffn_down(const Args& a, LAS unsigned char* lds, int i) {
    const Ctx c = mkctx(a);
    constexpr int NS = FF / 256;
    const bool split = c.G >= 8 * NS;
    {
        pg8::Gemm g{(bf16_t*)c.big, wdn_buf(c, i), M, 1024, FF, FF, 0}; pg8::StaticOrder S; S.init(split ? MP : M, 1024, c.G, c.bid);
        EpiResidT<false> E{nullptr, nullptr, c.Xb, ssqb(c, 2 * i + 2)};
        pg8::gemm_phase(lds, g, S, E);
    }
    if (!split) { if (i < 3) prep_ffn(a, c, (LAS float*)lds, i + 1); return; }
    if (c.bid >= 4 * NS) {
        if (i < 3) prep_ffn(a, c, (LAS float*)lds, i + 1, c.bid - 4 * NS, c.G - 4 * NS);
        return;
    }
    unsigned* cnt = (unsigned*)c.ws + 3600 + i;
    float* slab = (float*)(c.big + B_SLAB);
    {
        const int pn = c.bid & 3, ks = c.bid >> 2;
        pg8::Gemm g{(bf16_t*)c.big + ks * 256, wdn_buf(c, i) + ks * 256, M, 1024, 256, FF, 0}; g.ldb = FF;
        pg8::SingleUnit S{128, pn};
        EpiSlab E{slab + (size_t)(pn * NS + ks) * 65536};
        pg8::gemm_phase(lds, g, S, E);
        __builtin_amdgcn_fence(__ATOMIC_RELEASE, "agent"); asm volatile("s_waitcnt vmcnt(0)" ::: "memory");
        __syncthreads();
        if (c.tid == 0) __hip_atomic_fetch_add(cnt, 1u, __ATOMIC_RELAXED, __HIP_MEMORY_SCOPE_AGENT);
    }
    if (c.bid < 16) {
        if (c.tid == 0) { unsigned sp = 0; while (__hip_atomic_load(cnt, __ATOMIC_RELAXED, __HIP_MEMORY_SCOPE_AGENT) < 4u * NS) { __builtin_amdgcn_s_sleep(2); if (++sp > (1u << 22)) break; } }
        __syncthreads();
        __builtin_amdgcn_fence(__ATOMIC_ACQUIRE, "agent"); asm volatile("s_waitcnt vmcnt(0)" ::: "memory");
        const int sl = c.bid, pn = sl >> 2, row = c.tid >> 1, cq = (sl & 3) * 64 + (c.tid & 1) * 32;
        const size_t xoff = (size_t)(MP + row) * D + pn * 256 + cq;
        float ss = 0.f;
#pragma unroll
        for (int k8 = 0; k8 < 4; ++k8) {
            const u32x4 w = *(const GAS u32x4*)(c.Xb + xoff + k8 * 8);
            f32x4 v0 = {bflo(w.x), bfhi(w.x), bflo(w.y), bfhi(w.y)}, v1 = {bflo(w.z), bfhi(w.z), bflo(w.w), bfhi(w.w)};
#pragma unroll
            for (int ks = 0; ks < NS; ++ks) { const float* p = slab + (size_t)(pn * NS + ks) * 65536 + row * 256 + cq + k8 * 8;
                v0 += *(const GAS f32x4*)p; v1 += *(const GAS f32x4*)(p + 4); }
            *(GAS u32x4*)(c.Xb + xoff + k8 * 8) = pack8(v0, v1);
            ss += (v0[0] * v0[0] + v0[1] * v0[1]) + (v0[2] * v0[2] + v0[3] * v0[3]) + (v1[0] * v1[0] + v1[1] * v1[1]) + (v1[2] * v1[2] + v1[3] * v1[3]);
        }
        ss += __shfl_xor(ss, 1);
        if ((c.tid & 1) == 0) ssqb(c, 2 * i + 2)[(size_t)(MP + row) * 16 + sl] = ss;
    }
}

__device__ __forceinline__ void ph_l1_down(const Args& a, LAS unsigned char* lds) {
    const Ctx c = mkctx(a);
    pg8::Gemm g{c.Xb, c.wmix + W_DB, M, 768, 1024, 1024, 0}; pg8::StaticOrder S; S.init(M, 768, c.G, c.bid);
    EpiF32 E{(float*)(c.big + B1_DOWN), 768, ssqb(c, 2)};
    pg8::gemm_phase(lds, g, S, E);
}
__device__ __forceinline__ void ph_l1_rows(const Args& a) {
    const Ctx c = mkctx(a);
    const float* DOWN = (const float*)(c.big + B1_DOWN); bf16_t* CQ = (bf16_t*)(c.big + B1_CQ); bf16_t* CKV = (bf16_t*)(c.big + B1_CKV); bf16_t* KR = (bf16_t*)(c.big + B1_KR);
    bf16_t* KsN = (bf16_t*)(c.tail + T_K); bf16_t* VsB = (bf16_t*)(c.tail + T_V); bf16_t* KRs = (bf16_t*)(c.tail + T_KR);
    const float* gq = INP(17); const float* gkv = INP(19); const int lane = c.lane;
    for (int r = c.gw; r < M; r += c.NWV) {
        const float* dr = DOWN + (size_t)r * 768;
        const bool samp = r >= MP; const int sr_ = r - MP, sbb = sr_ >> 5, tt = sr_ & 31;
        const int pos = samp ? PAST + tt : (r & (SEQ - 1));
        float cq[6]; float s1 = 0.f;
#pragma unroll
        for (int j = 0; j < 6; ++j) { cq[j] = dr[j * 64 + lane]; s1 += cq[j] * cq[j]; }
        s1 = wave_sum(s1); const float r1 = rsqrtf(s1 * (1.0f / 384.0f) + NORM_EPS);
#pragma unroll
        for (int j = 0; j < 6; ++j) CQ[(size_t)r * 384 + j * 64 + lane] = f2bf(cq[j] * r1 * gq[j * 64 + lane]);
        float kv[4]; float s2 = 0.f;
#pragma unroll
        for (int j = 0; j < 4; ++j) { kv[j] = dr[384 + j * 64 + lane]; s2 += kv[j] * kv[j]; }
        s2 = wave_sum(s2); const float r2 = rsqrtf(s2 * (1.0f / 256.0f) + NORM_EPS);
        float* lo = samp ? c.out + O_BLS + (size_t)sr_ * 256 : c.out + O_BLP + (size_t)r * 256;
#pragma unroll
        for (int j = 0; j < 4; ++j) { const float v = kv[j] * r2 * gkv[j * 64 + lane]; lo[j * 64 + lane] = v; CKV[(size_t)r * 256 + j * 64 + lane] = f2bf(v); }
        const float xk = dr[640 + lane], xo = __shfl_xor(xk, 32);
        const float cs = c.rope[(size_t)pos * 64 + (lane & 31)], sn = c.rope[(size_t)pos * 64 + 32 + (lane & 31)];
        const float y = lane < 32 ? xk * cs - xo * sn : xk * cs + xo * sn;
        if (samp) { c.out[O_BRS + (size_t)sr_ * 64 + lane] = y; KRs[((size_t)sbb * NKSP + PAST + tt) * 64 + lane] = f2bf(y); }
        else { c.out[O_BRP + (size_t)r * 64 + lane] = y; KR[(size_t)r * 64 + lane] = f2bf(y); }
    }
    const float* cl = INP(4); const float* ckr = INP(5);
    for (long i = c.gt; i < (long)MCACHE * 256 / 8; i += c.NTH) {
        const long e = i * 8;
        *(GAS u32x4*)(CKV + (size_t)M * 256 + e) = pack8(*(const GAS f32x4*)(cl + e), *(const GAS f32x4*)(cl + e + 4));
    }
    for (long i = c.gt; i < (long)MCACHE * 64 / 8; i += c.NTH) {
        const long e = i * 8; const int sbb = (int)(e / (PAST * 64)); const long rem = e % (PAST * 64);
        *(GAS u32x4*)(KRs + (size_t)sbb * NKSP * 64 + rem) = pack8(*(const GAS f32x4*)(ckr + e), *(const GAS f32x4*)(ckr + e + 4));
    }
    for (long i = c.gt; i < (long)SBN * (NKSP - NKS) * D / 8; i += c.NTH) {
        const long e = i * 8; const int sbb = (int)(e / ((long)(NKSP - NKS) * D)); const long rem = e % ((long)(NKSP - NKS) * D);
        const size_t dst = ((size_t)sbb * NKSP + NKS) * D + rem;
        *(GAS u32x4*)(KsN + dst) = (u32x4){0, 0, 0, 0}; *(GAS u32x4*)(VsB + dst) = (u32x4){0, 0, 0, 0};
    }
    for (long i = c.gt; i < (long)SBN * (NKSP - NKS) * 64 / 8; i += c.NTH) {
        const long e = i * 8; const int sbb = (int)(e / ((long)(NKSP - NKS) * 64)); const long rem = e % ((long)(NKSP - NKS) * 64);
        *(GAS u32x4*)(KRs + ((size_t)sbb * NKSP + NKS) * 64 + rem) = (u32x4){0, 0, 0, 0};
    }
}
__device__ __forceinline__ void ph_l1_uq(const Args& a, LAS unsigned char* lds) {
    const Ctx c = mkctx(a);
    pg8::Gemm g{(bf16_t*)(c.big + B1_CQ), c.wmix + W_UQ, M, 1536, 384, 384, 0}; pg8::StaticOrder S; S.init(M, 1536, c.G, c.bid);
    EpiUQ E{c.rope, (bf16_t*)(c.big + B1_DOWN)};
    pg8::gemm_phase(lds, g, S, E);
}
__device__ __forceinline__ void ph_l1_expand(const Args& a, LAS unsigned char* lds) {
    const Ctx c = mkctx(a);
    pg8::Gemm g{(bf16_t*)(c.big + B1_CKV), c.wmix + W_UKV, MX, 2048, 256, 256, 0}; pg8::StaticOrder S; S.init(MX, 2048, c.G, (c.bid + c.G / 2) % c.G);
    EpiExpand E{(bf16_t*)(c.big + B1_KN), (bf16_t*)(c.big + B1_V), (bf16_t*)(c.tail + T_K), (bf16_t*)(c.tail + T_V)};
    pg8::gemm_phase(lds, g, S, E);
}
__device__ __forceinline__ void ph_l1_attn(const Args& a, LAS unsigned char* lds, int dummy) {
    const Ctx c = mkctx(a);
    bf16_t* QB = (bf16_t*)(c.big + B1_DOWN); bf16_t* KN = (bf16_t*)(c.big + B1_KN); bf16_t* KR = (bf16_t*)(c.big + B1_KR); bf16_t* VB = (bf16_t*)(c.big + B1_V); GAS bf16_t* AO = (GAS bf16_t*)(c.big + B1_AO);
    bf16_t* KsN = (bf16_t*)(c.tail + T_K); bf16_t* VsB = (bf16_t*)(c.tail + T_V); bf16_t* KRs = (bf16_t*)(c.tail + T_KR);
    const int ucount = attn_ucount(c.G, c.bid);
    if (__builtin_amdgcn_readfirstlane(c.tid) >= 256) __builtin_amdgcn_s_setprio(1);
#pragma unroll 1
    for (int ui = 0; ui < ucount; ++ui) {
        const AUnit u = attn_unit_of(c.G, c.bid, ui);
        const int row0 = u.samp ? MP + u.sbb * 32 : u.b * SEQ + u.qb * 256;
        const int NT = u.samp ? 17 : 4 * u.qb + 4;
        const int lim = u.samp ? (c.wid == 0 ? 16 : -1) : 4 * u.qb + (c.wid >> 1);
        const int nkeys = u.samp ? NKS : NT * 64;
        const bool act = lim >= 0;
        const bf16_t* Kp = u.samp ? KsN + (size_t)u.sbb * NKSP * D + u.h * 128 : KN + (size_t)u.b * SEQ * D + u.h * 128;
        const bf16_t* Krp = u.samp ? KRs + (size_t)u.sbb * NKSP * 64 : KR + (size_t)u.b * SEQ * 64;
        const bf16_t* Vp = u.samp ? VsB + (size_t)u.sbb * NKSP * D + u.h * 128 : VB + (size_t)u.b * SEQ * D + u.h * 128;
        f32x16 o[4];
        attn_unit_np<192>(QB + (size_t)row0 * 1536 + u.h * 192, 1536, Kp, D, Krp, Vp, D, NT, lim, nkeys, lds, o, 0.07216878364870322f);
        if (act && (!dummy || o[0][0] == 1.2345e-37f)) {
            unsigned ebase = (unsigned)((row0 + c.wid * 32 + 4 * c.hi) * D + u.h * 128 + c.r32);
            asm volatile("" : "+v"(ebase));
#pragma unroll
            for (int r = 0; r < 16; ++r)
#pragma unroll
                for (int d = 0; d < 4; ++d) AO[ebase + (unsigned)(((r & 3) + 8 * (r >> 2)) * D + d * 32)] = f2bf(o[d][r]);
        }
    }
    __builtin_amdgcn_s_setprio(0);
}
__device__ __forceinline__ void ph_mix_out(const Args& a, LAS unsigned char* lds, size_t a_off, size_t w_off, int K, int lda, int apn, int so) {
    const Ctx c = mkctx(a);
    pg8::Gemm g{(bf16_t*)(c.big + a_off), c.wmix + w_off, M, 1024, K, lda, apn}; pg8::StaticOrder S; S.init(M, 1024, c.G, c.bid);
    EpiResidT<false> E{nullptr, nullptr, c.Xb, ssqb(c, so)};
    pg8::gemm_phase(lds, g, S, E);
}

__device__ __forceinline__ void ph_l2_in(const Args& a, LAS unsigned char* lds) {
    const Ctx c = mkctx(a);
    pg8::Gemm g{c.Xb, c.wmix + W_CIN, M, 3072, 1024, 1024, 0}; pg8::StaticOrder S; S.init(M, 3072, c.G, c.bid);
    EpiBf16 E{(bf16_t*)(c.big + B2_CIN), 3072, ssqb(c, 4), nullptr, nullptr, 0};
    pg8::gemm_phase(lds, g, S, E);
}
__device__ __forceinline__ void ph_l2_conv(const Args& a) {
    const Ctx c = mkctx(a);
    const bf16_t* CIN = (const bf16_t*)(c.big + B2_CIN); bf16_t* CP = (bf16_t*)(c.big + B2_CP);
    const float* state_c = INP(6); const float* cw = INP(24);
    const long ntask = (long)(M / 4) * (D / 8);
    for (long t = c.gt; t < ntask; t += c.NTH) {
        const int cch = (int)(t % (D / 8)), rb = (int)(t / (D / 8)), r0 = rb * 4, c0 = cch * 8;
        const bool samp = r0 >= MP;
        const int spos = samp ? ((r0 - MP) & 31) : (r0 & (SEQ - 1));
        const int sbb = (r0 - MP) >> 5, bb_ = r0 >> 14;
        float z[6][8];
#pragma unroll
        for (int k = 0; k < 6; ++k) {
            if (k >= 2 || spos != 0) { float gc[8], vv[8]; const bf16_t* rp_ = CIN + (size_t)(r0 - 2 + k) * 3072 + c0;
                unpack8(*(const GAS u32x4*)(rp_ + 1024), gc); unpack8(*(const GAS u32x4*)(rp_ + 2048), vv);
#pragma unroll
                for (int e = 0; e < 8; ++e) z[k][e] = gc[e] * vv[e]; }
            else if (samp) {
#pragma unroll
                for (int e = 0; e < 8; ++e) z[k][e] = state_c[(size_t)(sbb * 2 + k) * D + c0 + e]; }
            else {
#pragma unroll
                for (int e = 0; e < 8; ++e) z[k][e] = 0.f; }
        }
        float w0[8], w1[8], w2[8];
#pragma unroll
        for (int e = 0; e < 8; ++e) { w0[e] = cw[c0 + e]; w1[e] = cw[D + c0 + e]; w2[e] = cw[2 * D + c0 + e]; }
#pragma unroll
        for (int j = 0; j < 4; ++j) {
            const int r = r0 + j;
            float gb[8]; unpack8(*(const GAS u32x4*)(CIN + (size_t)r * 3072 + c0), gb);
            float ov[8];
#pragma unroll
            for (int e = 0; e < 8; ++e) ov[e] = gb[e] * (w0[e] * z[j][e] + w1[e] * z[j + 1][e] + w2[e] * z[j + 2][e]);
            u32x4 w; w.x = cvt_pk(ov[0], ov[1]); w.y = cvt_pk(ov[2], ov[3]); w.z = cvt_pk(ov[4], ov[5]); w.w = cvt_pk(ov[6], ov[7]);
            *(GAS u32x4*)(CP + (size_t)r * D + c0) = w;
            float* so = nullptr;
            if (!samp) { const int s = spos + j; if (s >= SEQ - 2) so = c.out + O_CCP + (size_t)(bb_ * 2 + (s - (SEQ - 2))) * D + c0; }
            else { const int tq = spos + j; if (tq >= 30) so = c.out + O_CCS + (size_t)(sbb * 2 + (tq - 30)) * D + c0; }
            if (so) {
#pragma unroll
                for (int e = 0; e < 8; ++e) so[e] = z[j + 2][e]; }
        }
    }
}

__device__ __forceinline__ void ph_l3_rstd(const Args& a) {
    const Ctx c = mkctx(a);
    float* rst = (float*)(c.ws + 65536); const float* sq = ssqb(c, 6);
    for (long r = c.gt; r < M; r += c.NTH) rst[r] = rstd_row(sq, (int)r);
}
__device__ __forceinline__ void ph_l3_pool(const Args& a, LAS unsigned char* lds) {
    const Ctx c = mkctx(a);
    bf16_t* DP = (bf16_t*)c.big;
    const float* rst = (const float*)(c.ws + 65536); const float* gm = INP(9) + 3 * D; const float* state_d = INP(7);
    const long ntask = (long)M * (D / 4);
    for (long t = c.gt; t < ntask; t += c.NTH) {
        const int c0 = (int)(t % (D / 4)) * 4, r = (int)(t / (D / 4));
        const bool samp = r >= MP; const int sr_ = r - MP, sbb = sr_ >> 5;
        const int spos = samp ? (sr_ & 31) : (r & (SEQ - 1));
        const int w = 2 << (c0 >> 8);
        const f32x4 gv = *(const GAS f32x4*)(gm + c0);
        const u32x2 wt = *(const GAS u32x2*)(c.Xb + (size_t)r * D + c0);
        const f32x4 ht = (f32x4){bflo(wt.x), bfhi(wt.x), bflo(wt.y), bfhi(wt.y)} * rst[r] * gv;
        f32x4 sum = ht;
        for (int i = 1; i < w; ++i) {
            const int sp = spos - i;
            if (sp >= 0) { const u32x2 wi = *(const GAS u32x2*)(c.Xb + (size_t)(r - i) * D + c0); sum += (f32x4){bflo(wi.x), bfhi(wi.x), bflo(wi.y), bfhi(wi.y)} * rst[r - i] * gv; }
            else if (samp) sum += *(const GAS f32x4*)(state_d + (size_t)(sbb * 15 + 15 + sp) * D + c0);
        }
        const float cnt = samp ? (float)w : (float)((spos + 1) < w ? (spos + 1) : w);
        const f32x4 dp = sum / cnt - ht;
        *(GAS u32x2*)(DP + (size_t)r * D + c0) = pack4(dp);
        if (!samp) { if (spos >= SEQ - 15) *(GAS f32x4*)(c.out + O_DPP + (size_t)((r >> 14) * 15 + (spos - (SEQ - 15))) * D + c0) = ht; }
        else { if (spos >= 17) *(GAS f32x4*)(c.out + O_DPS + (size_t)(sbb * 15 + (spos - 17)) * D + c0) = ht; }
    }
}
__device__ __forceinline__ void ph_final(const Args& a) {
    const Ctx c = mkctx(a);
    const float* sq = ssqb(c, 8); const float* gf = INP(11);
    for (int r = c.gw; r < M; r += c.NWV) {
        const float rs = rstd_row(sq, r);
#pragma unroll
        for (int j = 0; j < 4; ++j) { const int cc_ = j * 256 + c.lane * 4; const u32x2 w = *(const GAS u32x2*)(c.Xb + (size_t)r * D + cc_);
            const f32x4 xv = {bflo(w.x), bfhi(w.x), bflo(w.y), bfhi(w.y)};
            *(GAS f32x4*)(c.X + (size_t)r * D + cc_) = xv * rs * *(const GAS f32x4*)(gf + cc_); }
    }
}

#ifdef SKIP_PH_PROLOGUE
#define ON_PH_PROLOGUE(x)
#else
#define ON_PH_PROLOGUE(x) x
#endif
#ifdef SKIP_PH_L0_QKV
#define ON_PH_L0_QKV(x)
#else
#define ON_PH_L0_QKV(x) x
#endif
#ifdef SKIP_PH_L0_ATTN
#define ON_PH_L0_ATTN(x)
#else
#define ON_PH_L0_ATTN(x) x
#endif
#ifdef SKIP_PH_L0_OUT
#define ON_PH_L0_OUT(x)
#else
#define ON_PH_L0_OUT(x) x
#endif
#ifdef SKIP_PH_L1_DOWN
#define ON_PH_L1_DOWN(x)
#else
#define ON_PH_L1_DOWN(x) x
#endif
#ifdef SKIP_PH_L1_ROWS
#define ON_PH_L1_ROWS(x)
#else
#define ON_PH_L1_ROWS(x) x
#endif
#ifdef SKIP_PH_L1_UQ
#define ON_PH_L1_UQ(x)
#else
#define ON_PH_L1_UQ(x) x
#endif
#ifdef SKIP_PH_L1_EXPAND
#define ON_PH_L1_EXPAND(x)
#else
#define ON_PH_L1_EXPAND(x) x
#endif
#ifdef SKIP_PH_L1_ATTN
#define ON_PH_L1_ATTN(x)
#else
#define ON_PH_L1_ATTN(x) x
#endif
#ifdef SKIP_PH_MIX_OUT
#define ON_PH_MIX_OUT(x)
#else
#define ON_PH_MIX_OUT(x) x
#endif
#ifdef SKIP_PH_L2_IN
#define ON_PH_L2_IN(x)
#else
#define ON_PH_L2_IN(x) x
#endif
#ifdef SKIP_PH_L2_CONV
#define ON_PH_L2_CONV(x)
#else
#define ON_PH_L2_CONV(x) x
#endif
#ifdef SKIP_PH_L3_POOL
#define ON_PH_L3_POOL(x)
#else
#define ON_PH_L3_POOL(x) x
#endif
#ifdef SKIP_PH_FFN_UP
#define ON_PH_FFN_UP(x)
#else
#define ON_PH_FFN_UP(x) x
#endif
#ifdef SKIP_PH_FFN_CONV
#define ON_PH_FFN_CONV(x)
#else
#define ON_PH_FFN_CONV(x) x
#endif
#ifdef SKIP_PH_FFN_DOWN
#define ON_PH_FFN_DOWN(x)
#else
#define ON_PH_FFN_DOWN(x) x
#endif
#ifdef SKIP_PH_FINAL
#define ON_PH_FINAL(x)
#else
#define ON_PH_FINAL(x) x
#endif
__global__ void __launch_bounds__(NTHREADS, 2) mega_fwd(Args a) {
    extern __shared__ __attribute__((aligned(16))) unsigned char lds_raw[];
    LAS unsigned char* lds = (LAS unsigned char*)lds_raw;
    cg::grid_group grid = cg::this_grid();
    if (gridDim.x == 0xffffffffu) grid.sync();
    int nrep_attn = PROBE_ATTN_REPS; asm volatile("" : "+s"(nrep_attn));
    int nrep_conv = PROBE_CONV_REPS; asm volatile("" : "+s"(nrep_conv));
    int nrep_sync = PROBE_SYNC_REPS; asm volatile("" : "+s"(nrep_sync));
    LAS unsigned* bst = (LAS unsigned*)(lds + 131072 + 2048);
    if (threadIdx.x < 2) bst[threadIdx.x] = 0u;
    __syncthreads();
    unsigned char* wsb = a.ws; asm volatile("" : "+s"(wsb));
    const XcdBarrier xbar = xcd_barrier_post((unsigned*)wsb, (volatile LAS unsigned*)bst);
#define GSYNC() do { for (int q_ = 0; q_ < nrep_sync; ++q_) { xcd_barrier(xbar); } } while (0)
    ON_PH_PROLOGUE(ph_prologue(a, lds);) GSYNC();
#pragma unroll 1
    for (int layer = 0; layer < 4; ++layer) {
        if (layer == 0) {
            ON_PH_L0_QKV(ph_l0_qkv(a, lds);) GSYNC();
            ON_PH_L0_ATTN(for (int rep = nrep_attn - 1; rep >= 0; --rep) ph_l0_attn(a, lds, rep);) GSYNC();
            ON_PH_L0_OUT(ph_l0_out(a, lds);) GSYNC();
        } else if (layer == 1) {
            ON_PH_L1_DOWN(ph_l1_down(a, lds);) GSYNC();
            ON_PH_L1_ROWS(ph_l1_rows(a);) GSYNC();
            ON_PH_L1_UQ(ph_l1_uq(a, lds);) ON_PH_L1_EXPAND(ph_l1_expand(a, lds);) GSYNC();
            ON_PH_L1_ATTN(for (int rep = nrep_attn - 1; rep >= 0; --rep) ph_l1_attn(a, lds, rep);) GSYNC();
            ON_PH_MIX_OUT(ph_mix_out(a, lds, B1_AO, W_OB, 1024, 1024, 0, 3);) GSYNC();
        } else if (layer == 2) {
            ON_PH_L2_IN(ph_l2_in(a, lds);) GSYNC();
            ON_PH_L2_CONV(ph_l2_conv(a);) GSYNC();
            ON_PH_MIX_OUT(ph_mix_out(a, lds, B2_CP, W_COUT, 1024, 1024, 0, 5);) GSYNC();
        } else {
            ON_PH_L3_POOL(ph_l3_rstd(a);) GSYNC();
            ON_PH_L3_POOL(ph_l3_pool(a, lds);) GSYNC();
            ON_PH_MIX_OUT(ph_mix_out(a, lds, 0, W_DG, 256, 1024, 256, 7);) GSYNC();
        }
        ON_PH_FFN_UP(ph_ffn_up(a, lds, layer);) GSYNC();
        ON_PH_FFN_DOWN(ph_ffn_down(a, lds, layer);) GSYNC();
    }
    ON_PH_FINAL(ph_final(a);)
}
extern "C" void kernel_launch(void* const* d_in, const int* in_sizes, int n_in, void* d_out, int out_size, void* d_ws, size_t ws_size, hipStream_t stream) {
    static int grid = 0;
    if (grid == 0) {
        if (n_in != 33 || (size_t)out_size != O_END || ws_size < WS_END) {
            fprintf(stderr, "kernel_launch: shape mismatch n_in %d out %d (want %zu) ws %zu (want %zu)\n", n_in, out_size, (size_t)O_END, ws_size, (size_t)WS_END);
            grid = -1; return; }
        int dev = 0, cus = 0, per_cu = 0;
        hipGetDevice(&dev);
        hipDeviceGetAttribute(&cus, hipDeviceAttributeMultiprocessorCount, dev);
        if (hipFuncSetAttribute((const void*)mega_fwd, hipFuncAttributeMaxDynamicSharedMemorySize, LDS_BYTES) != hipSuccess) { fprintf(stderr, "kernel_launch: hipFuncSetAttribute failed\n"); grid = -1; return; }
        if (hipOccupancyMaxActiveBlocksPerMultiprocessor(&per_cu, (const void*)mega_fwd, NTHREADS, LDS_BYTES) != hipSuccess || per_cu < 1) { fprintf(stderr, "kernel_launch: occupancy query failed (%d)\n", per_cu); per_cu = 1; }
        (void)hipGetLastError();
        grid = cus * 1;
        fprintf(stderr, "kernel_launch: cus %d per_cu %d grid %d\n", cus, per_cu, grid);
    }
    if (grid < 0) return;
    Args a{};
    for (int i = 0; i < 33; ++i) a.in[i] = (const float*)d_in[i];
    a.out = (float*)d_out; a.ws = (unsigned char*)d_ws;
    if (hipMemsetAsync(d_ws, 0, 16384, stream) != hipSuccess) { fprintf(stderr, "kernel_launch: memset failed\n"); return; }
    void* args[] = {&a};
    hipError_t e = hipLaunchCooperativeKernel((const void*)mega_fwd, dim3(grid), dim3(NTHREADS), args, LDS_BYTES, stream);
    if (e != hipSuccess) fprintf(stderr, "kernel_launch: cooperative launch failed: %s (grid %d)\n", hipGetErrorString(e), grid);
}
```

```cpp
#include <hip/hip_runtime.h>
#include <hip/hip_cooperative_groups.h>
#include <cstdio>
#include <cstdint>
namespace cg = cooperative_groups;

#define LAS __attribute__((address_space(3)))
#define GAS __attribute__((address_space(1)))
typedef unsigned short bf16_t;
typedef short bf16x8 __attribute__((ext_vector_type(8)));
typedef short s16x4 __attribute__((ext_vector_type(4)));
typedef float f32x4 __attribute__((ext_vector_type(4)));
typedef float f32x16 __attribute__((ext_vector_type(16)));
typedef unsigned u32x4 __attribute__((ext_vector_type(4)));
typedef unsigned u32x2 __attribute__((ext_vector_type(2)));

constexpr int D = 1024, SEQ = 16384, NBP = 2, MP = NBP * SEQ, SBN = 8, STN = 32, MS = SBN * STN, M = MP + MS;
constexpr int PAST = 1024, NKS = PAST + STN, NKSP = 1152, FF = 2816, MCACHE = SBN * PAST, MX = M + MCACHE;
constexpr float NORM_EPS = 1e-6f;
constexpr int NTHREADS = 512;
constexpr int LDS_BYTES = 131072 + 4096 + 8192;
#ifndef PROBE_CONV_REPS
#define PROBE_CONV_REPS 1
#endif
#ifndef PROBE_SYNC_REPS
#define PROBE_SYNC_REPS 3
#endif
#ifndef PROBE_ATTN_REPS
#define PROBE_ATTN_REPS 1
#endif

constexpr size_t O_Y = 0;
constexpr size_t O_AKP = (size_t)M * D;
constexpr size_t O_AVP = O_AKP + (size_t)MP * D;
constexpr size_t O_BLP = O_AVP + (size_t)MP * D;
constexpr size_t O_BRP = O_BLP + (size_t)MP * 256;
constexpr size_t O_CCP = O_BRP + (size_t)MP * 64;
constexpr size_t O_DPP = O_CCP + (size_t)NBP * 2 * D;
constexpr size_t O_FCP = O_DPP + (size_t)NBP * 15 * D;
constexpr size_t O_AKS = O_FCP + (size_t)4 * NBP * 2 * FF;
constexpr size_t O_AVS = O_AKS + (size_t)MS * D;
constexpr size_t O_BLS = O_AVS + (size_t)MS * D;
constexpr size_t O_BRS = O_BLS + (size_t)MS * 256;
constexpr size_t O_CCS = O_BRS + (size_t)MS * 64;
constexpr size_t O_DPS = O_CCS + (size_t)SBN * 2 * D;
constexpr size_t O_FCS = O_DPS + (size_t)SBN * 15 * D;
constexpr size_t O_END = O_FCS + (size_t)4 * SBN * 2 * FF;

constexpr size_t MiB = 1u << 20;
constexpr size_t WS_SSQ = 0;
constexpr size_t WS_ROPE = 2 * MiB;
constexpr size_t WS_WMIX = 6 * MiB;
constexpr size_t WS_WFFN = 29 * MiB;
constexpr size_t WS_XB = 46 * MiB;
constexpr size_t WS_BIG = 111 * MiB;
constexpr size_t WS_TAIL = 467 * MiB;
constexpr size_t WS_END = 512 * MiB;
constexpr size_t WS_SSQP = WS_TAIL + 38 * MiB;
static_assert((size_t)M * 16 * 4 <= 3 * MiB && WS_SSQP + 6 * MiB <= WS_END, "ssqp");
constexpr size_t W_QKV = 0, W_OA = W_QKV + 3072u * 1024, W_DB = W_OA + 1024u * 1024, W_UQ = W_DB + 768u * 1024, W_UKV = W_UQ + 1536u * 384,
                 W_OB = W_UKV + 2048u * 256, W_CIN = W_OB + 1024u * 1024, W_COUT = W_CIN + 3072u * 1024, W_DG = W_COUT + 1024u * 1024, W_MIX_END = W_DG + 1024u * 256;
static_assert(WS_WMIX + W_MIX_END * 2 <= WS_WFFN, "mixer weights");
constexpr size_t W_GU = 0, W_DN = 5632u * 1024, W_FFN_END = W_DN + 1024u * 2816;
static_assert(WS_WFFN + W_FFN_END * 2 <= WS_XB, "ffn weights");
static_assert(WS_XB + (size_t)M * D * 2 <= WS_BIG, "xb");
static_assert(WS_BIG + (size_t)M * 5632 * 2 <= WS_TAIL, "U");
constexpr size_t B0_Q = 0, B0_K = 65 * MiB, B0_V = 130 * MiB, B0_OS = 195 * MiB;
constexpr size_t B1_DOWN = 0, B1_CQ = 97 * MiB, B1_CKV = 122 * MiB, B1_KN = 143 * MiB, B1_KR = 208 * MiB, B1_V = 213 * MiB, B1_AO = 278 * MiB;
constexpr size_t B2_CIN = 0, B2_CP = 194 * MiB;
static_assert(B0_OS + (size_t)M * D * 4 <= 356 * MiB && B1_AO + 65 * MiB <= 356 * MiB, "big");
static_assert((size_t)MX * 256 * 2 <= 21 * MiB && (size_t)M * 1536 * 2 <= 97 * MiB && (size_t)M * 768 * 4 <= 97 * MiB, "big2");
constexpr size_t T_K = 0, T_V = 18 * MiB, T_KR = 36 * MiB;
static_assert((size_t)SBN * NKSP * D * 2 <= 18 * MiB && WS_TAIL + T_KR + (size_t)SBN * NKSP * 64 * 2 <= WS_END, "tail");

__device__ __forceinline__ unsigned cvt_pk(float lo, float hi) { unsigned r; asm volatile("v_cvt_pk_bf16_f32 %0, %1, %2" : "=v"(r) : "v"(lo), "v"(hi)); return r; }
__device__ __forceinline__ bf16_t f2bf(float f) { return (bf16_t)(cvt_pk(f, 0.f) & 0xffffu); }
__device__ __forceinline__ u32x2 pack4(f32x4 v) { u32x2 w; w.x = cvt_pk(v[0], v[1]); w.y = cvt_pk(v[2], v[3]); return w; }
__device__ __forceinline__ u32x4 pack8(f32x4 a, f32x4 b) { u32x4 w; w.x = cvt_pk(a[0], a[1]); w.y = cvt_pk(a[2], a[3]); w.z = cvt_pk(b[0], b[1]); w.w = cvt_pk(b[2], b[3]); return w; }
__device__ __forceinline__ float bflo(unsigned w) { return __uint_as_float(w << 16); }
__device__ __forceinline__ float bfhi(unsigned w) { return __uint_as_float(w & 0xffff0000u); }
__device__ __forceinline__ void unpack8(u32x4 w, float* f) { f[0] = bflo(w.x); f[1] = bfhi(w.x); f[2] = bflo(w.y); f[3] = bfhi(w.y); f[4] = bflo(w.z); f[5] = bfhi(w.z); f[6] = bflo(w.w); f[7] = bfhi(w.w); }
__device__ __forceinline__ float rstd_of(float ssq) { return rsqrtf(ssq * (1.0f / 1024.0f) + NORM_EPS); }
__device__ __forceinline__ float rstd_row(const float* __restrict__ p, int row) {
    const f32x4* q = (const f32x4*)(p + (size_t)row * 16);
    const f32x4 a = q[0], b = q[1], c = q[2], d = q[3];
    const float s = (((a[0] + a[1]) + (a[2] + a[3])) + ((b[0] + b[1]) + (b[2] + b[3]))) + (((c[0] + c[1]) + (c[2] + c[3])) + ((d[0] + d[1]) + (d[2] + d[3])));
    return rstd_of(s);
}
__device__ __forceinline__ float wave_sum(float v) {
#pragma unroll
    for (int o = 32; o >= 1; o >>= 1) v += __shfl_xor(v, o);
    return v;
}

namespace pg8 {
constexpr int BM = 256, BK = 64, HALF = 128, HTB = HALF * BK * 2, STAGE_BYTES = 8 * HTB, NXCD = 8, WGM = 8;
__host__ __device__ __forceinline__ int lds_byte(int r, int c) { const int st = (r >> 4) * 2 + (c >> 5), rr = r & 15, cc = c & 31, ob = rr * 64 + cc * 2; return st * 1024 + (ob ^ (((ob >> 9) & 1) << 5)); }
__host__ __device__ __forceinline__ void stage_rc(int b, int& R, int& C) { const int st = b / 1024, sb = b % 1024, swz = sb ^ (((sb >> 9) & 1) << 5); R = (st >> 1) * 16 + swz / 64; C = (st & 1) * 32 + (swz % 64) / 2; }
struct Unit { int pm, pn; };
struct Gemm { const bf16_t* A; const bf16_t* Bt; int M, N, K, lda, a_pn_step; int mrows = 256, moff = 0, ldb = 0; };
struct StaticOrder {
    int nM, nN, nwg, G, c;
    __device__ void init(int M_, int N_, int G_, int c_) { nM = M_ / BM; nN = N_ / BM; nwg = nM * nN; G = G_; c = c_; }
    __device__ void init2(int nM_, int nN_, int G_, int c_) { nM = nM_; nN = nN_; nwg = nM * nN; G = G_; c = c_; }
    __device__ bool next(int i, Unit& u) const {
        const long L = (long)i * G + c; if (L >= nwg) return false;
        int wgid = (int)L; { const int q = nwg / NXCD, r = nwg % NXCD, xcd = wgid % NXCD, off = wgid / NXCD; wgid = (xcd < r ? xcd * (q + 1) : r * (q + 1) + (xcd - r) * q) + off; }
        const int nig = WGM * nN, gid = wgid / nig, fm = gid * WGM, gsz = (nM - fm) < WGM ? (nM - fm) : WGM;
        u.pm = fm + ((wgid % nig) % gsz); u.pn = (wgid % nig) / gsz; return true;
    }
};
struct SingleUnit { int pm, pn; __device__ bool next(int i, Unit& u) const { if (i != 0) return false; u.pm = pm; u.pn = pn; return true; } };
template <class Epi, class Sched>
__device__ __forceinline__ void gemm_phase(LAS unsigned char* lds, const Gemm g, const Sched& S, const Epi& E) {
    int tid = threadIdx.x; asm volatile("" : "+v"(tid));
    const int wid = __builtin_amdgcn_readfirstlane(tid >> 6), lane = tid & 63, wr = wid >> 2, wc = wid & 3, fr = lane & 15, fq = lane >> 4;
    const int K = g.K, nt = K / BK;
    unsigned voffA[2], voffB[2];
#pragma unroll
    for (int i = 0; i < 2; ++i) { int R, C; stage_rc(tid * 16 + i * 8192, R, C); voffA[i] = (unsigned)(R * g.lda + C) * 2u; voffB[i] = (unsigned)(R * (g.ldb ? g.ldb : K) + C) * 2u; }
    const size_t kstep = (size_t)(BK * 2);
    const size_t hstepA = (size_t)HALF * g.lda * 2, hstepB = (size_t)HALF * (g.ldb ? g.ldb : K) * 2;
    const size_t tstepA = (size_t)g.mrows * g.lda * 2, tstepB = 2 * hstepB, apn = (size_t)g.a_pn_step * 2;
    const char* const Abase = (const char*)g.A + (long)g.moff * g.lda * 2;
    const unsigned ldsw = (unsigned)wid * 1024u;
    const int aoff = lds_byte(wr * 64 + fr, fq * 8), boff = lds_byte(wc * 32 + fr, fq * 8);
#define PG8_SA(b, h) (((b) * 2 + (h)) * HTB)
#define PG8_SB(b, h) ((4 + (b) * 2 + (h)) * HTB)
#define PG8_STAGE(bufoff, gbase, voff) do { _Pragma("unroll") for (int _i = 0; _i < 2; ++_i) \
        __builtin_amdgcn_global_load_lds((const unsigned*)((const char*)(gbase) + (voff)[_i]), (LAS unsigned*)(lds + (bufoff) + ldsw + _i * 8192), 16, 0, 0); } while (0)
#define PG8_LDA(dst, b, h) do { _Pragma("unroll") for (int m = 0; m < 4; ++m) _Pragma("unroll") for (int k = 0; k < 2; ++k) dst[m][k] = *(const LAS bf16x8*)(lds + PG8_SA(b, h) + aoff + m * 2048 + k * 1024); } while (0)
#define PG8_LDB(dst, b, h) do { _Pragma("unroll") for (int n = 0; n < 2; ++n) _Pragma("unroll") for (int k = 0; k < 2; ++k) dst[n][k] = *(const LAS bf16x8*)(lds + PG8_SB(b, h) + boff + n * 2048 + k * 1024); } while (0)
#define PG8_MMA(ai, bj, At, Bt) do { __builtin_amdgcn_s_setprio(1); _Pragma("unroll") for (int m = 0; m < 4; ++m) _Pragma("unroll") for (int n = 0; n < 2; ++n) _Pragma("unroll") for (int k = 0; k < 2; ++k) \
        acc[ai][bj][m][n] = __builtin_amdgcn_mfma_f32_16x16x32_bf16(Bt[n][k], At[m][k], acc[ai][bj][m][n], 0, 0, 0); __builtin_amdgcn_s_setprio(0); } while (0)
#define PG8_WAIT_V(n) asm volatile("s_waitcnt vmcnt(" #n ")" ::: "memory")
#define PG8_WAIT_L(n) asm volatile("s_waitcnt lgkmcnt(" #n ")" ::: "memory")
#define PG8_BAR __builtin_amdgcn_s_barrier()
#define PG8_SCHED __builtin_amdgcn_sched_barrier(0)
    Unit cur, nxt; int ui = 0;
    if (!S.next(0, cur)) return;
    f32x4 acc[2][2][4][2];
#pragma unroll
    for (int a = 0; a < 2; ++a)
#pragma unroll
        for (int b = 0; b < 2; ++b)
#pragma unroll
            for (int m = 0; m < 4; ++m)
#pragma unroll
                for (int n = 0; n < 2; ++n) acc[a][b][m][n] = (f32x4){0.f, 0.f, 0.f, 0.f};
    bf16x8 At[4][2], B0[2][2], B1[2][2];
    const char* cA = Abase + (size_t)cur.pm * tstepA + (size_t)cur.pn * apn; const char* cB = (const char*)g.Bt + (size_t)cur.pn * tstepB;
    PG8_STAGE(PG8_SB(0, 0), cB, voffB); PG8_STAGE(PG8_SB(0, 1), cB + hstepB, voffB); PG8_STAGE(PG8_SA(0, 0), cA, voffA); PG8_STAGE(PG8_SA(0, 1), cA + hstepA, voffA);
    if (wr == 1) PG8_BAR;
    PG8_WAIT_V(2); PG8_BAR;
    PG8_STAGE(PG8_SB(1, 0), cB + kstep, voffB); PG8_STAGE(PG8_SA(1, 0), cA + kstep, voffA); PG8_STAGE(PG8_SB(1, 1), cB + hstepB + kstep, voffB);
    PG8_WAIT_V(6); PG8_BAR;
    for (;;) {
        const bool has_next = S.next(ui + 1, nxt);
        const char* nA = has_next ? Abase + (size_t)nxt.pm * tstepA + (size_t)nxt.pn * apn : cA; const char* nB = has_next ? (const char*)g.Bt + (size_t)nxt.pn * tstepB : cB;
#pragma unroll 1
        for (int t = 0; t < nt; t += 2) {
            const bool last = (t == nt - 2);
            const char* a1 = cA + (size_t)(t + 1) * kstep;
            const char* a2 = last ? nA : cA + (size_t)(t + 2) * kstep; const char* b2 = last ? nB : cB + (size_t)(t + 2) * kstep;
            const char* a3 = a2 + kstep; const char* b3 = b2 + kstep;
            PG8_LDB(B0, 0, 0); PG8_LDB(B1, 0, 1); PG8_SCHED; PG8_LDA(At, 0, 0); PG8_STAGE(PG8_SA(1, 1), a1 + hstepA, voffA);
            PG8_WAIT_V(8); PG8_WAIT_L(0); PG8_BAR; PG8_MMA(0, 0, At, B0); PG8_MMA(0, 1, At, B1); PG8_BAR; PG8_SCHED;
            PG8_LDA(At, 0, 1); PG8_STAGE(PG8_SB(0, 0), b2, voffB); PG8_STAGE(PG8_SB(0, 1), b2 + hstepB, voffB); PG8_STAGE(PG8_SA(0, 0), a2, voffA);
            PG8_WAIT_V(8); PG8_WAIT_L(0); PG8_BAR; PG8_MMA(1, 0, At, B0); PG8_MMA(1, 1, At, B1); PG8_BAR; PG8_SCHED;
            PG8_LDB(B0, 1, 0); PG8_LDB(B1, 1, 1); PG8_SCHED; PG8_LDA(At, 1, 0); PG8_STAGE(PG8_SA(0, 1), a2 + hstepA, voffA);
            PG8_WAIT_V(8); PG8_WAIT_L(0); PG8_BAR; PG8_MMA(0, 0, At, B0); PG8_MMA(0, 1, At, B1); PG8_BAR; PG8_SCHED;
            PG8_LDA(At, 1, 1); PG8_STAGE(PG8_SB(1, 0), b3, voffB); PG8_STAGE(PG8_SB(1, 1), b3 + hstepB, voffB); PG8_STAGE(PG8_SA(1, 0), a3, voffA);
            PG8_WAIT_V(8); PG8_WAIT_L(0); PG8_BAR; PG8_MMA(1, 0, At, B0); PG8_MMA(1, 1, At, B1); PG8_BAR; PG8_SCHED;
        }
        if (wr == 0) PG8_BAR;
        E(acc, cur, wr, wc, fr, fq);
        if (!has_next) break;
#pragma unroll
        for (int a = 0; a < 2; ++a)
#pragma unroll
            for (int b = 0; b < 2; ++b)
#pragma unroll
                for (int m = 0; m < 4; ++m)
#pragma unroll
                    for (int n = 0; n < 2; ++n) acc[a][b][m][n] = (f32x4){0.f, 0.f, 0.f, 0.f};
        cur = nxt; cA = nA; cB = nB; ++ui;
        if (wr == 1) PG8_BAR;
    }
    PG8_WAIT_V(0);
    PG8_BAR;
#undef PG8_SA
#undef PG8_SB
#undef PG8_STAGE
#undef PG8_LDA
#undef PG8_LDB
#undef PG8_MMA
#undef PG8_WAIT_V
#undef PG8_WAIT_L
#undef PG8_BAR
#undef PG8_SCHED
}
}
using pg8::Unit;
typedef f32x4 Acc[2][2][4][2];

#define NT_ST4(ptr, v) __builtin_nontemporal_store((v), (GAS f32x4*)(ptr))
struct EpiBf16 {
    bf16_t* O; int ldc; const float* ssq; float* tap_p; float* tap_s; int tap_cols;
    __device__ __forceinline__ void operator()(const Acc& acc, const Unit& u, int wr, int wc, int fr, int fq) const {
#pragma unroll
        for (int ai = 0; ai < 2; ++ai)
#pragma unroll
            for (int m = 0; m < 4; ++m) {
                asm volatile("" ::: "memory");
                const int row = u.pm * 256 + ai * 128 + wr * 64 + m * 16 + fr;
                const float rs = ssq ? rstd_row(ssq, row) : 1.f;
                float* trow = nullptr;
                if (tap_cols) {
                    if (row < MP) { const int s = row & (SEQ - 1); if (s >= SEQ - 2) trow = tap_p + (size_t)((row >> 14) * 2 + (s - (SEQ - 2))) * FF; }
                    else { const int t = (row - MP) & 31; if (t >= 30) trow = tap_s + (size_t)(((row - MP) >> 5) * 2 + (t - 30)) * FF; }
                }
#pragma unroll
                for (int bj = 0; bj < 2; ++bj) {
                    const int col0 = u.pn * 256 + bj * 128 + wc * 32 + fq * 8;
                    const f32x4 v0 = acc[ai][bj][m][0] * rs, v1 = acc[ai][bj][m][1] * rs;
                    *(GAS u32x4*)(O + (size_t)row * ldc + col0) = pack8(v0, v1);
                    if (trow && col0 < tap_cols) { *(GAS f32x4*)(trow + col0) = v0; *(GAS f32x4*)(trow + col0 + 4) = v1; }
                }
            }
    }
};
struct EpiF32 {
    float* O; int ldc; const float* ssq;
    __device__ __forceinline__ void operator()(const Acc& acc, const Unit& u, int wr, int wc, int fr, int fq) const {
#pragma unroll
        for (int ai = 0; ai < 2; ++ai)
#pragma unroll
            for (int m = 0; m < 4; ++m) {
                asm volatile("" ::: "memory");
                const int row = u.pm * 256 + ai * 128 + wr * 64 + m * 16 + fr;
                const float rs = rstd_row(ssq, row);
#pragma unroll
                for (int bj = 0; bj < 2; ++bj) {
                    const int col0 = u.pn * 256 + bj * 128 + wc * 32 + fq * 8;
                    *(GAS f32x4*)(O + (size_t)row * ldc + col0) = acc[ai][bj][m][0] * rs;
                    *(GAS f32x4*)(O + (size_t)row * ldc + col0 + 4) = acc[ai][bj][m][1] * rs;
                }
            }
    }
};
struct EpiSlab {
    float* P;
    __device__ __forceinline__ void operator()(const Acc& acc, const Unit& u, int wr, int wc, int fr, int fq) const {
#pragma unroll
        for (int ai = 0; ai < 2; ++ai)
#pragma unroll
            for (int m = 0; m < 4; ++m) {
                const int row_l = ai * 128 + wr * 64 + m * 16 + fr;
#pragma unroll
                for (int bj = 0; bj < 2; ++bj) {
                    const int col_l = bj * 128 + wc * 32 + fq * 8;
                    *(GAS f32x4*)(P + row_l * 256 + col_l) = acc[ai][bj][m][0]; *(GAS f32x4*)(P + row_l * 256 + col_l + 4) = acc[ai][bj][m][1];
                }
            }
    }
};
template <bool F32IN> struct EpiResidT {
    const float* rp; const float* rsm; bf16_t* Xb; float* ssq_out;
    __device__ __forceinline__ void operator()(const Acc& acc, const Unit& u, int wr, int wc, int fr, int fq) const {
#pragma unroll
        for (int ai = 0; ai < 2; ++ai)
#pragma unroll
            for (int m = 0; m < 4; ++m) {
                asm volatile("" ::: "memory");
                const int row = u.pm * 256 + ai * 128 + wr * 64 + m * 16 + fr;
                float ss = 0.f;
#pragma unroll
                for (int bj = 0; bj < 2; ++bj) {
                    const int col0 = u.pn * 256 + bj * 128 + wc * 32 + fq * 8;
                    f32x4 r0, r1;
                    if (F32IN) { const float* rrow = (row < MP) ? rp + (size_t)row * D : rsm + (size_t)(row - MP) * D; r0 = *(const GAS f32x4*)(rrow + col0); r1 = *(const GAS f32x4*)(rrow + col0 + 4); }
                    else { const u32x4 w = *(const GAS u32x4*)(Xb + (size_t)row * D + col0); r0 = (f32x4){bflo(w.x), bfhi(w.x), bflo(w.y), bfhi(w.y)}; r1 = (f32x4){bflo(w.z), bfhi(w.z), bflo(w.w), bfhi(w.w)}; }
                    const f32x4 v0 = r0 + acc[ai][bj][m][0], v1 = r1 + acc[ai][bj][m][1];
                    *(GAS u32x4*)(Xb + (size_t)row * D + col0) = pack8(v0, v1);
                    ss += (v0[0] * v0[0] + v0[1] * v0[1]) + (v0[2] * v0[2] + v0[3] * v0[3]) + (v1[0] * v1[0] + v1[1] * v1[1]) + (v1[2] * v1[2] + v1[3] * v1[3]);
                }
                ss += __shfl_xor(ss, 16); ss += __shfl_xor(ss, 32);
                if (fq == 0) ssq_out[(size_t)row * 16 + u.pn * 4 + wc] = ss;
            }
    }
};

__device__ __forceinline__ float dpp_shr1(float oldv, float x) { return __int_as_float(__builtin_amdgcn_update_dpp(__float_as_int(oldv), __float_as_int(x), 0x111, 0xf, 0xf, false)); }
__device__ __forceinline__ float dpp_shr2(float oldv, float x) { return __int_as_float(__builtin_amdgcn_update_dpp(__float_as_int(oldv), __float_as_int(x), 0x112, 0xf, 0xf, false)); }
__device__ __forceinline__ float dpp_ror1(float x) { return __int_as_float(__builtin_amdgcn_update_dpp(0, __float_as_int(x), 0x121, 0xf, 0xf, false)); }
__device__ __forceinline__ float dpp_ror2(float x) { return __int_as_float(__builtin_amdgcn_update_dpp(0, __float_as_int(x), 0x122, 0xf, 0xf, false)); }
struct EpiFfn {
    bf16_t* ACT; const float* ssq; const float* cw; const float* cb; const float* st; float* tap_p; float* tap_s; LAS unsigned char* slab;
    __device__ __forceinline__ void operator()(Acc& acc, const Unit& u, int wr, int wc, int fr, int fq) const {
        asm volatile("" : "+v"(fr), "+v"(fq), "+s"(wr), "+s"(wc));
        const int r_lo = u.pm * 254 - 2;
        const bool has_start = (r_lo <= 0) || (r_lo <= SEQ && r_lo + 255 >= SEQ) || (r_lo + 255 >= MP);
        LAS float* rl = (LAS float*)(slab + 6144);
        { const int t_ = (wr * 4 + wc) * 64 + fq * 16 + fr, rw = t_ >> 1;
          const float* pp = ssq + (size_t)(r_lo + rw) * 16 + (t_ & 1) * 8;
          const f32x4 a_ = *(const GAS f32x4*)pp, b_ = *(const GAS f32x4*)(pp + 4);
          float sm = ((a_[0] + a_[1]) + (a_[2] + a_[3])) + ((b_[0] + b_[1]) + (b_[2] + b_[3]));
          sm += __shfl_xor(sm, 1);
          if ((t_ & 1) == 0) rl[rw] = rstd_of(sm); }
        asm volatile("s_waitcnt lgkmcnt(0)" ::: "memory"); __builtin_amdgcn_s_barrier(); asm volatile("" ::: "memory");
#pragma unroll
        for (int ai = 0; ai < 2; ++ai)
#pragma unroll
            for (int m = 0; m < 4; ++m) { const float rs = rl[ai * 128 + wr * 64 + m * 16 + fr];
#pragma unroll
                for (int bj = 0; bj < 2; ++bj) { acc[ai][bj][m][0] = acc[ai][bj][m][0] * rs; acc[ai][bj][m][1] = acc[ai][bj][m][1] * rs; } }
        LAS f32x4* sl = (LAS f32x4*)slab;
        if (fr >= 14) {
#pragma unroll
            for (int ai = 0; ai < 2; ++ai)
#pragma unroll
                for (int bj = 0; bj < 2; ++bj) sl[((((ai * 2 + wr) * 4 + wc) * 2 + bj) * 2 + (fr - 14)) * 4 + fq] = acc[ai][bj][3][0];
        }
        asm volatile("s_waitcnt lgkmcnt(0)" ::: "memory"); __builtin_amdgcn_s_barrier(); asm volatile("" ::: "memory");
#pragma unroll
        for (int bj = 0; bj < 2; ++bj) {
            const int cbase = u.pn * 128 + bj * 64 + wc * 16 + fq * 4;
            u32x2 wq0, wq1, wq2, wqb;
            { const f32x4 t0 = *(const GAS f32x4*)(cw + cbase), t1 = *(const GAS f32x4*)(cw + FF + cbase), t2 = *(const GAS f32x4*)(cw + 2 * FF + cbase), tb = *(const GAS f32x4*)(cb + cbase);
              wq0 = pack4(t0); wq1 = pack4(t1); wq2 = pack4(t2); wqb = pack4(tb); }
#pragma unroll
            for (int ai = 0; ai < 2; ++ai) {
                asm volatile("" ::: "memory");
                f32x4 H = {0.f, 0.f, 0.f, 0.f};
                if ((ai | wr) != 0 && fr >= 14) { const int sai = wr ? ai : ai - 1, swr = wr ? 0 : 1; H = sl[((((sai * 2 + swr) * 4 + wc) * 2 + bj) * 2 + (fr - 14)) * 4 + fq]; }
                f32x4 uprev = H;
#pragma unroll
                for (int m = 0; m < 4; ++m) {
                    asm volatile("" ::: "memory");
                    const int row_l = ai * 128 + wr * 64 + m * 16 + fr, grow = r_lo + row_l;
                    const f32x4 uu = acc[ai][bj][m][0], up = acc[ai][bj][m][1];
                    f32x4 p1, p2;
#pragma unroll
                    for (int i = 0; i < 4; ++i) { p1[i] = dpp_shr1(dpp_ror1(uprev[i]), uu[i]); p2[i] = dpp_shr2(dpp_ror2(uprev[i]), uu[i]); }
                    if (has_start) {
                        const bool samp = grow >= MP;
                        const int sp = samp ? ((grow - MP) & 31) : (grow & (SEQ - 1));
                        if (grow >= 0 && grow < M && sp < 2) {
                            f32x4 h0 = {0.f, 0.f, 0.f, 0.f}, h1 = {0.f, 0.f, 0.f, 0.f};
                            if (samp) { const int sbb = (grow - MP) >> 5; h0 = *(const GAS f32x4*)(st + (size_t)(sbb * 2 + 0) * FF + cbase); h1 = *(const GAS f32x4*)(st + (size_t)(sbb * 2 + 1) * FF + cbase); }
                            if (sp == 0) { p1 = h1; p2 = h0; } else { p2 = h1; }
                        }
                    }
                    f32x4 gs = (f32x4){bflo(wqb.x), bfhi(wqb.x), bflo(wqb.y), bfhi(wqb.y)} + (f32x4){bflo(wq2.x), bfhi(wq2.x), bflo(wq2.y), bfhi(wq2.y)} * uu;
                    gs += (f32x4){bflo(wq1.x), bfhi(wq1.x), bflo(wq1.y), bfhi(wq1.y)} * p1;
                    gs += (f32x4){bflo(wq0.x), bfhi(wq0.x), bflo(wq0.y), bfhi(wq0.y)} * p2;
                    f32x4 act;
#pragma unroll
                    for (int i = 0; i < 4; ++i) act[i] = gs[i] * __builtin_amdgcn_rcpf(1.f + __expf(-gs[i])) * up[i];
                    if (row_l >= 2 && grow < M) {
                        *(GAS u32x2*)(ACT + (size_t)grow * FF + cbase) = pack4(act);
                        float* trow = nullptr;
                        if (grow < MP) { const int s_ = grow & (SEQ - 1); if (s_ >= SEQ - 2) trow = tap_p + (size_t)((grow >> 14) * 2 + (s_ - (SEQ - 2))) * FF; }
                        else { const int t_ = (grow - MP) & 31; if (t_ >= 30) trow = tap_s + (size_t)(((grow - MP) >> 5) * 2 + (t_ - 30)) * FF; }
                        if (trow) *(GAS f32x4*)(trow + cbase) = uu;
                    }
                    uprev = uu;
                }
            }
        }
    }
};
struct EpiQKV {
    const float* ssq; const float* rope; bf16_t* Q; bf16_t* Kb; bf16_t* Vb; bf16_t* Ks; bf16_t* Vs; float* okp; float* ovp; float* oks; float* ovs;
    __device__ __forceinline__ void operator()(const Acc& acc, const Unit& u, int wr, int wc, int fr, int fq) const {
        const int part = u.pn >> 2;
#pragma unroll
        for (int ai = 0; ai < 2; ++ai)
#pragma unroll
            for (int m = 0; m < 4; ++m) {
                asm volatile("" ::: "memory");
                const int row = u.pm * 256 + ai * 128 + wr * 64 + m * 16 + fr;
                const float rs = rstd_row(ssq, row);
                const bool samp = row >= MP;
                const int sr_ = row - MP, sbb = sr_ >> 5, tt = sr_ & 31;
                const int pos = samp ? PAST + tt : (row & (SEQ - 1));
                const size_t crow = (size_t)(sbb * NKSP + PAST + tt);
                if (part < 2) {
                    const int w = wc & 1, d0 = 16 * w + 4 * fq;
                    const f32x4 cs = *(const GAS f32x4*)(rope + (size_t)pos * 64 + d0), sn = *(const GAS f32x4*)(rope + (size_t)pos * 64 + 32 + d0);
#pragma unroll
                    for (int bj = 0; bj < 2; ++bj) {
                        const int lc = ((u.pn & 3) * 256 + bj * 128 + (wc >> 1) * 64) + d0;
                        const f32x4 x1 = acc[ai][bj][m][0] * rs, x2 = acc[ai][bj][m][1] * rs;
                        const f32x4 y1 = x1 * cs - x2 * sn, y2 = x2 * cs + x1 * sn;
                        if (part == 0) {
                            *(GAS u32x2*)(Q + (size_t)row * D + lc) = pack4(y1); *(GAS u32x2*)(Q + (size_t)row * D + lc + 32) = pack4(y2);
                        } else if (!samp) {
                            *(GAS u32x2*)(Kb + (size_t)row * D + lc) = pack4(y1); *(GAS u32x2*)(Kb + (size_t)row * D + lc + 32) = pack4(y2);
                            NT_ST4(okp + (size_t)row * D + lc, y1); NT_ST4(okp + (size_t)row * D + lc + 32, y2);
                        } else {
                            *(GAS u32x2*)(Ks + crow * D + lc) = pack4(y1); *(GAS u32x2*)(Ks + crow * D + lc + 32) = pack4(y2);
                            NT_ST4(oks + (size_t)sr_ * D + lc, y1); NT_ST4(oks + (size_t)sr_ * D + lc + 32, y2);
                        }
                    }
                } else {
#pragma unroll
                    for (int bj = 0; bj < 2; ++bj) {
                        const int lc = (u.pn & 3) * 256 + bj * 128 + wc * 32 + fq * 8;
                        const f32x4 v0 = acc[ai][bj][m][0] * rs, v1 = acc[ai][bj][m][1] * rs;
                        if (!samp) {
                            *(GAS u32x4*)(Vb + (size_t)row * D + lc) = pack8(v0, v1);
                            NT_ST4(ovp + (size_t)row * D + lc, v0); NT_ST4(ovp + (size_t)row * D + lc + 4, v1);
                        } else {
                            *(GAS u32x4*)(Vs + crow * D + lc) = pack8(v0, v1);
                            NT_ST4(ovs + (size_t)sr_ * D + lc, v0); NT_ST4(ovs + (size_t)sr_ * D + lc + 4, v1);
                        }
                    }
                }
            }
    }
};
struct EpiUQ {
    const float* rope; bf16_t* QB;
    __device__ __forceinline__ void operator()(const Acc& acc, const Unit& u, int wr, int wc, int fr, int fq) const {
#pragma unroll
        for (int ai = 0; ai < 2; ++ai)
#pragma unroll
            for (int m = 0; m < 4; ++m) {
                asm volatile("" ::: "memory");
                const int row = u.pm * 256 + ai * 128 + wr * 64 + m * 16 + fr;
                const int pos = row >= MP ? PAST + ((row - MP) & 31) : (row & (SEQ - 1));
#pragma unroll
                for (int bj = 0; bj < 2; ++bj) {
                    const int G = u.pn * 4 + bj * 2 + (wc >> 1);
                    if (G % 3 == 2) {
                        const int d0 = 16 * (wc & 1) + 4 * fq, lc = G * 64 + d0;
                        const f32x4 cs = *(const GAS f32x4*)(rope + (size_t)pos * 64 + d0), sn = *(const GAS f32x4*)(rope + (size_t)pos * 64 + 32 + d0);
                        const f32x4 x1 = acc[ai][bj][m][0], x2 = acc[ai][bj][m][1];
                        *(GAS u32x2*)(QB + (size_t)row * 1536 + lc) = pack4(x1 * cs - x2 * sn); *(GAS u32x2*)(QB + (size_t)row * 1536 + lc + 32) = pack4(x2 * cs + x1 * sn);
                    } else {
                        const int lc = u.pn * 256 + bj * 128 + wc * 32 + fq * 8;
                        *(GAS u32x4*)(QB + (size_t)row * 1536 + lc) = pack8(acc[ai][bj][m][0], acc[ai][bj][m][1]);
                    }
                }
            }
    }
};
struct EpiExpand {
    bf16_t* KN; bf16_t* VB; bf16_t* KsN; bf16_t* VsB;
    __device__ __forceinline__ void operator()(const Acc& acc, const Unit& u, int wr, int wc, int fr, int fq) const {
        const bool isk = u.pn < 4;
        bf16_t* const pbase = isk ? KN : VB; bf16_t* const sbase = isk ? KsN : VsB;
#pragma unroll
        for (int ai = 0; ai < 2; ++ai)
#pragma unroll
            for (int m = 0; m < 4; ++m) {
                asm volatile("" ::: "memory");
                const int row = u.pm * 256 + ai * 128 + wr * 64 + m * 16 + fr;
                int cr = row;
                if (row >= M) { const int s = row - M; cr = (s >> 10) * NKSP + (s & 1023); }
                else if (row >= MP) { const int s = row - MP; cr = (s >> 5) * NKSP + PAST + (s & 31); }
                bf16_t* dst = (row < MP ? pbase : sbase) + (size_t)cr * D;
#pragma unroll
                for (int bj = 0; bj < 2; ++bj) {
                    const int lc = (u.pn & 3) * 256 + bj * 128 + wc * 32 + fq * 8;
                    *(GAS u32x4*)(dst + lc) = pack8(acc[ai][bj][m][0], acc[ai][bj][m][1]);
                }
            }
    }
};

__device__ __forceinline__ void prep_w(LAS float* tile, const float* __restrict__ W, int ldw, int K, int nsrc, bf16_t* __restrict__ Bt, int nrows,
                                       int ropemode, int ropeG, const float* __restrict__ ks, int kper, float kmul, const float* __restrict__ ns, int rank = -1, int nwork = 0) {
    if (rank < 0) { rank = blockIdx.x; nwork = gridDim.x; }
    int tid = threadIdx.x; asm volatile("" : "+v"(tid));
    const int nkt = K / 64, nnt = nrows / 64;
    for (int t = rank; t < nkt * nnt; t += nwork) {
        const int kt = t % nkt, ntl = t / nkt, k0 = kt * 64, n0 = ntl * 64;
        {
            const int kk = tid >> 3, c8 = (tid & 7) * 8;
            f32x4 a = {0.f, 0.f, 0.f, 0.f}, b = {0.f, 0.f, 0.f, 0.f};
            if (n0 < nsrc) {
                a = *(const GAS f32x4*)(W + (size_t)(k0 + kk) * ldw + n0 + c8); b = *(const GAS f32x4*)(W + (size_t)(k0 + kk) * ldw + n0 + c8 + 4);
                float sc = kmul; if (ks) sc *= ks[(k0 + kk) % kper];
                a = a * sc; b = b * sc;
                if (ns) { a = a * *(const GAS f32x4*)(ns + n0 + c8); b = b * *(const GAS f32x4*)(ns + n0 + c8 + 4); }
            }
            LAS float* tp = tile + kk * 65 + c8;
            tp[0] = a[0]; tp[1] = a[1]; tp[2] = a[2]; tp[3] = a[3]; tp[4] = b[0]; tp[5] = b[1]; tp[6] = b[2]; tp[7] = b[3];
        }
        __syncthreads();
        {
            const int nl = tid >> 3, kc = (tid & 7) * 8, G = n0 >> 6;
            const bool rp = (ropemode == 1) ? (G < ropeG) : (ropemode == 3 ? (G % 3 == 2) : false);
            const int hi32 = nl >> 5, n = (nl >> 4) & 1, fq = (nl >> 2) & 3, i = nl & 3;
            const int sl = rp ? (32 * n + 16 * hi32 + 4 * fq + i) : (32 * hi32 + 8 * fq + 4 * n + i);
            float v[8];
#pragma unroll
            for (int j = 0; j < 8; ++j) v[j] = tile[(kc + j) * 65 + sl];
            u32x4 w; w.x = cvt_pk(v[0], v[1]); w.y = cvt_pk(v[2], v[3]); w.z = cvt_pk(v[4], v[5]); w.w = cvt_pk(v[6], v[7]);
            *(GAS u32x4*)(Bt + (size_t)(n0 + nl) * K + k0 + kc) = w;
        }
        __syncthreads();
    }
}


__device__ __forceinline__ void prep_gu(LAS float* tile, const float* __restrict__ Wg, const float* __restrict__ Wu, bf16_t* __restrict__ Bt, const float* __restrict__ ks, int rank = -1, int nwork = 0) {
    if (rank < 0) { rank = blockIdx.x; nwork = gridDim.x; }
    int tid = threadIdx.x; asm volatile("" : "+v"(tid));
    constexpr int K = D, nkt = K / 64, nnt = 2 * FF / 64;
    for (int t = rank; t < nkt * nnt; t += nwork) {
        const int kt = t % nkt, ntl = t / nkt, k0 = kt * 64, n0 = ntl * 64, cb0 = (n0 >> 5) * 16;
        {
            const int kk = tid >> 3, c8 = (tid & 7) * 8;
            const float* src = (c8 < 32 ? Wg + cb0 + c8 : Wu + cb0 + (c8 - 32)) + (size_t)(k0 + kk) * FF;
            f32x4 a = *(const GAS f32x4*)src, b = *(const GAS f32x4*)(src + 4);
            const float sc = ks[k0 + kk]; a = a * sc; b = b * sc;
            LAS float* tp = tile + kk * 65 + c8;
            tp[0] = a[0]; tp[1] = a[1]; tp[2] = a[2]; tp[3] = a[3]; tp[4] = b[0]; tp[5] = b[1]; tp[6] = b[2]; tp[7] = b[3];
        }
        __syncthreads();
        {
            const int nl = tid >> 3, kc = (tid & 7) * 8;
            const int sl = ((nl >> 4) & 1) * 32 + (nl >> 5) * 16 + (nl & 15);
            float v[8];
#pragma unroll
            for (int j = 0; j < 8; ++j) v[j] = tile[(kc + j) * 65 + sl];
            u32x4 w; w.x = cvt_pk(v[0], v[1]); w.y = cvt_pk(v[2], v[3]); w.z = cvt_pk(v[4], v[5]); w.w = cvt_pk(v[6], v[7]);
            *(GAS u32x4*)(Bt + (size_t)(n0 + nl) * K + k0 + kc) = w;
        }
        __syncthreads();
    }
}
__device__ __forceinline__ int crow(int r, int hi) { return (r & 3) + 8 * (r >> 2) + 4 * hi; }
#define SBAR() __builtin_amdgcn_sched_barrier(0)
__device__ __forceinline__ void partialSM(f32x16& p0, f32x16& p1, float& m_reg, float& mn, float& alpha, const float C, const float thr_raw) {
    float pmax = p0[0];
#pragma unroll
    for (int r = 1; r < 16; ++r) pmax = fmaxf(pmax, p0[r]);
#pragma unroll
    for (int r = 0; r < 16; ++r) pmax = fmaxf(pmax, p1[r]);
    { auto rr = __builtin_amdgcn_permlane32_swap(__float_as_uint(pmax), __float_as_uint(pmax), false, false);
      pmax = fmaxf(__uint_as_float(rr[0]), __uint_as_float(rr[1])); }
    if (__builtin_expect(__all(pmax - m_reg <= thr_raw), 1)) { mn = m_reg; alpha = 1.f; }
    else { mn = fmaxf(m_reg, pmax); alpha = __builtin_amdgcn_exp2f((m_reg - mn) * C); m_reg = mn; }
    const float mnC = -mn * C;
#pragma unroll
    for (int r = 0; r < 16; ++r) p0[r] = __builtin_amdgcn_exp2f(fmaf(p0[r], C, mnC));
#pragma unroll
    for (int r = 0; r < 16; ++r) p1[r] = __builtin_amdgcn_exp2f(fmaf(p1[r], C, mnC));
}
__device__ __forceinline__ void finishSM(f32x16& p0, f32x16& p1, float alpha, float& l_reg, bf16x8& pa0, bf16x8& pa1, bf16x8& pa2, bf16x8& pa3) {
    float ps = 0;
#pragma unroll
    for (int r = 0; r < 16; ++r) ps += p0[r];
#pragma unroll
    for (int r = 0; r < 16; ++r) ps += p1[r];
    { auto rr = __builtin_amdgcn_permlane32_swap(__float_as_uint(ps), __float_as_uint(ps), false, false);
      ps = __uint_as_float(rr[0]) + __uint_as_float(rr[1]); }
    l_reg = l_reg * alpha + ps;
#define PK4(P, BASE, OUT) do { unsigned a0 = cvt_pk(P[BASE + 0], P[BASE + 1]), a1 = cvt_pk(P[BASE + 2], P[BASE + 3]);   \
    unsigned b0 = cvt_pk(P[BASE + 4], P[BASE + 5]), b1 = cvt_pk(P[BASE + 6], P[BASE + 7]);                              \
    auto r0 = __builtin_amdgcn_permlane32_swap(a0, b0, false, false); auto r1 = __builtin_amdgcn_permlane32_swap(a1, b1, false, false); \
    u32x4 w = {r0[0], r1[0], r0[1], r1[1]}; OUT = *reinterpret_cast<bf16x8*>(&w); } while (0)
    PK4(p0, 0, pa0); PK4(p0, 8, pa1); PK4(p1, 0, pa2); PK4(p1, 8, pa3);
#undef PK4
}
__device__ __forceinline__ int v_st(int k, int c) { const int kk = (k & ~0xC) | ((k & 4) << 1) | ((k & 8) >> 1); return ((kk >> 3) * 4 + (c >> 5)) * 512 + ((kk & 7) * 32 + (c & 31)) * 2; }
__device__ __forceinline__ int v_rd_base(int lane) { return ((lane & 3) << 3) | (((lane >> 2) & 3) << 6) | (((lane >> 4) & 1) << 5) | (((lane >> 5) & 1) << 8); }
constexpr int v_rd_off(int d0, int ks, int half) { return d0 * 512 + ks * 4096 + half * 2048; }
template <int OFF> __device__ __forceinline__ s16x4 tr_read(unsigned vb) {
    s16x4 r; asm volatile("ds_read_b64_tr_b16 %0, %1 offset:%2" : "=&v"(r) : "v"(vb), "i"(OFF) : "memory"); return r;
}
template <int D0> __device__ __forceinline__ void pv_one(f32x16& od, unsigned vb, bf16x8 pa0, bf16x8 pa1, bf16x8 pa2, bf16x8 pa3) {
    const s16x4 l0 = tr_read<v_rd_off(D0, 0, 0)>(vb), h0 = tr_read<v_rd_off(D0, 0, 1)>(vb), l1 = tr_read<v_rd_off(D0, 1, 0)>(vb), h1 = tr_read<v_rd_off(D0, 1, 1)>(vb);
    const s16x4 l2 = tr_read<v_rd_off(D0, 2, 0)>(vb), h2 = tr_read<v_rd_off(D0, 2, 1)>(vb), l3 = tr_read<v_rd_off(D0, 3, 0)>(vb), h3 = tr_read<v_rd_off(D0, 3, 1)>(vb);
    asm volatile("s_waitcnt lgkmcnt(0)" ::: "memory"); SBAR();
#define PKV(L, H) (bf16x8){L[0], L[1], L[2], L[3], H[0], H[1], H[2], H[3]}
    od = __builtin_amdgcn_mfma_f32_32x32x16_bf16(pa0, PKV(l0, h0), od, 0, 0, 0);
    od = __builtin_amdgcn_mfma_f32_32x32x16_bf16(pa1, PKV(l1, h1), od, 0, 0, 0);
    od = __builtin_amdgcn_mfma_f32_32x32x16_bf16(pa2, PKV(l2, h2), od, 0, 0, 0);
    od = __builtin_amdgcn_mfma_f32_32x32x16_bf16(pa3, PKV(l3, h3), od, 0, 0, 0);
#undef PKV
}

__device__ __forceinline__ void partialSM2(f32x16& p0, f32x16& p1, float& m_reg, float& alpha, const float C, const float thr_raw) {
    float pmax = p0[0];
#pragma unroll
    for (int r = 1; r < 16; ++r) pmax = fmaxf(pmax, p0[r]);
#pragma unroll
    for (int r = 0; r < 16; ++r) pmax = fmaxf(pmax, p1[r]);
    { auto rr = __builtin_amdgcn_permlane32_swap(__float_as_uint(pmax), __float_as_uint(pmax), false, false);
      pmax = fmaxf(__uint_as_float(rr[0]), __uint_as_float(rr[1])); }
    float mn;
    if (__builtin_expect(__all(pmax - m_reg <= thr_raw), 1)) { mn = m_reg; alpha = 1.f; }
    else { mn = fmaxf(m_reg, pmax); alpha = __builtin_amdgcn_exp2f((m_reg - mn) * C); m_reg = mn; }
    const float mnC = -mn * C;
    typedef float f32x2 __attribute__((ext_vector_type(2)));
    const f32x2 C2 = {C, C}, M2 = {mnC, mnC};
#pragma unroll
    for (int r = 0; r < 16; r += 2) { f32x2 t = {p0[r], p0[r + 1]}; t = __builtin_elementwise_fma(t, C2, M2); p0[r] = t.x; p0[r + 1] = t.y; }
#pragma unroll
    for (int r = 0; r < 16; r += 2) { f32x2 t = {p1[r], p1[r + 1]}; t = __builtin_elementwise_fma(t, C2, M2); p1[r] = t.x; p1[r + 1] = t.y; }
#pragma unroll
    for (int r = 0; r < 16; ++r) p0[r] = __builtin_amdgcn_exp2f(p0[r]);
}
__device__ __forceinline__ void finishSM2(f32x16& p0, f32x16& p1, float alpha, float& l_reg, bf16x8& pa0, bf16x8& pa1, bf16x8& pa2, bf16x8& pa3) {
#pragma unroll
    for (int r = 0; r < 16; ++r) p1[r] = __builtin_amdgcn_exp2f(p1[r]);
    typedef float f32x2 __attribute__((ext_vector_type(2)));
    f32x2 s2 = {0.f, 0.f};
#pragma unroll
    for (int r = 0; r < 16; r += 2) { const f32x2 t = {p0[r], p0[r + 1]}; s2 += t; }
#pragma unroll
    for (int r = 0; r < 16; r += 2) { const f32x2 t = {p1[r], p1[r + 1]}; s2 += t; }
    float ps = s2.x + s2.y;
    { auto rr = __builtin_amdgcn_permlane32_swap(__float_as_uint(ps), __float_as_uint(ps), false, false);
      ps = __uint_as_float(rr[0]) + __uint_as_float(rr[1]); }
    l_reg = l_reg * alpha + ps;
#define PK4(P, BASE, OUT) do { unsigned a0 = cvt_pk(P[BASE + 0], P[BASE + 1]), a1 = cvt_pk(P[BASE + 2], P[BASE + 3]);   \
    unsigned b0 = cvt_pk(P[BASE + 4], P[BASE + 5]), b1 = cvt_pk(P[BASE + 6], P[BASE + 7]);                              \
    auto r0 = __builtin_amdgcn_permlane32_swap(a0, b0, false, false); auto r1 = __builtin_amdgcn_permlane32_swap(a1, b1, false, false); \
    u32x4 w = {r0[0], r1[0], r0[1], r1[1]}; OUT = *reinterpret_cast<bf16x8*>(&w); } while (0)
    PK4(p0, 0, pa0); PK4(p0, 8, pa1); PK4(p1, 0, pa2); PK4(p1, 8, pa3);
#undef PK4
}
template <int DQK>
__device__ __forceinline__ void attn_unit(const bf16_t* __restrict__ Qp, int ldq, const bf16_t* __restrict__ Kp, int ldk, const bf16_t* __restrict__ Kr,
                                          const bf16_t* __restrict__ Vp, int ldv, const int NT, const int nkw, LAS unsigned char* lds, f32x16 (&o)[4], float scale) {
    constexpr int ND = DQK / 16, KCH = DQK / 64, KRB = DQK * 2, KTB = 64 * KRB, CPR = DQK / 8;
    int tid = threadIdx.x; asm volatile("" : "+v"(tid));
    const int wid = tid >> 6, lane = tid & 63, r32 = lane & 31, hi = lane >> 5;
    LAS unsigned char* Vl = lds; LAS unsigned char* Kl = lds + 32768; LAS float* wsc = (LAS float*)(lds + 32768 + 49152) + wid * 64;
    const float C = scale * 1.4426950408889634f, thr_raw = 8.0f / scale;
    bf16x8 qr[ND];
    {
        const bf16_t* qw = Qp + (size_t)(wid * 32 + r32) * ldq + hi * 8;
#pragma unroll
        for (int d0 = 0; d0 < ND; ++d0) qr[d0] = *(const GAS bf16x8*)(qw + d0 * 16);
    }
    const bf16_t* kp[KCH]; unsigned kl[KCH]; int kst[KCH];
#pragma unroll
    for (int i = 0; i < KCH; ++i) {
        const int q = tid + i * 512, row = q / CPR, cc = q % CPR;
        if (DQK == 192 && cc >= 16) { kp[i] = Kr + (size_t)row * 64 + (cc - 16) * 8; kst[i] = 64 * 64; }
        else { kp[i] = Kp + (size_t)row * ldk + cc * 8; kst[i] = 64 * ldk; }
        kl[i] = (unsigned)(row * KRB + ((cc ^ ((row >> 1) & 7)) << 4));
    }
    const int sr = tid >> 4, sc = (tid & 15) * 8;
    const bf16_t* vp0 = Vp + (size_t)sr * ldv + sc; const bf16_t* vp1 = vp0 + (size_t)32 * ldv; const int vstp = 64 * ldv;
    const int vs0 = v_st(sr, sc), vs1 = v_st(32 + sr, sc);
    const unsigned vbase = (unsigned)(uintptr_t)Vl + (unsigned)v_rd_base(lane);
    const unsigned sw = (unsigned)((r32 >> 1) & 7);
    u32x4 kreg[KCH], vreg0, vreg1;
#define A_SLOAD() do { _Pragma("unroll") for (int i = 0; i < KCH; ++i) { kreg[i] = *(const GAS u32x4*)kp[i]; kp[i] += kst[i]; } \
        vreg0 = *(const GAS u32x4*)vp0; vreg1 = *(const GAS u32x4*)vp1; vp0 += vstp; vp1 += vstp; } while (0)
#define A_SWRITE(b) do { LAS unsigned char* Kn_ = Kl + (b) * KTB; LAS unsigned char* Vn_ = Vl + (b) * 16384; \
        _Pragma("unroll") for (int i = 0; i < KCH; ++i) *(LAS u32x4*)(Kn_ + kl[i]) = kreg[i]; \
        *(LAS u32x4*)(Vn_ + vs0) = vreg0; *(LAS u32x4*)(Vn_ + vs1) = vreg1; } while (0)
#define A_QKT(P0, P1, b) do { LAS unsigned char* Kc_ = Kl + (b) * KTB; \
        _Pragma("unroll") for (int r = 0; r < 16; ++r) { P0[r] = 0.f; P1[r] = 0.f; } \
        _Pragma("unroll") for (int d0 = 0; d0 < ND; ++d0) { const unsigned off_ = (unsigned)(r32 * KRB) + ((((unsigned)(d0 * 2 + hi)) ^ sw) << 4); \
            const bf16x8 b0_ = *(const LAS bf16x8*)(Kc_ + off_); const bf16x8 b1_ = *(const LAS bf16x8*)(Kc_ + off_ + 32 * KRB); \
            P0 = __builtin_amdgcn_mfma_f32_32x32x16_bf16(b0_, qr[d0], P0, 0, 0, 0); P1 = __builtin_amdgcn_mfma_f32_32x32x16_bf16(b1_, qr[d0], P1, 0, 0, 0); } } while (0)
#define A_MASK(P0, P1, j) do { if (((j) + 1) * 64 > nkw) { asm volatile("" ::: "memory"); _Pragma("unroll") for (int r = 0; r < 16; ++r) { const int kb_ = (j) * 64 + crow(r, hi); \
        if (kb_ >= nkw) P0[r] = -1e30f; if (kb_ + 32 >= nkw) P1[r] = -1e30f; } } } while (0)
#define A_RESC(al) do { if (__any((al) < 1.f)) { if (hi == 0) wsc[r32] = (al); asm volatile("s_waitcnt lgkmcnt(0)" ::: "memory"); \
        _Pragma("unroll") for (int r = 0; r < 16; ++r) { const float al_ = wsc[crow(r, hi)]; _Pragma("unroll") for (int d = 0; d < 4; ++d) o[d][r] *= al_; } } } while (0)
#define A_PV(b) do { const unsigned vb_ = vbase + (unsigned)((b) * 16384); \
        pv_one<0>(o[0], vb_, pa0, pa1, pa2, pa3); pv_one<1>(o[1], vb_, pa0, pa1, pa2, pa3); pv_one<2>(o[2], vb_, pa0, pa1, pa2, pa3); pv_one<3>(o[3], vb_, pa0, pa1, pa2, pa3); } while (0)
    float m_reg = -1e30f, l_reg = 0.f;
#pragma unroll
    for (int d = 0; d < 4; ++d)
#pragma unroll
        for (int r = 0; r < 16; ++r) o[d][r] = 0.f;
    f32x16 pA0, pA1, pB0, pB1; float alA, alB; bf16x8 pa0, pa1, pa2, pa3;
    A_SLOAD(); A_SWRITE(0); __syncthreads();
    A_QKT(pA0, pA1, 0); A_MASK(pA0, pA1, 0); partialSM2(pA0, pA1, m_reg, alA, C, thr_raw);
    A_SLOAD(); A_SWRITE(1); __syncthreads();
#pragma unroll 1
    for (int j = 1; j + 1 < NT; j += 2) {
        SBAR(); A_QKT(pB0, pB1, 1);
        finishSM2(pA0, pA1, alA, l_reg, pa0, pa1, pa2, pa3); SBAR();
        A_SLOAD(); SBAR();
        A_PV(0); A_MASK(pB0, pB1, j); partialSM2(pB0, pB1, m_reg, alB, C, thr_raw);
        __syncthreads(); A_SWRITE(0);
        A_RESC(alB); __syncthreads();
        SBAR(); A_QKT(pA0, pA1, 0);
        finishSM2(pB0, pB1, alB, l_reg, pa0, pa1, pa2, pa3); SBAR();
        A_SLOAD(); SBAR();
        A_PV(1); A_MASK(pA0, pA1, j + 1); partialSM2(pA0, pA1, m_reg, alA, C, thr_raw);
        __syncthreads(); A_SWRITE(1);
        A_RESC(alA); __syncthreads();
    }
    SBAR(); A_QKT(pB0, pB1, 1);
    finishSM2(pA0, pA1, alA, l_reg, pa0, pa1, pa2, pa3); SBAR();
    A_PV(0); A_MASK(pB0, pB1, NT - 1); partialSM2(pB0, pB1, m_reg, alB, C, thr_raw);
    A_RESC(alB);
    finishSM2(pB0, pB1, alB, l_reg, pa0, pa1, pa2, pa3); SBAR();
    A_PV(1);
    __syncthreads();
    {
        if (hi == 0) wsc[32 + r32] = l_reg;
        asm volatile("s_waitcnt lgkmcnt(0)" ::: "memory");
#pragma unroll
        for (int r = 0; r < 16; ++r) { const float rl = __builtin_amdgcn_rcpf(wsc[32 + crow(r, hi)]);
#pragma unroll
            for (int d = 0; d < 4; ++d) o[d][r] *= rl; }
    }
#undef A_SLOAD
#undef A_SWRITE
#undef A_QKT
#undef A_MASK
#undef A_RESC
#undef A_PV
}

template <int DQK>
__device__ __forceinline__ void attn_unit_np(const bf16_t* __restrict__ Qp, int ldq, const bf16_t* __restrict__ Kp, int ldk, const bf16_t* __restrict__ Kr,
                                          const bf16_t* __restrict__ Vp, int ldv, int NT, int lim, int nkeys, LAS unsigned char* lds, f32x16 (&o)[4], float scale) {
    constexpr int ND = DQK / 16, KCH = DQK / 64, KRB = DQK * 2, KTB = 64 * KRB, CPR = DQK / 8;
    int tid = threadIdx.x; asm volatile("" : "+v"(tid));
    const int wid = tid >> 6, lane = tid & 63, r32 = lane & 31, hi = lane >> 5;
    LAS unsigned char* Vl = lds; LAS unsigned char* Kl = lds + 32768; LAS float* wsc = (LAS float*)(lds + 32768 + 49152) + wid * 64;
    const float C = scale * 1.4426950408889634f, thr_raw = 8.0f / scale;
    bf16x8 qr[ND];
    if (lim >= 0) {
        const bf16_t* qw = Qp + (size_t)(wid * 32 + r32) * ldq + hi * 8;
#pragma unroll
        for (int d0 = 0; d0 < ND; ++d0) qr[d0] = *(const GAS bf16x8*)(qw + d0 * 16);
    } else {
#pragma unroll
        for (int d0 = 0; d0 < ND; ++d0) qr[d0] = (bf16x8){0, 0, 0, 0, 0, 0, 0, 0};
    }
    const bf16_t* kp[KCH]; unsigned kl[KCH]; int kst[KCH];
#pragma unroll
    for (int i = 0; i < KCH; ++i) {
        const int q = tid + i * 512, row = q / CPR, cc = q % CPR;
        if (DQK == 192 && cc >= 16) { kp[i] = Kr + (size_t)row * 64 + (cc - 16) * 8; kst[i] = 64 * 64; }
        else { kp[i] = Kp + (size_t)row * ldk + cc * 8; kst[i] = 64 * ldk; }
        kl[i] = (unsigned)(row * KRB + ((cc ^ ((row >> 1) & 7)) << 4));
    }
    const int sr = tid >> 4, sc = (tid & 15) * 8;
    const bf16_t* vp0 = Vp + (size_t)sr * ldv + sc; const bf16_t* vp1 = vp0 + (size_t)32 * ldv; const int vstp = 64 * ldv;
    const int vs0 = v_st(sr, sc), vs1 = v_st(32 + sr, sc);
    const unsigned vbase = (unsigned)(uintptr_t)Vl + (unsigned)v_rd_base(lane);
    u32x4 kreg[KCH], vreg0, vreg1;
#pragma unroll
    for (int i = 0; i < KCH; ++i) { kreg[i] = *(const GAS u32x4*)kp[i]; kp[i] += kst[i]; }
    vreg0 = *(const GAS u32x4*)vp0; vreg1 = *(const GAS u32x4*)vp1; vp0 += vstp; vp1 += vstp;
#pragma unroll
    for (int i = 0; i < KCH; ++i) *(LAS u32x4*)(Kl + kl[i]) = kreg[i];
    *(LAS u32x4*)(Vl + vs0) = vreg0; *(LAS u32x4*)(Vl + vs1) = vreg1;
    __syncthreads();
    float m_reg = -1e30f, l_reg = 0.f;
#pragma unroll
    for (int d = 0; d < 4; ++d)
#pragma unroll
        for (int r = 0; r < 16; ++r) o[d][r] = 0.f;
    const unsigned sw = (unsigned)((r32 >> 1) & 7);
    for (int j = 0; j < NT; ++j) {
        const int cur = j & 1;
        const bool more = (j + 1 < NT);
        if (more) {
#pragma unroll
            for (int i = 0; i < KCH; ++i) { kreg[i] = *(const GAS u32x4*)kp[i]; kp[i] += kst[i]; }
            vreg0 = *(const GAS u32x4*)vp0; vreg1 = *(const GAS u32x4*)vp1; vp0 += vstp; vp1 += vstp;
        }
        if (j <= lim) {
            f32x16 p0, p1;
#pragma unroll
            for (int r = 0; r < 16; ++r) { p0[r] = 0.f; p1[r] = 0.f; }
            LAS unsigned char* Kc = Kl + cur * KTB;
#define NP_KOFF(d0) ((unsigned)(r32 * KRB) + ((((unsigned)((d0) * 2 + hi)) ^ sw) << 4))
            bf16x8 kb0[3], kb1[3];
            kb0[0] = *(const LAS bf16x8*)(Kc + NP_KOFF(0)); kb1[0] = *(const LAS bf16x8*)(Kc + NP_KOFF(0) + 32 * KRB);
            if (ND > 1) { kb0[1] = *(const LAS bf16x8*)(Kc + NP_KOFF(1)); kb1[1] = *(const LAS bf16x8*)(Kc + NP_KOFF(1) + 32 * KRB); }
#pragma unroll
            for (int d0 = 0; d0 < ND; ++d0) {
                if (d0 + 2 < ND) { kb0[(d0 + 2) % 3] = *(const LAS bf16x8*)(Kc + NP_KOFF(d0 + 2)); kb1[(d0 + 2) % 3] = *(const LAS bf16x8*)(Kc + NP_KOFF(d0 + 2) + 32 * KRB); }
                SBAR();
                p0 = __builtin_amdgcn_mfma_f32_32x32x16_bf16(kb0[d0 % 3], qr[d0], p0, 0, 0, 0);
                p1 = __builtin_amdgcn_mfma_f32_32x32x16_bf16(kb1[d0 % 3], qr[d0], p1, 0, 0, 0);
                SBAR();
            }
#undef NP_KOFF
            if (j == NT - 1 && nkeys < NT * 64) {
#pragma unroll
                for (int r = 0; r < 16; ++r) { const int kb = j * 64 + crow(r, hi); if (kb >= nkeys) p0[r] = -1e30f; if (kb + 32 >= nkeys) p1[r] = -1e30f; }
            }
            float mn, alpha; bf16x8 pa0, pa1, pa2, pa3;
            partialSM(p0, p1, m_reg, mn, alpha, C, thr_raw);
            finishSM(p0, p1, alpha, l_reg, pa0, pa1, pa2, pa3);
            if (__any(alpha < 1.f)) {
                if (hi == 0) wsc[r32] = alpha;
                asm volatile("s_waitcnt lgkmcnt(0)" ::: "memory");
#pragma unroll
                for (int r = 0; r < 16; ++r) { const float al = wsc[crow(r, hi)];
#pragma unroll
                    for (int d = 0; d < 4; ++d) o[d][r] *= al; }
            }
            const unsigned vb = vbase + (unsigned)(cur * 16384);
            pv_one<0>(o[0], vb, pa0, pa1, pa2, pa3); pv_one<1>(o[1], vb, pa0, pa1, pa2, pa3); pv_one<2>(o[2], vb, pa0, pa1, pa2, pa3); pv_one<3>(o[3], vb, pa0, pa1, pa2, pa3);
        }
        if (more) {
            LAS unsigned char* Kn = Kl + (cur ^ 1) * KTB; LAS unsigned char* Vn = Vl + (cur ^ 1) * 16384;
#pragma unroll
            for (int i = 0; i < KCH; ++i) *(LAS u32x4*)(Kn + kl[i]) = kreg[i];
            *(LAS u32x4*)(Vn + vs0) = vreg0; *(LAS u32x4*)(Vn + vs1) = vreg1;
        }
        __syncthreads();
    }
    if (lim >= 0) {
        if (hi == 0) wsc[32 + r32] = l_reg;
        asm volatile("s_waitcnt lgkmcnt(0)" ::: "memory");
#pragma unroll
        for (int r = 0; r < 16; ++r) { const float rl = __builtin_amdgcn_rcpf(wsc[32 + crow(r, hi)]);
#pragma unroll
            for (int d = 0; d < 4; ++d) o[d][r] *= rl; }
    }
}


template <int D0, int SUB> __device__ __forceinline__ void pv_one128(f32x16& od, unsigned vb, bf16x8 pa0, bf16x8 pa1, bf16x8 pa2, bf16x8 pa3) {
    constexpr int B = SUB * 16384;
    const s16x4 l0 = tr_read<B + v_rd_off(D0, 0, 0)>(vb), h0 = tr_read<B + v_rd_off(D0, 0, 1)>(vb), l1 = tr_read<B + v_rd_off(D0, 1, 0)>(vb), h1 = tr_read<B + v_rd_off(D0, 1, 1)>(vb);
    const s16x4 l2 = tr_read<B + v_rd_off(D0, 2, 0)>(vb), h2 = tr_read<B + v_rd_off(D0, 2, 1)>(vb), l3 = tr_read<B + v_rd_off(D0, 3, 0)>(vb), h3 = tr_read<B + v_rd_off(D0, 3, 1)>(vb);
    asm volatile("s_waitcnt lgkmcnt(0)" ::: "memory"); SBAR();
#define PKV(L, H) (bf16x8){L[0], L[1], L[2], L[3], H[0], H[1], H[2], H[3]}
    od = __builtin_amdgcn_mfma_f32_32x32x16_bf16(pa0, PKV(l0, h0), od, 0, 0, 0);
    od = __builtin_amdgcn_mfma_f32_32x32x16_bf16(pa1, PKV(l1, h1), od, 0, 0, 0);
    od = __builtin_amdgcn_mfma_f32_32x32x16_bf16(pa2, PKV(l2, h2), od, 0, 0, 0);
    od = __builtin_amdgcn_mfma_f32_32x32x16_bf16(pa3, PKV(l3, h3), od, 0, 0, 0);
#undef PKV
}
__device__ __forceinline__ void attn_unit_k128(const bf16_t* __restrict__ Qp, int ldq, const bf16_t* __restrict__ Kp, int ldk, const bf16_t* __restrict__ Vp, int ldv,
                                               const int NT, const int nkw, LAS unsigned char* lds, f32x16 (&o)[4], float scale) {
    constexpr int ND = 4, KRB = 128, KTB = 128 * KRB, VTB = 32768;
    int tid = threadIdx.x; asm volatile("" : "+v"(tid));
    const int wid = tid >> 6, lane = tid & 63, r32 = lane & 31, hi = lane >> 5;
    LAS unsigned char* Vl = lds; LAS unsigned char* Kl = lds + 2 * VTB; LAS float* wsc = (LAS float*)(lds + 2 * VTB + 2 * KTB) + wid * 64;
    const float C = scale * 1.4426950408889634f, thr_raw = 8.0f / scale;
    bf16x8 qr[ND];
    if (nkw > 0) {
        const bf16_t* qw = Qp + (size_t)(wid * 32 + r32) * ldq + hi * 8;
#pragma unroll
        for (int d0 = 0; d0 < ND; ++d0) qr[d0] = *(const GAS bf16x8*)(qw + d0 * 16);
    } else {
#pragma unroll
        for (int d0 = 0; d0 < ND; ++d0) qr[d0] = (bf16x8){0, 0, 0, 0, 0, 0, 0, 0};
    }
    const bf16_t* kp0; unsigned kl0;
    { const int row = tid >> 3, cc = tid & 7; kp0 = Kp + (size_t)row * ldk + cc * 8; kl0 = (unsigned)(row * KRB + ((cc ^ ((row >> 1) & 7)) << 4)); }
    const int sr = tid >> 4, sc = (tid & 15) * 8;
    const bf16_t* vp0 = Vp + (size_t)sr * ldv + sc; const unsigned vs0 = (unsigned)v_st(sr, sc);
    const long k64 = 64L * ldk, v32 = 32L * ldv;
    const int kstp = 128 * ldk, vstp = 128 * ldv;
#define K128_LOAD() do { kreg[0] = *(const GAS u32x4*)kp0; kreg[1] = *(const GAS u32x4*)(kp0 + k64); kp0 += kstp; \
        vreg[0] = *(const GAS u32x4*)vp0; vreg[1] = *(const GAS u32x4*)(vp0 + v32); vreg[2] = *(const GAS u32x4*)(vp0 + 2 * v32); vreg[3] = *(const GAS u32x4*)(vp0 + 3 * v32); vp0 += vstp; } while (0)
#define K128_WRITE(Kb_, Vb_) do { *(LAS u32x4*)((Kb_) + kl0) = kreg[0]; *(LAS u32x4*)((Kb_) + kl0 + 8192) = kreg[1]; \
        *(LAS u32x4*)((Vb_) + vs0) = vreg[0]; *(LAS u32x4*)((Vb_) + vs0 + 8192) = vreg[1]; *(LAS u32x4*)((Vb_) + vs0 + 16384) = vreg[2]; *(LAS u32x4*)((Vb_) + vs0 + 24576) = vreg[3]; } while (0)
    const unsigned vbase = (unsigned)(uintptr_t)Vl + (unsigned)v_rd_base(lane);
    const unsigned sw = (unsigned)((r32 >> 1) & 7);
    u32x4 kreg[2], vreg[4];
    K128_LOAD(); K128_WRITE(Kl, Vl);
    __syncthreads();
    float m_reg = -1e30f, l_reg = 0.f;
#pragma unroll
    for (int d = 0; d < 4; ++d)
#pragma unroll
        for (int r = 0; r < 16; ++r) o[d][r] = 0.f;
#pragma unroll 1
    for (int j = 0; j < NT; ++j) {
        const int cur = j & 1;
        const bool more = (j + 1 < NT);
        if (more) K128_LOAD();
        if (j * 128 < nkw) {
            f32x16 p[4];
#pragma unroll
            for (int k = 0; k < 4; ++k)
#pragma unroll
                for (int r = 0; r < 16; ++r) p[k][r] = 0.f;
            LAS unsigned char* Kc = Kl + cur * KTB;
#define K128_OFF(d0, k) ((unsigned)((32 * (k) + r32) * KRB) + ((((unsigned)((d0) * 2 + hi)) ^ sw) << 4))
            bf16x8 fa[4], fb[4];
#pragma unroll
            for (int k = 0; k < 4; ++k) fa[k] = *(const LAS bf16x8*)(Kc + K128_OFF(0, k));
#pragma unroll
            for (int k = 0; k < 4; ++k) fb[k] = *(const LAS bf16x8*)(Kc + K128_OFF(1, k));
            SBAR();
#pragma unroll
            for (int k = 0; k < 4; ++k) p[k] = __builtin_amdgcn_mfma_f32_32x32x16_bf16(fa[k], qr[0], p[k], 0, 0, 0);
            SBAR();
#pragma unroll
            for (int k = 0; k < 4; ++k) fa[k] = *(const LAS bf16x8*)(Kc + K128_OFF(2, k));
            SBAR();
#pragma unroll
            for (int k = 0; k < 4; ++k) p[k] = __builtin_amdgcn_mfma_f32_32x32x16_bf16(fb[k], qr[1], p[k], 0, 0, 0);
            SBAR();
#pragma unroll
            for (int k = 0; k < 4; ++k) fb[k] = *(const LAS bf16x8*)(Kc + K128_OFF(3, k));
            SBAR();
#pragma unroll
            for (int k = 0; k < 4; ++k) p[k] = __builtin_amdgcn_mfma_f32_32x32x16_bf16(fa[k], qr[2], p[k], 0, 0, 0);
            SBAR();
#pragma unroll
            for (int k = 0; k < 4; ++k) p[k] = __builtin_amdgcn_mfma_f32_32x32x16_bf16(fb[k], qr[3], p[k], 0, 0, 0);
#undef K128_OFF
            if ((j + 1) * 128 > nkw) {
                asm volatile("" ::: "memory");
#pragma unroll
                for (int k = 0; k < 4; ++k)
#pragma unroll
                    for (int r = 0; r < 16; ++r) { const int kb = j * 128 + 32 * k + crow(r, hi); if (kb >= nkw) p[k][r] = -1e30f; }
            }
            float pmax = p[0][0];
#pragma unroll
            for (int k = 0; k < 4; ++k)
#pragma unroll
                for (int r = 0; r < 16; ++r) pmax = fmaxf(pmax, p[k][r]);
            { auto rr = __builtin_amdgcn_permlane32_swap(__float_as_uint(pmax), __float_as_uint(pmax), false, false);
              pmax = fmaxf(__uint_as_float(rr[0]), __uint_as_float(rr[1])); }
            float mn, alpha;
            if (__builtin_expect(__all(pmax - m_reg <= thr_raw), 1)) { mn = m_reg; alpha = 1.f; }
            else { mn = fmaxf(m_reg, pmax); alpha = __builtin_amdgcn_exp2f((m_reg - mn) * C); m_reg = mn; }
            const float mnC = -mn * C;
            typedef float f32x2 __attribute__((ext_vector_type(2)));
            const f32x2 C2 = {C, C}, M2 = {mnC, mnC};
            f32x2 s2 = {0.f, 0.f};
#pragma unroll
            for (int k = 0; k < 4; ++k)
#pragma unroll
                for (int r = 0; r < 16; r += 2) { f32x2 t = {p[k][r], p[k][r + 1]}; t = __builtin_elementwise_fma(t, C2, M2);
                    t.x = __builtin_amdgcn_exp2f(t.x); t.y = __builtin_amdgcn_exp2f(t.y); p[k][r] = t.x; p[k][r + 1] = t.y; s2 += t; }
            float ps = s2.x + s2.y;
            { auto rr = __builtin_amdgcn_permlane32_swap(__float_as_uint(ps), __float_as_uint(ps), false, false);
              ps = __uint_as_float(rr[0]) + __uint_as_float(rr[1]); }
            l_reg = l_reg * alpha + ps;
            bf16x8 pa[8];
#define PK4(P, BASE, OUT) do { unsigned a0 = cvt_pk(P[BASE + 0], P[BASE + 1]), a1 = cvt_pk(P[BASE + 2], P[BASE + 3]);   \
    unsigned b0 = cvt_pk(P[BASE + 4], P[BASE + 5]), b1 = cvt_pk(P[BASE + 6], P[BASE + 7]);                              \
    auto r0 = __builtin_amdgcn_permlane32_swap(a0, b0, false, false); auto r1 = __builtin_amdgcn_permlane32_swap(a1, b1, false, false); \
    u32x4 w = {r0[0], r1[0], r0[1], r1[1]}; OUT = *reinterpret_cast<bf16x8*>(&w); } while (0)
#pragma unroll
            for (int k = 0; k < 4; ++k) { PK4(p[k], 0, pa[2 * k]); PK4(p[k], 8, pa[2 * k + 1]); }
#undef PK4
            if (__any(alpha < 1.f)) {
                if (hi == 0) wsc[r32] = alpha;
                asm volatile("s_waitcnt lgkmcnt(0)" ::: "memory");
#pragma unroll
                for (int r = 0; r < 16; ++r) { const float al = wsc[crow(r, hi)];
#pragma unroll
                    for (int d = 0; d < 4; ++d) o[d][r] *= al; }
            }
            const unsigned vb = vbase + (unsigned)(cur * VTB);
            pv_one128<0, 0>(o[0], vb, pa[0], pa[1], pa[2], pa[3]); pv_one128<0, 1>(o[0], vb, pa[4], pa[5], pa[6], pa[7]);
            pv_one128<1, 0>(o[1], vb, pa[0], pa[1], pa[2], pa[3]); pv_one128<1, 1>(o[1], vb, pa[4], pa[5], pa[6], pa[7]);
            pv_one128<2, 0>(o[2], vb, pa[0], pa[1], pa[2], pa[3]); pv_one128<2, 1>(o[2], vb, pa[4], pa[5], pa[6], pa[7]);
            pv_one128<3, 0>(o[3], vb, pa[0], pa[1], pa[2], pa[3]); pv_one128<3, 1>(o[3], vb, pa[4], pa[5], pa[6], pa[7]);
        }
        if (more) {
            LAS unsigned char* Kn = Kl + (cur ^ 1) * KTB; LAS unsigned char* Vn = Vl + (cur ^ 1) * VTB;
            K128_WRITE(Kn, Vn);
        }
        __syncthreads();
    }
    if (nkw > 0) {
        if (hi == 0) wsc[32 + r32] = l_reg;
        asm volatile("s_waitcnt lgkmcnt(0)" ::: "memory");
#pragma unroll
        for (int r = 0; r < 16; ++r) { const float rl = __builtin_amdgcn_rcpf(wsc[32 + crow(r, hi)]);
#pragma unroll
            for (int d = 0; d < 4; ++d) o[d][r] *= rl; }
    }
#undef K128_LOAD
#undef K128_WRITE
}

__device__ __forceinline__ void ffn_conv_phase(bf16_t* U, const float* __restrict__ st, const float* __restrict__ cw, const float* __restrict__ cb, long gt_, long NTH_, int dummy) {
        const long ntask = (long)(M / 4) * (FF / 8);
        for (long t = gt_; t < ntask; t += NTH_) {
            const int cch = (int)(t % (FF / 8)), rb = (int)(t / (FF / 8)), r0 = rb * 4, c0 = cch * 8;
            const bool samp = r0 >= MP;
            const int spos = samp ? ((r0 - MP) & 31) : (r0 & (SEQ - 1));
            const int sbb = (r0 - MP) >> 5;
            float gv[6][8];
#pragma unroll
            for (int k = 0; k < 6; ++k) {
                if (k >= 2 || spos != 0) unpack8(*(const GAS u32x4*)(U + (size_t)(r0 - 2 + k) * 5632 + c0), gv[k]);
                else if (samp) { const f32x4 h0 = *(const GAS f32x4*)(st + (size_t)(sbb * 2 + k) * FF + c0), h1 = *(const GAS f32x4*)(st + (size_t)(sbb * 2 + k) * FF + c0 + 4);
                    gv[k][0] = h0[0]; gv[k][1] = h0[1]; gv[k][2] = h0[2]; gv[k][3] = h0[3]; gv[k][4] = h1[0]; gv[k][5] = h1[1]; gv[k][6] = h1[2]; gv[k][7] = h1[3]; }
                else {
#pragma unroll
                    for (int e = 0; e < 8; ++e) gv[k][e] = 0.f; }
            }
            float w0[8], w1[8], w2[8], bb[8];
#pragma unroll
            for (int e = 0; e < 8; ++e) { w0[e] = cw[c0 + e]; w1[e] = cw[FF + c0 + e]; w2[e] = cw[2 * FF + c0 + e]; bb[e] = cb[c0 + e]; }
#pragma unroll
            for (int j = 0; j < 4; ++j) {
                bf16_t* up = U + (size_t)(r0 + j) * 5632 + FF + c0;
                float uv[8]; unpack8(*(const GAS u32x4*)up, uv);
                float ov[8];
#pragma unroll
                for (int e = 0; e < 8; ++e) { const float gs = w0[e] * gv[j][e] + w1[e] * gv[j + 1][e] + w2[e] * gv[j + 2][e] + bb[e];
                    ov[e] = gs / (1.f + __expf(-gs)) * uv[e]; }
                u32x4 w; w.x = cvt_pk(ov[0], ov[1]); w.y = cvt_pk(ov[2], ov[3]); w.z = cvt_pk(ov[4], ov[5]); w.w = cvt_pk(ov[6], ov[7]);
                if (!dummy || ov[0] == 1.2345e-37f) *(GAS u32x4*)up = w;
            }
        }
}

#define XB_TMO      128
#define XB_XCNT(j)  (256  + 64 * (j))
#define XB_XSUB(j)  (1280 + 64 * (j))
#define XB_XGEN(j)  (2304 + 64 * (j))
#define XB_TOP      3328
#define XB_TOPGEN   3392
#define XCD_BAR_WORDS 3456
#define XB_SPIN_CAP (1u << 18)

__device__ __forceinline__ unsigned xb_ld(unsigned* p)              { return __hip_atomic_load(p, __ATOMIC_RELAXED, __HIP_MEMORY_SCOPE_AGENT); }
__device__ __forceinline__ unsigned xb_add(unsigned* p, unsigned v) { return __hip_atomic_fetch_add(p, v, __ATOMIC_RELAXED, __HIP_MEMORY_SCOPE_AGENT); }
__device__ __forceinline__ unsigned xb_xcc_id() { return (unsigned)__builtin_amdgcn_s_getreg((3 << 11) | 20) & 0xFu; }
#define XB_SPIN(cond, bar) do { unsigned _sp = 0; while (cond) { __builtin_amdgcn_s_sleep(1); \
    if ((++_sp & 255u) == 0u) { if (xb_ld(&(bar)[XB_TMO])) break; if (_sp > XB_SPIN_CAP) { atomicAdd(&(bar)[XB_TMO], 1u); break; } } } } while (0)

struct XcdBarrier {
    unsigned* bar; unsigned x;
    volatile LAS unsigned* st;
};

__device__ __forceinline__ XcdBarrier xcd_barrier_post(unsigned* bar, volatile LAS unsigned* st) {
    XcdBarrier b; b.bar = bar; b.x = (unsigned)__builtin_amdgcn_readfirstlane((int)xb_xcc_id()); b.st = st;
    if (threadIdx.x == 0) (void)xb_add(&bar[XB_XCNT(b.x)], 1u);
    return b;
}
__device__ __forceinline__ void xcd_barrier_complete(unsigned* bar, unsigned x, unsigned& nloc, unsigned& nx) {
    const unsigned G = gridDim.x * gridDim.y * gridDim.z;
    unsigned sum, cnt, mine, sp = 0u;
    for (;;) {
        sum = 0u; cnt = 0u; mine = 0u;
#pragma unroll
        for (unsigned j = 0; j < 16; ++j) { const unsigned c = xb_ld(&bar[XB_XCNT(j)]); sum += c; cnt += (c > 0u) ? 1u : 0u; mine = (j == x) ? c : mine; }
        if (sum == G) break;
        __builtin_amdgcn_s_sleep(1);
        if ((++sp & 255u) == 0u) { if (xb_ld(&bar[XB_TMO])) break; if (sp > XB_SPIN_CAP) { atomicAdd(&bar[XB_TMO], 1u); break; } }
    }
    nloc = mine > 0u ? mine : 1u; nx = cnt > 0u ? cnt : 1u;
}

__device__ __forceinline__ void xcd_barrier(const XcdBarrier& b) {
    asm volatile("s_waitcnt vmcnt(0)" ::: "memory");
    __syncthreads();
    if (threadIdx.x == 0) {
        unsigned* bar = b.bar;
        __builtin_amdgcn_s_waitcnt(0);
        unsigned nloc = b.st[0], nx = b.st[1];
        if (nloc == 0u) { xcd_barrier_complete(bar, b.x, nloc, nx); b.st[0] = nloc; b.st[1] = nx; }
        const unsigned old = xb_add(&bar[XB_XSUB(b.x)], 1u);
        const unsigned gen = old / nloc;
        if (old + 1u == (gen + 1u) * nloc) {
            __builtin_amdgcn_fence(__ATOMIC_RELEASE, "agent");
            asm volatile("s_waitcnt vmcnt(0)" ::: "memory");
            const unsigned og = xb_add(&bar[XB_TOP], 1u);
            const unsigned tg = og / nx;
            if (og + 1u == (tg + 1u) * nx) xb_add(&bar[XB_TOPGEN], 1u);
            else XB_SPIN(xb_ld(&bar[XB_TOPGEN]) == tg, bar);
            __builtin_amdgcn_fence(__ATOMIC_ACQUIRE, "agent");
            xb_add(&bar[XB_XGEN(b.x)], 1u);
            asm volatile("s_waitcnt vmcnt(0)" ::: "memory");
        } else {
            XB_SPIN(xb_ld(&bar[XB_XGEN(b.x)]) == gen, bar);
            __builtin_amdgcn_fence(__ATOMIC_ACQUIRE, "agent");
            asm volatile("s_waitcnt vmcnt(0)" ::: "memory");
        }
    }
    __syncthreads();
}


struct Args { const float* in[33]; float* out; unsigned char* ws; };
__device__ __forceinline__ const float* ld_in(const Args& a, int k) { asm volatile("" : "+s"(k)); return a.in[k]; }
#define INP(k) ld_in(a, (k))
struct Ctx {
    unsigned char* ws; float* out; int tid, wid, lane, r32, hi, G, bid; long gt, NTH; int gw, NWV;
    float* ssq; float* rope; bf16_t* wmix; bf16_t* wffn; bf16_t* Xb; unsigned char* big; unsigned char* tail; float* X;
};
__device__ __forceinline__ Ctx mkctx(const Args& a) {
    Ctx c;
    { unsigned long long w = (unsigned long long)(uintptr_t)a.ws, o = (unsigned long long)(uintptr_t)a.out;
      unsigned wl = __builtin_amdgcn_readfirstlane((unsigned)w), wh = __builtin_amdgcn_readfirstlane((unsigned)(w >> 32));
      unsigned ol = __builtin_amdgcn_readfirstlane((unsigned)o), oh = __builtin_amdgcn_readfirstlane((unsigned)(o >> 32));
      asm volatile("" : "+s"(wl), "+s"(wh), "+s"(ol), "+s"(oh));
      c.ws = (unsigned char*)(uintptr_t)(((unsigned long long)wh << 32) | wl); c.out = (float*)(uintptr_t)(((unsigned long long)oh << 32) | ol); }
    int t = threadIdx.x; asm volatile("" : "+v"(t)); c.tid = t; c.wid = t >> 6; c.lane = t & 63; c.r32 = t & 31; c.hi = (t >> 5) & 1;
    int g = gridDim.x, b = blockIdx.x; asm volatile("" : "+s"(g), "+s"(b)); c.G = g; c.bid = b;
    c.gt = (long)b * NTHREADS + t; c.NTH = (long)g * NTHREADS; c.gw = b * 8 + c.wid; c.NWV = g * 8;
    c.ssq = (float*)(c.ws + WS_SSQP); c.rope = (float*)(c.ws + WS_ROPE); c.wmix = (bf16_t*)(c.ws + WS_WMIX); c.wffn = (bf16_t*)(c.ws + WS_WFFN);
    c.Xb = (bf16_t*)(c.ws + WS_XB); c.big = c.ws + WS_BIG; c.tail = c.ws + WS_TAIL; c.X = c.out + O_Y;
    return c;
}

__device__ __forceinline__ float* ssqb(const Ctx& c, int s) { return (float*)((unsigned char*)c.ssq + (size_t)(s & 1) * 3 * MiB); }
constexpr size_t B_WDN1 = 346 * MiB;
static_assert(B_WDN1 + 1024u * 2816 * 2 <= 356 * MiB, "wdn1");
__device__ __forceinline__ bf16_t* wdn_buf(const Ctx& c, int i) { return (i & 1) ? (bf16_t*)(c.big + B_WDN1) : c.wffn + W_DN; }
__device__ __forceinline__ void prep_ffn(const Args& a, const Ctx& c, LAS float* ltile, int i, int rank = -1, int nwork = 0) {
    prep_gu(ltile, INP(28) + (size_t)i * D * FF, INP(29) + (size_t)i * D * FF, c.wffn + W_GU, INP(10) + i * D, rank, nwork);
    prep_w(ltile, INP(32) + (size_t)i * FF * D, D, FF, D, wdn_buf(c, i), D, 0, 0, nullptr, 1, 1.f, nullptr, rank, nwork);
}

__device__ __forceinline__ void prep_mixer_rest(const Args& a, const Ctx& c, LAS float* ltile) {
    prep_w(ltile, INP(15), 1024, 1024, 1024, c.wmix + W_OA, 1024, 0, 0, INP(14), 128, 0.8f, nullptr);
    prep_w(ltile, INP(16), 704, 1024, 704, c.wmix + W_DB, 768, 0, 0, INP(9) + D, D, 1.f, nullptr);
    prep_w(ltile, INP(18), 1536, 384, 1536, c.wmix + W_UQ, 1536, 3, 0, nullptr, 1, 1.f, nullptr);
    prep_w(ltile, INP(20), 1024, 256, 1024, c.wmix + W_UKV, 1024, 0, 0, nullptr, 1, 1.f, nullptr);
    prep_w(ltile, INP(21), 1024, 256, 1024, c.wmix + W_UKV + 1024u * 256, 1024, 0, 0, nullptr, 1, 1.f, nullptr);
    prep_w(ltile, INP(22), 1024, 1024, 1024, c.wmix + W_OB, 1024, 0, 0, nullptr, 1, 1.f, nullptr);
    prep_w(ltile, INP(23), 3072, 1024, 3072, c.wmix + W_CIN, 3072, 0, 0, INP(9) + 2 * D, D, 1.f, nullptr);
    prep_w(ltile, INP(25), 1024, 1024, 1024, c.wmix + W_COUT, 1024, 0, 0, nullptr, 1, 1.f, nullptr);
#pragma unroll 1
    for (int g4 = 0; g4 < 4; ++g4)
        prep_w(ltile, INP(26) + (size_t)g4 * 65536, 256, 256, 256, c.wmix + W_DG + (size_t)g4 * 65536, 256, 0, 0, nullptr, 1, 1.f, INP(27) + g4 * 256);
}
__device__ __forceinline__ void ph_prologue(const Args& a, LAS unsigned char* lds) {
    const Ctx c = mkctx(a); LAS float* ltile = (LAS float*)lds;
    prep_w(ltile, INP(12), 3072, 1024, 3072, c.wmix + W_QKV, 3072, 1, 32, INP(9), D, 1.f, nullptr);
    for (long i = c.gt; i < 16384L * 32; i += c.NTH) {
        const int pos = (int)(i >> 5), k = (int)(i & 31);
        double inv = 1.0; for (int q = 0; q < k; ++q) inv *= 0.7498942093324559;
        const float invf = (float)inv;
        const double rev = (double)pos * (double)invf * 0.15915494309189535;
        const float fr = (float)(rev - floor(rev));
        c.rope[(size_t)pos * 64 + k] = __builtin_amdgcn_cosf(fr); c.rope[(size_t)pos * 64 + 32 + k] = __builtin_amdgcn_sinf(fr);
    }
    {
        const float* xp = INP(0); const float* xs = INP(1);
        for (int r = c.gw; r < M; r += c.NWV) {
            const float* src = r < MP ? xp + (size_t)r * D : xs + (size_t)(r - MP) * D;
            float ss = 0.f;
#pragma unroll
            for (int j = 0; j < 4; ++j) { const f32x4 v = *(const GAS f32x4*)(src + j * 256 + c.lane * 4); ss += v[0] * v[0] + v[1] * v[1] + v[2] * v[2] + v[3] * v[3];
                *(GAS u32x2*)(c.Xb + (size_t)r * D + j * 256 + c.lane * 4) = pack4(v); }
            ss = wave_sum(ss);
            if (c.lane < 16) ssqb(c, 0)[(size_t)r * 16 + c.lane] = c.lane == 0 ? ss : 0.f;
        }
    }
    {
        const float* ck = INP(2); const float* cv = INP(3);
        bf16_t* Ks = (bf16_t*)(c.tail + T_K); bf16_t* Vs = (bf16_t*)(c.tail + T_V);
        for (long i = c.gt; i < (long)SBN * PAST * D / 8; i += c.NTH) {
            const long e = i * 8; const int sbb = (int)(e / ((long)PAST * D)); const long rem = e % ((long)PAST * D);
            const size_t dst = (size_t)sbb * NKSP * D + rem;
            *(GAS u32x4*)(Ks + dst) = pack8(*(const GAS f32x4*)(ck + e), *(const GAS f32x4*)(ck + e + 4));
            *(GAS u32x4*)(Vs + dst) = pack8(*(const GAS f32x4*)(cv + e), *(const GAS f32x4*)(cv + e + 4));
        }
        for (long i = c.gt; i < (long)SBN * (NKSP - NKS) * D / 8; i += c.NTH) {
            const long e = i * 8; const int sbb = (int)(e / ((long)(NKSP - NKS) * D)); const long rem = e % ((long)(NKSP - NKS) * D);
            const size_t dst = ((size_t)sbb * NKSP + NKS) * D + rem;
            *(GAS u32x4*)(Ks + dst) = (u32x4){0, 0, 0, 0}; *(GAS u32x4*)(Vs + dst) = (u32x4){0, 0, 0, 0};
        }
    }
}

__device__ __forceinline__ void ph_l0_qkv(const Args& a, LAS unsigned char* lds) {
    const Ctx c = mkctx(a);
    bf16_t* Q = (bf16_t*)(c.big + B0_Q); bf16_t* Kb = (bf16_t*)(c.big + B0_K); bf16_t* Vb = (bf16_t*)(c.big + B0_V);
    bf16_t* Ks = (bf16_t*)(c.tail + T_K); bf16_t* Vs = (bf16_t*)(c.tail + T_V);
    pg8::Gemm g{c.Xb, c.wmix + W_QKV, M, 3072, 1024, 1024, 0}; pg8::StaticOrder S; S.init(M, 3072, c.G, c.bid);
    EpiQKV E{ssqb(c, 0), c.rope, Q, Kb, Vb, Ks, Vs, c.out + O_AKP, c.out + O_AVP, c.out + O_AKS, c.out + O_AVS};
    pg8::gemm_phase(lds, g, S, E);
    prep_mixer_rest(a, c, (LAS float*)lds);
}
struct AUnit { int b, h, qb, sbb; bool samp; };
__device__ __forceinline__ AUnit attn_unit_of(int G, int bid, int ui) {
    AUnit u; u.samp = false; u.sbb = 0; u.b = 0; u.qb = 0; u.h = 0;
    if (G == 256) {
        if (ui < 4) { const int combo = (bid & 7) * 2 + (ui >> 1); u.b = combo >> 3; u.h = combo & 7; u.qb = (ui & 1) ? (bid >> 3) : 63 - (bid >> 3); }
        else { u.samp = true; u.sbb = bid >> 3; u.h = bid & 7; }
    } else {
        const int id = bid + ui * G;
        if (id < 1024) { u.b = id >> 9; u.h = (id >> 6) & 7; u.qb = id & 63; } else { u.samp = true; u.sbb = (id - 1024) >> 3; u.h = (id - 1024) & 7; }
    }
    return u;
}
__device__ __forceinline__ int attn_ucount(int G, int bid) { return (G == 256) ? 4 + (bid < 64 ? 1 : 0) : (1024 + 64 - bid + G - 1) / G; }

__device__ __forceinline__ void ph_l0_attn(const Args& a, LAS unsigned char* lds, int dummy) {
    const Ctx c = mkctx(a);
    bf16_t* Q = (bf16_t*)(c.big + B0_Q); bf16_t* Kb = (bf16_t*)(c.big + B0_K); bf16_t* Vb = (bf16_t*)(c.big + B0_V); GAS float* OS = (GAS float*)(c.big + B0_OS);
    GAS bf16_t* Qg = (GAS bf16_t*)Q;
    bf16_t* Ks = (bf16_t*)(c.tail + T_K); bf16_t* Vs = (bf16_t*)(c.tail + T_V);
    float lam;
    { const float* al = INP(13); const float pa = al[c.lane] * al[64 + c.lane], pb = al[128 + c.lane] * al[192 + c.lane];
      lam = __expf(wave_sum(pa)) - __expf(wave_sum(pb)) + 0.2f; }
    const int ucount = attn_ucount(c.G, c.bid);
    if (__builtin_amdgcn_readfirstlane(c.tid) >= 256) __builtin_amdgcn_s_setprio(1);
#pragma unroll 1
    for (int ui = 0; ui < ucount; ++ui) {
        const AUnit u = attn_unit_of(c.G, c.bid, ui);
        const int row0 = u.samp ? MP + u.sbb * 32 : u.b * SEQ + u.qb * 256;
        const int NT = u.samp ? 9 : 2 * u.qb + 2;
        const int nkw = __builtin_amdgcn_readfirstlane(u.samp ? (c.wid == 0 ? NKS : 0) : (4 * u.qb + (c.wid >> 1) + 1) * 64);
        const bool act = nkw > 0;
#pragma unroll 1
        for (int cc = 0; cc < 2; ++cc) {
            const bf16_t* Kp = u.samp ? Ks + (size_t)u.sbb * NKSP * D + u.h * 128 + cc * 64 : Kb + (size_t)u.b * SEQ * D + u.h * 128 + cc * 64;
            const bf16_t* Vp = u.samp ? Vs + (size_t)u.sbb * NKSP * D + u.h * 128 : Vb + (size_t)u.b * SEQ * D + u.h * 128;
            f32x16 o[4];
            attn_unit_k128(Q + (size_t)row0 * D + u.h * 128 + cc * 64, D, Kp, D, Vp, D, NT, nkw, lds, o, 0.125f);
            if (act && (!dummy || o[0][0] == 1.2345e-37f)) {
                unsigned ebase = (unsigned)((row0 + c.wid * 32 + 4 * c.hi) * D + u.h * 128 + c.r32);
                asm volatile("" : "+v"(ebase));
                if (cc == 0) {
#pragma unroll
                    for (int r = 0; r < 16; ++r)
#pragma unroll
                        for (int d = 0; d < 4; ++d) OS[ebase + (unsigned)(((r & 3) + 8 * (r >> 2)) * D + d * 32)] = o[d][r];
                } else {
#pragma unroll
                    for (int r = 0; r < 16; ++r) {
                        if ((r & 3) == 0) asm volatile("" ::: "memory");
                        const unsigned base = ebase + (unsigned)(((r & 3) + 8 * (r >> 2)) * D);
                        float x[4]; float ss = 0.f;
#pragma unroll
                        for (int d = 0; d < 4; ++d) { x[d] = OS[base + d * 32] - lam * o[d][r]; ss += x[d] * x[d]; }
                        ss += __shfl_xor(ss, 1); ss += __shfl_xor(ss, 2); ss += __shfl_xor(ss, 4); ss += __shfl_xor(ss, 8); ss += __shfl_xor(ss, 16);
                        const float rs = rsqrtf(ss * (1.0f / 128.0f) + 1e-5f);
#pragma unroll
                        for (int d = 0; d < 4; ++d) Qg[base + d * 32] = f2bf(x[d] * rs);
                    }
                }
            }
        }
    }
    __builtin_amdgcn_s_setprio(0);
}
__device__ __forceinline__ void ph_l0_out(const Args& a, LAS unsigned char* lds) {
    const Ctx c = mkctx(a);
    bf16_t* Q = (bf16_t*)(c.big + B0_Q);
    pg8::Gemm g{Q, c.wmix + W_OA, M, 1024, 1024, 1024, 0}; pg8::StaticOrder S; S.init(M, 1024, c.G, c.bid);
    EpiResidT<true> E{INP(0), INP(1), c.Xb, ssqb(c, 1)};
    pg8::gemm_phase(lds, g, S, E);
    prep_ffn(a, c, (LAS float*)lds, 0);
}

__device__ __forceinline__ void ph_ffn_up(const Args& a, LAS unsigned char* lds, int i) {
    const Ctx c = mkctx(a);
    pg8::Gemm g{c.Xb, c.wffn + W_GU, M, 5632, 1024, 1024, 0}; g.mrows = 254; g.moff = -2;
    pg8::StaticOrder S; S.init2(131, 22, c.G, c.bid);
    EpiFfn E{(bf16_t*)c.big, ssqb(c, 2 * i + 1), INP(30) + (size_t)i * 3 * FF, INP(31) + (size_t)i * FF, INP(8) + (size_t)i * SBN * 2 * FF,
             c.out + O_FCP + (size_t)i * NBP * 2 * FF, c.out + O_FCS + (size_t)i * SBN * 2 * FF, lds + 131072 + 4096};
    pg8::gemm_phase(lds, g, S, E);
}
constexpr size_t B_SLAB = 180 * MiB;
__device__ __forceinline__ void ph_ffn_down(const Args& a, LAS unsigned char* lds, int i) {
    const Ctx c = mkctx(a);
    constexpr int NS = FF / 256;
    const bool split = c.G >= 8 * NS;
    {
        pg8::Gemm g{(bf16_t*)c.big, wdn_buf(c, i), M, 1024, FF, FF, 0}; pg8::StaticOrder S; S.init(split ? MP : M, 1024, c.G, c.bid);
        EpiResidT<false> E{nullptr, nullptr, c.Xb, ssqb(c, 2 * i + 2)};
        pg8::gemm_phase(lds, g, S, E);
    }
    if (!split) { if (i < 3) prep_ffn(a, c, (LAS float*)lds, i + 1); return; }
    if (c.bid >= 4 * NS) {
        if (i < 3) prep_ffn(a, c, (LAS float*)lds, i + 1, c.bid - 4 * NS, c.G - 4 * NS);
        return;
    }
    unsigned* cnt = (unsigned*)c.ws + 3600 + i;
    float* slab = (float*)(c.big + B_SLAB);
    {
        const int pn = c.bid & 3, ks = c.bid >> 2;
        pg8::Gemm g{(bf16_t*)c.big + ks * 256, wdn_buf(c, i) + ks * 256, M, 1024, 256, FF, 0}; g.ldb = FF;
        pg8::SingleUnit S{128, pn};
        EpiSlab E{slab + (size_t)(pn * NS + ks) * 65536};
        pg8::gemm_phase(lds, g, S, E);
        __builtin_amdgcn_fence(__ATOMIC_RELEASE, "agent"); asm volatile("s_waitcnt vmcnt(0)" ::: "memory");
        __syncthreads();
        if (c.tid == 0) __hip_atomic_fetch_add(cnt, 1u, __ATOMIC_RELAXED, __HIP_MEMORY_SCOPE_AGENT);
    }
    if (c.bid < 16) {
        if (c.tid == 0) { unsigned sp = 0; while (__hip_atomic_load(cnt, __ATOMIC_RELAXED, __HIP_MEMORY_SCOPE_AGENT) < 4u * NS) { __builtin_amdgcn_s_sleep(2); if (++sp > (1u << 22)) break; } }
        __syncthreads();
        __builtin_amdgcn_fence(__ATOMIC_ACQUIRE, "agent"); asm volatile("s_waitcnt vmcnt(0)" ::: "memory");
        const int sl = c.bid, pn = sl >> 2, row = c.tid >> 1, cq = (sl & 3) * 64 + (c.tid & 1) * 32;
        const size_t xoff = (size_t)(MP + row) * D + pn * 256 + cq;
        float ss = 0.f;
#pragma unroll
        for (int k8 = 0; k8 < 4; ++k8) {
            const u32x4 w = *(const GAS u32x4*)(c.Xb + xoff + k8 * 8);
            f32x4 v0 = {bflo(w.x), bfhi(w.x), bflo(w.y), bfhi(w.y)}, v1 = {bflo(w.z), bfhi(w.z), bflo(w.w), bfhi(w.w)};
#pragma unroll
            for (int ks = 0; ks < NS; ++ks) { const float* p = slab + (size_t)(pn * NS + ks) * 65536 + row * 256 + cq + k8 * 8;
                v0 += *(const GAS f32x4*)p; v1 += *(const GAS f32x4*)(p + 4); }
            *(GAS u32x4*)(c.Xb + xoff + k8 * 8) = pack8(v0, v1);
            ss += (v0[0] * v0[0] + v0[1] * v0[1]) + (v0[2] * v0[2] + v0[3] * v0[3]) + (v1[0] * v1[0] + v1[1] * v1[1]) + (v1[2] * v1[2] + v1[3] * v1[3]);
        }
        ss += __shfl_xor(ss, 1);
        if ((c.tid & 1) == 0) ssqb(c, 2 * i + 2)[(size_t)(MP + row) * 16 + sl] = ss;
    }
}

__device__ __forceinline__ void ph_l1_down(const Args& a, LAS unsigned char* lds) {
    const Ctx c = mkctx(a);
    pg8::Gemm g{c.Xb, c.wmix + W_DB, M, 768, 1024, 1024, 0}; pg8::StaticOrder S; S.init(M, 768, c.G, c.bid);
    EpiF32 E{(float*)(c.big + B1_DOWN), 768, ssqb(c, 2)};
    pg8::gemm_phase(lds, g, S, E);
}
__device__ __forceinline__ void ph_l1_rows(const Args& a) {
    const Ctx c = mkctx(a);
    const float* DOWN = (const float*)(c.big + B1_DOWN); bf16_t* CQ = (bf16_t*)(c.big + B1_CQ); bf16_t* CKV = (bf16_t*)(c.big + B1_CKV); bf16_t* KR = (bf16_t*)(c.big + B1_KR);
    bf16_t* KsN = (bf16_t*)(c.tail + T_K); bf16_t* VsB = (bf16_t*)(c.tail + T_V); bf16_t* KRs = (bf16_t*)(c.tail + T_KR);
    const float* gq = INP(17); const float* gkv = INP(19); const int lane = c.lane;
    for (int r = c.gw; r < M; r += c.NWV) {
        const float* dr = DOWN + (size_t)r * 768;
        const bool samp = r >= MP; const int sr_ = r - MP, sbb = sr_ >> 5, tt = sr_ & 31;
        const int pos = samp ? PAST + tt : (r & (SEQ - 1));
        float cq[6]; float s1 = 0.f;
#pragma unroll
        for (int j = 0; j < 6; ++j) { cq[j] = dr[j * 64 + lane]; s1 += cq[j] * cq[j]; }
        s1 = wave_sum(s1); const float r1 = rsqrtf(s1 * (1.0f / 384.0f) + NORM_EPS);
#pragma unroll
        for (int j = 0; j < 6; ++j) CQ[(size_t)r * 384 + j * 64 + lane] = f2bf(cq[j] * r1 * gq[j * 64 + lane]);
        float kv[4]; float s2 = 0.f;
#pragma unroll
        for (int j = 0; j < 4; ++j) { kv[j] = dr[384 + j * 64 + lane]; s2 += kv[j] * kv[j]; }
        s2 = wave_sum(s2); const float r2 = rsqrtf(s2 * (1.0f / 256.0f) + NORM_EPS);
        float* lo = samp ? c.out + O_BLS + (size_t)sr_ * 256 : c.out + O_BLP + (size_t)r * 256;
#pragma unroll
        for (int j = 0; j < 4; ++j) { const float v = kv[j] * r2 * gkv[j * 64 + lane]; lo[j * 64 + lane] = v; CKV[(size_t)r * 256 + j * 64 + lane] = f2bf(v); }
        const float xk = dr[640 + lane], xo = __shfl_xor(xk, 32);
        const float cs = c.rope[(size_t)pos * 64 + (lane & 31)], sn = c.rope[(size_t)pos * 64 + 32 + (lane & 31)];
        const float y = lane < 32 ? xk * cs - xo * sn : xk * cs + xo * sn;
        if (samp) { c.out[O_BRS + (size_t)sr_ * 64 + lane] = y; KRs[((size_t)sbb * NKSP + PAST + tt) * 64 + lane] = f2bf(y); }
        else { c.out[O_BRP + (size_t)r * 64 + lane] = y; KR[(size_t)r * 64 + lane] = f2bf(y); }
    }
    const float* cl = INP(4); const float* ckr = INP(5);
    for (long i = c.gt; i < (long)MCACHE * 256 / 8; i += c.NTH) {
        const long e = i * 8;
        *(GAS u32x4*)(CKV + (size_t)M * 256 + e) = pack8(*(const GAS f32x4*)(cl + e), *(const GAS f32x4*)(cl + e + 4));
    }
    for (long i = c.gt; i < (long)MCACHE * 64 / 8; i += c.NTH) {
        const long e = i * 8; const int sbb = (int)(e / (PAST * 64)); const long rem = e % (PAST * 64);
        *(GAS u32x4*)(KRs + (size_t)sbb * NKSP * 64 + rem) = pack8(*(const GAS f32x4*)(ckr + e), *(const GAS f32x4*)(ckr + e + 4));
    }
    for (long i = c.gt; i < (long)SBN * (NKSP - NKS) * D / 8; i += c.NTH) {
        const long e = i * 8; const int sbb = (int)(e / ((long)(NKSP - NKS) * D)); const long rem = e % ((long)(NKSP - NKS) * D);
        const size_t dst = ((size_t)sbb * NKSP + NKS) * D + rem;
        *(GAS u32x4*)(KsN + dst) = (u32x4){0, 0, 0, 0}; *(GAS u32x4*)(VsB + dst) = (u32x4){0, 0, 0, 0};
    }
    for (long i = c.gt; i < (long)SBN * (NKSP - NKS) * 64 / 8; i += c.NTH) {
        const long e = i * 8; const int sbb = (int)(e / ((long)(NKSP - NKS) * 64)); const long rem = e % ((long)(NKSP - NKS) * 64);
        *(GAS u32x4*)(KRs + ((size_t)sbb * NKSP + NKS) * 64 + rem) = (u32x4){0, 0, 0, 0};
    }
}
__device__ __forceinline__ void ph_l1_uq(const Args& a, LAS unsigned char* lds) {
    const Ctx c = mkctx(a);
    pg8::Gemm g{(bf16_t*)(c.big + B1_CQ), c.wmix + W_UQ, M, 1536, 384, 384, 0}; pg8::StaticOrder S; S.init(M, 1536, c.G, c.bid);
    EpiUQ E{c.rope, (bf16_t*)(c.big + B1_DOWN)};
    pg8::gemm_phase(lds, g, S, E);
}
__device__ __forceinline__ void ph_l1_expand(const Args& a, LAS unsigned char* lds) {
    const Ctx c = mkctx(a);
    pg8::Gemm g{(bf16_t*)(c.big + B1_CKV), c.wmix + W_UKV, MX, 2048, 256, 256, 0}; pg8::StaticOrder S; S.init(MX, 2048, c.G, (c.bid + c.G / 2) % c.G);
    EpiExpand E{(bf16_t*)(c.big + B1_KN), (bf16_t*)(c.big + B1_V), (bf16_t*)(c.tail + T_K), (bf16_t*)(c.tail + T_V)};
    pg8::gemm_phase(lds, g, S, E);
}
__device__ __forceinline__ void ph_l1_attn(const Args& a, LAS unsigned char* lds, int dummy) {
    const Ctx c = mkctx(a);
    bf16_t* QB = (bf16_t*)(c.big + B1_DOWN); bf16_t* KN = (bf16_t*)(c.big + B1_KN); bf16_t* KR = (bf16_t*)(c.big + B1_KR); bf16_t* VB = (bf16_t*)(c.big + B1_V); GAS bf16_t* AO = (GAS bf16_t*)(c.big + B1_AO);
    bf16_t* KsN = (bf16_t*)(c.tail + T_K); bf16_t* VsB = (bf16_t*)(c.tail + T_V); bf16_t* KRs = (bf16_t*)(c.tail + T_KR);
    const int ucount = attn_ucount(c.G, c.bid);
    if (__builtin_amdgcn_readfirstlane(c.tid) >= 256) __builtin_amdgcn_s_setprio(1);
#pragma unroll 1
    for (int ui = 0; ui < ucount; ++ui) {
        const AUnit u = attn_unit_of(c.G, c.bid, ui);
        const int row0 = u.samp ? MP + u.sbb * 32 : u.b * SEQ + u.qb * 256;
        const int NT = u.samp ? 17 : 4 * u.qb + 4;
        const int lim = u.samp ? (c.wid == 0 ? 16 : -1) : 4 * u.qb + (c.wid >> 1);
        const int nkeys = u.samp ? NKS : NT * 64;
        const bool act = lim >= 0;
        const bf16_t* Kp = u.samp ? KsN + (size_t)u.sbb * NKSP * D + u.h * 128 : KN + (size_t)u.b * SEQ * D + u.h * 128;
        const bf16_t* Krp = u.samp ? KRs + (size_t)u.sbb * NKSP * 64 : KR + (size_t)u.b * SEQ * 64;
        const bf16_t* Vp = u.samp ? VsB + (size_t)u.sbb * NKSP * D + u.h * 128 : VB + (size_t)u.b * SEQ * D + u.h * 128;
        f32x16 o[4];
        attn_unit_np<192>(QB + (size_t)row0 * 1536 + u.h * 192, 1536, Kp, D, Krp, Vp, D, NT, lim, nkeys, lds, o, 0.07216878364870322f);
        if (act && (!dummy || o[0][0] == 1.2345e-37f)) {
            unsigned ebase = (unsigned)((row0 + c.wid * 32 + 4 * c.hi) * D + u.h * 128 + c.r32);
            asm volatile("" : "+v"(ebase));
#pragma unroll
            for (int r = 0; r < 16; ++r)
#pragma unroll
                for (int d = 0; d < 4; ++d) AO[ebase + (unsigned)(((r & 3) + 8 * (r >> 2)) * D + d * 32)] = f2bf(o[d][r]);
        }
    }
    __builtin_amdgcn_s_setprio(0);
}
__device__ __forceinline__ void ph_mix_out(const Args& a, LAS unsigned char* lds, size_t a_off, size_t w_off, int K, int lda, int apn, int so) {
    const Ctx c = mkctx(a);
    pg8::Gemm g{(bf16_t*)(c.big + a_off), c.wmix + w_off, M, 1024, K, lda, apn}; pg8::StaticOrder S; S.init(M, 1024, c.G, c.bid);
    EpiResidT<false> E{nullptr, nullptr, c.Xb, ssqb(c, so)};
    pg8::gemm_phase(lds, g, S, E);
}

__device__ __forceinline__ void ph_l2_in(const Args& a, LAS unsigned char* lds) {
    const Ctx c = mkctx(a);
    pg8::Gemm g{c.Xb, c.wmix + W_CIN, M, 3072, 1024, 1024, 0}; pg8::StaticOrder S; S.init(M, 3072, c.G, c.bid);
    EpiBf16 E{(bf16_t*)(c.big + B2_CIN), 3072, ssqb(c, 4), nullptr, nullptr, 0};
    pg8::gemm_phase(lds, g, S, E);
}
__device__ __forceinline__ void ph_l2_conv(const Args& a) {
    const Ctx c = mkctx(a);
    const bf16_t* CIN = (const bf16_t*)(c.big + B2_CIN); bf16_t* CP = (bf16_t*)(c.big + B2_CP);
    const float* state_c = INP(6); const float* cw = INP(24);
    const long ntask = (long)(M / 4) * (D / 8);
    for (long t = c.gt; t < ntask; t += c.NTH) {
        const int cch = (int)(t % (D / 8)), rb = (int)(t / (D / 8)), r0 = rb * 4, c0 = cch * 8;
        const bool samp = r0 >= MP;
        const int spos = samp ? ((r0 - MP) & 31) : (r0 & (SEQ - 1));
        const int sbb = (r0 - MP) >> 5, bb_ = r0 >> 14;
        float z[6][8];
#pragma unroll
        for (int k = 0; k < 6; ++k) {
            if (k >= 2 || spos != 0) { float gc[8], vv[8]; const bf16_t* rp_ = CIN + (size_t)(r0 - 2 + k) * 3072 + c0;
                unpack8(*(const GAS u32x4*)(rp_ + 1024), gc); unpack8(*(const GAS u32x4*)(rp_ + 2048), vv);
#pragma unroll
                for (int e = 0; e < 8; ++e) z[k][e] = gc[e] * vv[e]; }
            else if (samp) {
#pragma unroll
                for (int e = 0; e < 8; ++e) z[k][e] = state_c[(size_t)(sbb * 2 + k) * D + c0 + e]; }
            else {
#pragma unroll
                for (int e = 0; e < 8; ++e) z[k][e] = 0.f; }
        }
        float w0[8], w1[8], w2[8];
#pragma unroll
        for (int e = 0; e < 8; ++e) { w0[e] = cw[c0 + e]; w1[e] = cw[D + c0 + e]; w2[e] = cw[2 * D + c0 + e]; }
#pragma unroll
        for (int j = 0; j < 4; ++j) {
            const int r = r0 + j;
            float gb[8]; unpack8(*(const GAS u32x4*)(CIN + (size_t)r * 3072 + c0), gb);
            float ov[8];
#pragma unroll
            for (int e = 0; e < 8; ++e) ov[e] = gb[e] * (w0[e] * z[j][e] + w1[e] * z[j + 1][e] + w2[e] * z[j + 2][e]);
            u32x4 w; w.x = cvt_pk(ov[0], ov[1]); w.y = cvt_pk(ov[2], ov[3]); w.z = cvt_pk(ov[4], ov[5]); w.w = cvt_pk(ov[6], ov[7]);
            *(GAS u32x4*)(CP + (size_t)r * D + c0) = w;
            float* so = nullptr;
            if (!samp) { const int s = spos + j; if (s >= SEQ - 2) so = c.out + O_CCP + (size_t)(bb_ * 2 + (s - (SEQ - 2))) * D + c0; }
            else { const int tq = spos + j; if (tq >= 30) so = c.out + O_CCS + (size_t)(sbb * 2 + (tq - 30)) * D + c0; }
            if (so) {
#pragma unroll
                for (int e = 0; e < 8; ++e) so[e] = z[j + 2][e]; }
        }
    }
}

__device__ __forceinline__ void ph_l3_rstd(const Args& a) {
    const Ctx c = mkctx(a);
    float* rst = (float*)(c.ws + 65536); const float* sq = ssqb(c, 6);
    for (long r = c.gt; r < M; r += c.NTH) rst[r] = rstd_row(sq, (int)r);
}
__device__ __forceinline__ void ph_l3_pool(const Args& a, LAS unsigned char* lds) {
    const Ctx c = mkctx(a);
    bf16_t* DP = (bf16_t*)c.big;
    const float* rst = (const float*)(c.ws + 65536); const float* gm = INP(9) + 3 * D; const float* state_d = INP(7);
    const long ntask = (long)M * (D / 4);
    for (long t = c.gt; t < ntask; t += c.NTH) {
        const int c0 = (int)(t % (D / 4)) * 4, r = (int)(t / (D / 4));
        const bool samp = r >= MP; const int sr_ = r - MP, sbb = sr_ >> 5;
        const int spos = samp ? (sr_ & 31) : (r & (SEQ - 1));
        const int w = 2 << (c0 >> 8);
        const f32x4 gv = *(const GAS f32x4*)(gm + c0);
        const u32x2 wt = *(const GAS u32x2*)(c.Xb + (size_t)r * D + c0);
        const f32x4 ht = (f32x4){bflo(wt.x), bfhi(wt.x), bflo(wt.y), bfhi(wt.y)} * rst[r] * gv;
        f32x4 sum = ht;
        for (int i = 1; i < w; ++i) {
            const int sp = spos - i;
            if (sp >= 0) { const u32x2 wi = *(const GAS u32x2*)(c.Xb + (size_t)(r - i) * D + c0); sum += (f32x4){bflo(wi.x), bfhi(wi.x), bflo(wi.y), bfhi(wi.y)} * rst[r - i] * gv; }
            else if (samp) sum += *(const GAS f32x4*)(state_d + (size_t)(sbb * 15 + 15 + sp) * D + c0);
        }
        const float cnt = samp ? (float)w : (float)((spos + 1) < w ? (spos + 1) : w);
        const f32x4 dp = sum / cnt - ht;
        *(GAS u32x2*)(DP + (size_t)r * D + c0) = pack4(dp);
        if (!samp) { if (spos >= SEQ - 15) *(GAS f32x4*)(c.out + O_DPP + (size_t)((r >> 14) * 15 + (spos - (SEQ - 15))) * D + c0) = ht; }
        else { if (spos >= 17) *(GAS f32x4*)(c.out + O_DPS + (size_t)(sbb * 15 + (spos - 17)) * D + c0) = ht; }
    }
}
__device__ __forceinline__ void ph_final(const Args& a) {
    const Ctx c = mkctx(a);
    const float* sq = ssqb(c, 8); const float* gf = INP(11);
    for (int r = c.gw; r < M; r += c.NWV) {
        const float rs = rstd_row(sq, r);
#pragma unroll
        for (int j = 0; j < 4; ++j) { const int cc_ = j * 256 + c.lane * 4; const u32x2 w = *(const GAS u32x2*)(c.Xb + (size_t)r * D + cc_);
            const f32x4 xv = {bflo(w.x), bfhi(w.x), bflo(w.y), bfhi(w.y)};
            NT_ST4(c.X + (size_t)r * D + cc_, xv * rs * *(const GAS f32x4*)(gf + cc_)); }
    }
}

#ifdef SKIP_PH_PROLOGUE
#define ON_PH_PROLOGUE(x)
#else
#define ON_PH_PROLOGUE(x) x
#endif
#ifdef SKIP_PH_L0_QKV
#define ON_PH_L0_QKV(x)
#else
#define ON_PH_L0_QKV(x) x
#endif
#ifdef SKIP_PH_L0_ATTN
#define ON_PH_L0_ATTN(x)
#else
#define ON_PH_L0_ATTN(x) x
#endif
#ifdef SKIP_PH_L0_OUT
#define ON_PH_L0_OUT(x)
#else
#define ON_PH_L0_OUT(x) x
#endif
#ifdef SKIP_PH_L1_DOWN
#define ON_PH_L1_DOWN(x)
#else
#define ON_PH_L1_DOWN(x) x
#endif
#ifdef SKIP_PH_L1_ROWS
#define ON_PH_L1_ROWS(x)
#else
#define ON_PH_L1_ROWS(x) x
#endif
#ifdef SKIP_PH_L1_UQ
#define ON_PH_L1_UQ(x)
#else
#define ON_PH_L1_UQ(x) x
#endif
#ifdef SKIP_PH_L1_EXPAND
#define ON_PH_L1_EXPAND(x)
#else
#define ON_PH_L1_EXPAND(x) x
#endif
#ifdef SKIP_PH_L1_ATTN
#define ON_PH_L1_ATTN(x)
#else
#define ON_PH_L1_ATTN(x) x
#endif
#ifdef SKIP_PH_MIX_OUT
#define ON_PH_MIX_OUT(x)
#else
#define ON_PH_MIX_OUT(x) x
#endif
#ifdef SKIP_PH_L2_IN
#define ON_PH_L2_IN(x)
#else
#define ON_PH_L2_IN(x) x
#endif
#ifdef SKIP_PH_L2_CONV
#define ON_PH_L2_CONV(x)
#else
#define ON_PH_L2_CONV(x) x
#endif
#ifdef SKIP_PH_L3_POOL
#define ON_PH_L3_POOL(x)
#else
#define ON_PH_L3_POOL(x) x
#endif
#ifdef SKIP_PH_FFN_UP
#define ON_PH_FFN_UP(x)
#else
#define ON_PH_FFN_UP(x) x
#endif
#ifdef SKIP_PH_FFN_CONV
#define ON_PH_FFN_CONV(x)
#else
#define ON_PH_FFN_CONV(x) x
#endif
#ifdef SKIP_PH_FFN_DOWN
#define ON_PH_FFN_DOWN(x)
#else
#define ON_PH_FFN_DOWN(x) x
#endif
#ifdef SKIP_PH_FINAL
#define ON_PH_FINAL(x)
#else
#define ON_PH_FINAL(x) x
#endif
__global__ void __launch_bounds__(NTHREADS, 2) mega_fwd(Args a) {
    extern __shared__ __attribute__((aligned(16))) unsigned char lds_raw[];
    LAS unsigned char* lds = (LAS unsigned char*)lds_raw;
    cg::grid_group grid = cg::this_grid();
    if (gridDim.x == 0xffffffffu) grid.sync();
    int nrep_attn = PROBE_ATTN_REPS; asm volatile("" : "+s"(nrep_attn));
    int nrep_conv = PROBE_CONV_REPS; asm volatile("" : "+s"(nrep_conv));
    int nrep_sync = PROBE_SYNC_REPS; asm volatile("" : "+s"(nrep_sync));
    LAS unsigned* bst = (LAS unsigned*)(lds + 131072 + 2048);
    if (threadIdx.x < 2) bst[threadIdx.x] = 0u;
    __syncthreads();
    unsigned char* wsb = a.ws; asm volatile("" : "+s"(wsb));
    const XcdBarrier xbar = xcd_barrier_post((unsigned*)wsb, (volatile LAS unsigned*)bst);
#define GSYNC() do { for (int q_ = 0; q_ < nrep_sync; ++q_) { xcd_barrier(xbar); } } while (0)
    ON_PH_PROLOGUE(ph_prologue(a, lds);) GSYNC();
#pragma unroll 1
    for (int layer = 0; layer < 4; ++layer) {
        if (layer == 0) {
            ON_PH_L0_QKV(ph_l0_qkv(a, lds);) GSYNC();
            ON_PH_L0_ATTN(for (int rep = nrep_attn - 1; rep >= 0; --rep) ph_l0_attn(a, lds, rep);) GSYNC();
            ON_PH_L0_OUT(ph_l0_out(a, lds);) GSYNC();
        } else if (layer == 1) {
            ON_PH_L1_DOWN(ph_l1_down(a, lds);) GSYNC();
            ON_PH_L1_ROWS(ph_l1_rows(a);) GSYNC();
            ON_PH_L1_UQ(ph_l1_uq(a, lds);) ON_PH_L1_EXPAND(ph_l1_expand(a, lds);) GSYNC();
            ON_PH_L1_ATTN(for (int rep = nrep_attn - 1; rep >= 0; --rep) ph_l1_attn(a, lds, rep);) GSYNC();
            ON_PH_MIX_OUT(ph_mix_out(a, lds, B1_AO, W_OB, 1024, 1024, 0, 3);) GSYNC();
        } else if (layer == 2) {
            ON_PH_L2_IN(ph_l2_in(a, lds);) GSYNC();
            ON_PH_L2_CONV(ph_l2_conv(a);) GSYNC();
            ON_PH_MIX_OUT(ph_mix_out(a, lds, B2_CP, W_COUT, 1024, 1024, 0, 5);) GSYNC();
        } else {
            ON_PH_L3_POOL(ph_l3_rstd(a);) GSYNC();
            ON_PH_L3_POOL(ph_l3_pool(a, lds);) GSYNC();
            ON_PH_MIX_OUT(ph_mix_out(a, lds, 0, W_DG, 256, 1024, 256, 7);) GSYNC();
        }
        ON_PH_FFN_UP(ph_ffn_up(a, lds, layer);) GSYNC();
        ON_PH_FFN_DOWN(ph_ffn_down(a, lds, layer);) GSYNC();
    }
    ON_PH_FINAL(ph_final(a);)
}
extern "C" void kernel_launch(void* const* d_in, const int* in_sizes, int n_in, void* d_out, int out_size, void* d_ws, size_t ws_size, hipStream_t stream) {
    static int grid = 0;
    if (grid == 0) {
        if (n_in != 33 || (size_t)out_size != O_END || ws_size < WS_END) {
            fprintf(stderr, "kernel_launch: shape mismatch n_in %d out %d (want %zu) ws %zu (want %zu)\n", n_in, out_size, (size_t)O_END, ws_size, (size_t)WS_END);
            grid = -1; return; }
        int dev = 0, cus = 0, per_cu = 0;
        hipGetDevice(&dev);
        hipDeviceGetAttribute(&cus, hipDeviceAttributeMultiprocessorCount, dev);
        if (hipFuncSetAttribute((const void*)mega_fwd, hipFuncAttributeMaxDynamicSharedMemorySize, LDS_BYTES) != hipSuccess) { fprintf(stderr, "kernel_launch: hipFuncSetAttribute failed\n"); grid = -1; return; }
        if (hipOccupancyMaxActiveBlocksPerMultiprocessor(&per_cu, (const void*)mega_fwd, NTHREADS, LDS_BYTES) != hipSuccess || per_cu < 1) { fprintf(stderr, "kernel_launch: occupancy query failed (%d)\n", per_cu); per_cu = 1; }
        (void)hipGetLastError();
        grid = cus * 1;
        fprintf(stderr, "kernel_launch: cus %d per_cu %d grid %d\n", cus, per_cu, grid);
    }
    if (grid < 0) return;
    Args a{};
    for (int i = 0; i < 33; ++i) a.in[i] = (const float*)d_in[i];
    a.out = (float*)d_out; a.ws = (unsigned char*)d_ws;
    if (hipMemsetAsync(d_ws, 0, 16384, stream) != hipSuccess) { fprintf(stderr, "kernel_launch: memset failed\n"); return; }
    void* args[] = {&a};
    hipError_t e = hipLaunchCooperativeKernel((const void*)mega_fwd, dim3(grid), dim3(NTHREADS), args, LDS_BYTES, stream);
    if (e != hipSuccess) fprintf(stderr, "kernel_launch: cooperative launch failed: %s (grid %d)\n", hipGetErrorString(e), grid);
}
```
